# Optimizing an MI355X kernel written in HIP

```python
import jax, jax.numpy as jnp
from jax import lax
import numpy as np

D_MODEL = 1024
BATCH = 4
SEQ = 4096
DEPTH = 4

GRID_W = 64
CTX_LEN = 256
HEAD_DIM = 64
ATTN_DIM = D_MODEL // 2
N_Q_HEADS = ATTN_DIM // HEAD_DIM
N_KV_HEADS = N_Q_HEADS // 4
Q_PER_KV = N_Q_HEADS // N_KV_HEADS
KV_DIM = N_KV_HEADS * HEAD_DIM
GMLP_DIM = D_MODEL - ATTN_DIM
GMLP_GROUP_DIM = 128
N_GMLP_GROUPS = GMLP_DIM // GMLP_GROUP_DIM
CHUNK = 128
MIX_DIM = ATTN_DIM + GMLP_DIM
IN_DIM = ATTN_DIM + 2 * KV_DIM + 2 * GMLP_DIM
FF_DIM = 4 * D_MODEL
Q_BLOCK = 128
ROPE_THETA = 10000.0
EPS = 1e-6
N_MOD = 6

kernel_name = "hybrid_gmlp_gqa_prefix_dit"


def rmsnorm(x, g):
    xf = x.astype(jnp.float32)
    y = xf * lax.rsqrt(jnp.mean(xf * xf, axis=-1, keepdims=True) + EPS)
    return (y * g.astype(jnp.float32)).astype(x.dtype)


def group_layernorm(v, g):
    vf = v.astype(jnp.float32)
    mu = jnp.mean(vf, axis=-1, keepdims=True)
    var = jnp.mean(jnp.square(vf - mu), axis=-1, keepdims=True)
    return ((vf - mu) * lax.rsqrt(var + EPS) * g.astype(jnp.float32)).astype(v.dtype)


def modulation(cond, w_mod, b_mod):
    m = jax.nn.silu(cond) @ w_mod + b_mod
    return m.reshape(m.shape[:-1] + (N_MOD, D_MODEL))


def modulate(h, shift, scale):
    return h * (1 + scale) + shift


def axial_rope_tables(n_lat):
    rows = n_lat // GRID_W
    row = jnp.repeat(jnp.arange(rows, dtype=jnp.float32), GRID_W)
    col = jnp.tile(jnp.arange(GRID_W, dtype=jnp.float32), rows)
    n_freq = HEAD_DIM // 4
    inv_freq = ROPE_THETA ** (-jnp.arange(n_freq, dtype=jnp.float32) / n_freq)
    ang = jnp.stack([row[:, None] * inv_freq, col[:, None] * inv_freq], axis=1)
    return jnp.cos(ang), jnp.sin(ang)


def apply_rope(x, cos, sin):
    xf = x.astype(jnp.float32).reshape(x.shape[:-1] + (2, 2, HEAD_DIM // 4))
    x1, x2 = xf[..., 0, :], xf[..., 1, :]
    out = jnp.stack([x1 * cos - x2 * sin, x2 * cos + x1 * sin], axis=-2)
    return out.reshape(x.shape).astype(x.dtype)


def q_heads(q):
    b, n, _ = q.shape
    return q.reshape(b, n, N_KV_HEADS, Q_PER_KV, HEAD_DIM).transpose(0, 2, 3, 1, 4)


def kv_heads(k):
    b, n, _ = k.shape
    return k.reshape(b, n, N_KV_HEADS, HEAD_DIM).transpose(0, 2, 1, 3)


def gqa_blocks(q, k, v):
    b, kvh, g, n, dh = q.shape
    nb = n // Q_BLOCK
    qb = jnp.moveaxis(q.reshape(b, kvh, g, nb, Q_BLOCK, dh), 3, 0)

    def one_block(qblk):
        s = jnp.einsum('bkgqd,bkmd->bkgqm', qblk, k).astype(jnp.float32)
        p = jax.nn.softmax(s, axis=-1).astype(v.dtype)
        return jnp.einsum('bkgqm,bkmd->bkgqd', p, v)

    o = lax.map(one_block, qb)
    o = jnp.moveaxis(o, 0, 3).reshape(b, kvh, g, n, dh)
    return o.transpose(0, 3, 1, 2, 4).reshape(b, n, ATTN_DIM)


def chunk_gmlp(u, vg, w_s, b_s, g_norm):
    b, n, _ = u.shape
    u = jax.nn.gelu(u)
    vg = group_layernorm(jax.nn.gelu(vg).reshape(b, n, N_GMLP_GROUPS, GMLP_GROUP_DIM),
                         g_norm.reshape(N_GMLP_GROUPS, GMLP_GROUP_DIM))
    vc = vg.reshape(b, n // CHUNK, CHUNK, N_GMLP_GROUPS, GMLP_GROUP_DIM)
    mixed = jnp.einsum('gpq,bnqgc->bnpgc', w_s, vc) + b_s.T[None, None, :, :, None]
    return u * mixed.reshape(b, n, GMLP_DIM)


def sqrelu_mlp(h, w1, w2):
    return jnp.square(jax.nn.relu(h @ w1)) @ w2


def setup_inputs(seed: int = 0) -> dict:
    key = jax.random.key(seed)
    ks = jax.random.split(key, 17)
    f32 = jnp.float32
    nrm = lambda k, shape, s: (jax.random.normal(k, shape, f32) * s)
    gain = lambda k, shape: 1.0 + 0.02 * jax.random.normal(k, shape, f32)
    return {
        "x": nrm(ks[0], (BATCH, SEQ, D_MODEL), 1.0),
        "c": nrm(ks[1], (BATCH, D_MODEL), 1.0),
        "ctx": nrm(ks[2], (BATCH, CTX_LEN, D_MODEL), 1.0),
        "c_ctx": nrm(ks[3], (D_MODEL,), 1.0),
        "w_mod": nrm(ks[4], (DEPTH, D_MODEL, N_MOD * D_MODEL), D_MODEL ** -0.5),
        "b_mod": nrm(ks[5], (DEPTH, N_MOD * D_MODEL), 0.02),
        "norm1_g": gain(ks[6], (DEPTH, D_MODEL)),
        "w_in": nrm(ks[7], (DEPTH, D_MODEL, IN_DIM), D_MODEL ** -0.5),
        "q_norm_g": gain(ks[8], (DEPTH, HEAD_DIM)),
        "k_norm_g": gain(ks[9], (DEPTH, HEAD_DIM)),
        "gmlp_norm_g": gain(ks[10], (DEPTH, GMLP_DIM)),
        "w_spatial": nrm(ks[11], (DEPTH, N_GMLP_GROUPS, CHUNK, CHUNK), CHUNK ** -0.5),
        "b_spatial": gain(ks[12], (DEPTH, N_GMLP_GROUPS, CHUNK)),
        "w_out": nrm(ks[13], (DEPTH, MIX_DIM, D_MODEL), MIX_DIM ** -0.5),
        "norm2_g": gain(ks[14], (DEPTH, D_MODEL)),
        "w_ff1": nrm(ks[15], (DEPTH, D_MODEL, FF_DIM), D_MODEL ** -0.5),
        "w_ff2": nrm(ks[16], (DEPTH, FF_DIM, D_MODEL), FF_DIM ** -0.5),
    }


def reference(x, c, ctx, c_ctx, w_mod, b_mod, norm1_g, w_in, q_norm_g, k_norm_g, gmlp_norm_g,
              w_spatial, b_spatial, w_out, norm2_g, w_ff1, w_ff2):
    n_lat = x.shape[1]
    cos, sin = axial_rope_tables(n_lat)
    q_scale = HEAD_DIM ** -0.5
    kv_lo, kv_hi = ATTN_DIM, ATTN_DIM + 2 * KV_DIM
    x_lat, x_ctx = x, ctx
    for l in range(DEPTH):
        last = l == DEPTH - 1
        m_lat = modulation(c, w_mod[l], b_mod[l])
        m_ctx = modulation(c_ctx, w_mod[l], b_mod[l])
        sh1, sc1, ga1, sh2, sc2, ga2 = [m_lat[:, i, None, :] for i in range(N_MOD)]
        csh1, csc1, cga1, csh2, csc2, cga2 = [m_ctx[None, i, None, :] for i in range(N_MOD)]

        h_lat = modulate(rmsnorm(x_lat, norm1_g[l]), sh1, sc1)
        h_ctx = modulate(rmsnorm(x_ctx, norm1_g[l]), csh1, csc1)
        z_lat = h_lat @ w_in[l]
        q_l = z_lat[..., :ATTN_DIM]
        k_l = z_lat[..., kv_lo:kv_lo + KV_DIM]
        v_l = z_lat[..., kv_lo + KV_DIM:kv_hi]
        u_l = z_lat[..., kv_hi:kv_hi + GMLP_DIM]
        g_l = z_lat[..., kv_hi + GMLP_DIM:]
        if last:
            z_ctx = h_ctx @ w_in[l][:, kv_lo:kv_hi]
            k_c, v_c = z_ctx[..., :KV_DIM], z_ctx[..., KV_DIM:]
        else:
            z_ctx = h_ctx @ w_in[l]
            q_c = z_ctx[..., :ATTN_DIM]
            k_c = z_ctx[..., kv_lo:kv_lo + KV_DIM]
            v_c = z_ctx[..., kv_lo + KV_DIM:kv_hi]
            u_c = z_ctx[..., kv_hi:kv_hi + GMLP_DIM]
            g_c = z_ctx[..., kv_hi + GMLP_DIM:]

        qh_l = apply_rope(rmsnorm(q_heads(q_l), q_norm_g[l]), cos, sin) * q_scale
        kh_l = apply_rope(rmsnorm(kv_heads(k_l), k_norm_g[l]), cos, sin)
        kh_c = rmsnorm(kv_heads(k_c), k_norm_g[l])
        vh_c = kv_heads(v_c)
        k_all = jnp.concatenate([kh_c, kh_l], axis=2)
        v_all = jnp.concatenate([vh_c, kv_heads(v_l)], axis=2)
        attn_lat = gqa_blocks(qh_l, k_all, v_all)
        gm_lat = chunk_gmlp(u_l, g_l, w_spatial[l], b_spatial[l], gmlp_norm_g[l])
        x_lat = x_lat + ga1 * (jnp.concatenate([attn_lat, gm_lat], axis=-1) @ w_out[l])
        x_lat = x_lat + ga2 * sqrelu_mlp(modulate(rmsnorm(x_lat, norm2_g[l]), sh2, sc2),
                                         w_ff1[l], w_ff2[l])

        if not last:
            qh_c = rmsnorm(q_heads(q_c), q_norm_g[l]) * q_scale
            attn_ctx = gqa_blocks(qh_c, kh_c, vh_c)
            gm_ctx = chunk_gmlp(u_c, g_c, w_spatial[l], b_spatial[l], gmlp_norm_g[l])
            x_ctx = x_ctx + cga1 * (jnp.concatenate([attn_ctx, gm_ctx], axis=-1) @ w_out[l])
            x_ctx = x_ctx + cga2 * sqrelu_mlp(modulate(rmsnorm(x_ctx, norm2_g[l]), csh2, csc2),
                                              w_ff1[l], w_ff2[l])
    return x_lat
```

```cpp
#include <hip/hip_runtime.h>
#include <hip/hip_cooperative_groups.h>
#include <stdint.h>
#include <cstdio>
namespace cg = cooperative_groups;

#ifndef MK_COOP
#define MK_COOP 1
#endif

#define DI __device__ __forceinline__
#define LDSP __attribute__((address_space(3)))
typedef LDSP char* ldsp_t;
typedef unsigned short bf16_t;
typedef short bf16x8 __attribute__((ext_vector_type(8)));
typedef float f32x2 __attribute__((ext_vector_type(2)));
typedef float f32x4 __attribute__((ext_vector_type(4)));
typedef float f32x16 __attribute__((ext_vector_type(16)));
typedef unsigned u32x2 __attribute__((ext_vector_type(2)));
typedef unsigned u32x4 __attribute__((ext_vector_type(4)));
typedef __bf16 bf2_t __attribute__((ext_vector_type(2)));

constexpr int DM = 1024, NB = 4, SEQ = 4096, DEPTH = 4, CTXL = 256;
constexpr int NLAT = NB * SEQ;
constexpr int NCTX = NB * CTXL;
constexpr int NTOK = NLAT + NCTX;
constexpr int IN_DIM = 1792, FF = 4096, NKEY = CTXL + SEQ;
constexpr float EPS = 1e-6f;
constexpr float LOG2E = 1.4426950408889634f;

struct Params {
    const float *x, *c, *ctx, *c_ctx, *w_mod, *b_mod, *norm1_g, *w_in, *q_norm_g, *k_norm_g, *gmlp_norm_g, *w_spatial, *b_spatial, *w_out, *norm2_g, *w_ff1, *w_ff2;
    float* out;
    bf16_t *wt_in, *wt_out, *wt_ff1, *wt_ff2, *ws_bf;
    float *mod, *rope, *xc;
    bf16_t *H, *Q, *Qc, *K, *Vt, *U, *GT, *MIX, *ACT;
};

DI unsigned pk2(float a, float b) { f32x2 v = {a, b}; bf2_t r = __builtin_convertvector(v, bf2_t); return __builtin_bit_cast(unsigned, r); }
DI bf16_t f2bf(float a) { return (bf16_t)(pk2(a, 0.f) & 0xffffu); }
DI float fexp2(float x) { return __builtin_amdgcn_exp2f(x); }
DI float gelu_tanh(float x) {
    const float y = 0.7978845608028654f * (x + 0.044715f * x * x * x);
    return x / (1.f + fexp2(-2.f * LOG2E * y));
}
DI float* xrow_ptr(const Params& p, int row) { return row < NLAT ? p.out + (size_t)row * DM : p.xc + (size_t)(row - NLAT) * DM; }

DI void transpose_tile(const float* __restrict__ src, bf16_t* __restrict__ dst, int K, int N, int tk, int tn, ldsp_t smem) {
    LDSP float* t = (LDSP float*)smem;
    const int tid = threadIdx.x, k0 = tk * 64, n0 = tn * 64;
#pragma unroll
    for (int i = 0; i < 2; ++i) {
        const int k = (tid >> 4) + 32 * i, n4 = (tid & 15) * 4;
        const f32x4 v = *(const f32x4*)(src + (size_t)(k0 + k) * N + n0 + n4);
        t[k * 65 + n4 + 0] = v[0]; t[k * 65 + n4 + 1] = v[1]; t[k * 65 + n4 + 2] = v[2]; t[k * 65 + n4 + 3] = v[3];
    }
    __syncthreads();
    {
        const int n = tid >> 3, k8 = (tid & 7) * 8;
        u32x4 w;
        w[0] = pk2(t[(k8 + 0) * 65 + n], t[(k8 + 1) * 65 + n]);
        w[1] = pk2(t[(k8 + 2) * 65 + n], t[(k8 + 3) * 65 + n]);
        w[2] = pk2(t[(k8 + 4) * 65 + n], t[(k8 + 5) * 65 + n]);
        w[3] = pk2(t[(k8 + 6) * 65 + n], t[(k8 + 7) * 65 + n]);
        *(u32x4*)(dst + (size_t)(n0 + n) * K + k0 + k8) = w;
    }
    __syncthreads();
}

DI void mod_unit(const Params& p, int l, int cgi, ldsp_t smem) {
    LDSP float* s = (LDSP float*)smem;
    LDSP float* red = (LDSP float*)(smem + 20480);
    const int tid = threadIdx.x;
    for (int i = tid; i < 5 * 1024; i += 512) {
        const int cnd = i >> 10, k = i & 1023;
        const float v = cnd < 4 ? p.c[cnd * 1024 + k] : p.c_ctx[k];
        s[i] = v / (1.f + fexp2(-LOG2E * v));
    }
    __syncthreads();
    const int c4 = tid & 15, ks = tid >> 4;
    f32x4 acc[5];
#pragma unroll
    for (int q = 0; q < 5; ++q) acc[q] = (f32x4){0.f, 0.f, 0.f, 0.f};
    const float* wp = p.w_mod + ((size_t)l * 1024 + ks * 32) * 6144 + cgi * 64 + c4 * 4;
#pragma unroll 4
    for (int kk = 0; kk < 32; ++kk) {
        const f32x4 w = *(const f32x4*)(wp + (size_t)kk * 6144);
        const int k = ks * 32 + kk;
#pragma unroll
        for (int q = 0; q < 5; ++q) acc[q] += w * s[q * 1024 + k];
    }
#pragma unroll
    for (int q = 0; q < 5; ++q)
#pragma unroll
        for (int j = 0; j < 4; ++j) red[(ks * 5 + q) * 64 + c4 * 4 + j] = acc[q][j];
    __syncthreads();
    if (tid < 320) {
        const int q = tid >> 6, col = tid & 63;
        float a = 0.f;
        for (int k2 = 0; k2 < 32; ++k2) a += red[(k2 * 5 + q) * 64 + col];
        const int j = cgi * 64 + col;
        p.mod[((size_t)l * 5 + q) * 6144 + j] = a + p.b_mod[(size_t)l * 6144 + j];
    }
    __syncthreads();
}

DI void phase0(const Params& p, ldsp_t smem) {
    constexpr int T_IN = 16 * 28, T_OUT = 16 * 16, T_FF1 = 16 * 64, T_FF2 = 64 * 16;
    constexpr int T_L = T_IN + T_OUT + T_FF1 + T_FF2;
    constexpr int U_T = DEPTH * T_L;
    constexpr int U_MOD = DEPTH * 96;
    constexpr int U_WS = 64;
    constexpr int U_ALL = U_MOD + U_T + U_WS + 1;
    for (int u = blockIdx.x; u < U_ALL; u += gridDim.x) {
        if (u < U_MOD) { mod_unit(p, u / 96, u % 96, smem); continue; }
        int v = u - U_MOD;
        if (v < U_T) {
            const int l = v / T_L; int r = v % T_L;
            if (r < T_IN) { transpose_tile(p.w_in + (size_t)l * DM * IN_DIM, p.wt_in + (size_t)l * IN_DIM * DM, DM, IN_DIM, r / 28, r % 28, smem); continue; }
            r -= T_IN;
            if (r < T_OUT) { transpose_tile(p.w_out + (size_t)l * DM * DM, p.wt_out + (size_t)l * DM * DM, DM, DM, r / 16, r % 16, smem); continue; }
            r -= T_OUT;
            if (r < T_FF1) { transpose_tile(p.w_ff1 + (size_t)l * DM * FF, p.wt_ff1 + (size_t)l * FF * DM, DM, FF, r / 64, r % 64, smem); continue; }
            r -= T_FF1;
            transpose_tile(p.w_ff2 + (size_t)l * FF * DM, p.wt_ff2 + (size_t)l * DM * FF, FF, DM, r / 16, r % 16, smem); continue;
        }
        v -= U_T;
        if (v < U_WS) {
            const size_t i = ((size_t)v * 512 + threadIdx.x) * 8;
            const f32x4 a = *(const f32x4*)(p.w_spatial + i), b = *(const f32x4*)(p.w_spatial + i + 4);
            u32x4 w; w[0] = pk2(a[0], a[1]); w[1] = pk2(a[2], a[3]); w[2] = pk2(b[0], b[1]); w[3] = pk2(b[2], b[3]);
            *(u32x4*)(p.ws_bf + i) = w;
            continue;
        }
        for (int i = threadIdx.x; i < 1024; i += 512) {
            const int pos = i >> 4, f = i & 15;
            const float inv = fexp2(-(float)f * (13.287712379549449f / 16.f));
            const float rev = (float)pos * inv * 0.15915494309189535f;
            p.rope[i] = __builtin_amdgcn_cosf(rev);
            p.rope[1024 + i] = __builtin_amdgcn_sinf(rev);
        }
    }
}

DI void norm_phase(const Params& p, int l, int which) {
    const int lane = threadIdx.x & 63, wid = threadIdx.x >> 6;
    const float* g = (which == 1 ? p.norm1_g : p.norm2_g) + (size_t)l * DM;
    const int si = which == 1 ? 0 : 3;
    const int M = (which == 2 && l == DEPTH - 1) ? NLAT : NTOK;
    const bool first = (which == 1 && l == 0);
    for (int row = blockIdx.x * 8 + wid; row < M; row += gridDim.x * 8) {
        const float* src;
        if (first) src = row < NLAT ? p.x + (size_t)row * DM : p.ctx + (size_t)(row - NLAT) * DM;
        else src = xrow_ptr(p, row);
        const int cond = row < NLAT ? (row >> 12) : 4;
        const float* mp = p.mod + ((size_t)l * 5 + cond) * 6144;
        f32x4 v[4];
        float ss = 0.f;
#pragma unroll
        for (int i = 0; i < 4; ++i) { v[i] = *(const f32x4*)(src + i * 256 + lane * 4); ss += v[i][0] * v[i][0] + v[i][1] * v[i][1] + v[i][2] * v[i][2] + v[i][3] * v[i][3]; }
#pragma unroll
        for (int o = 1; o < 64; o <<= 1) ss += __shfl_xor(ss, o);
        const float rstd = rsqrtf(ss * (1.f / DM) + EPS);
        bf16_t* hp = p.H + (size_t)row * DM;
        float* xw = first ? xrow_ptr(p, row) : nullptr;
#pragma unroll
        for (int i = 0; i < 4; ++i) {
            const int idx = i * 256 + lane * 4;
            const f32x4 gg = *(const f32x4*)(g + idx), sh = *(const f32x4*)(mp + si * DM + idx), sc = *(const f32x4*)(mp + (si + 1) * DM + idx);
            f32x4 y;
#pragma unroll
            for (int j = 0; j < 4; ++j) y[j] = v[i][j] * rstd * gg[j] * (1.f + sc[j]) + sh[j];
            u32x2 w; w[0] = pk2(y[0], y[1]); w[1] = pk2(y[2], y[3]);
            *(u32x2*)(hp + idx) = w;
            if (first) *(f32x4*)(xw + idx) = v[i];
        }
    }
}

constexpr int G_TILE_B = 256 * 64 * 2, G_STAGE_B = 2 * G_TILE_B;
DI int lds_byte2(int r, int c) {
    const int st = (r >> 4) * 2 + (c >> 5), ob = (r & 15) * 64 + (c & 31) * 2;
    return st * 1024 + (ob ^ (((ob >> 9) & 1) << 5));
}
DI void stage_rc2(int b, int& R, int& C) {
    const int st = b >> 10, sb = b & 1023, swz = sb ^ (((sb >> 9) & 1) << 5);
    R = (st >> 1) * 16 + swz / 64;
    C = (st & 1) * 32 + (swz % 64) / 2;
}
#define WAIT_V0() asm volatile("s_waitcnt vmcnt(0)" ::: "memory")

struct TileCtx { int brow, bcol, pn, wr, wc, fr, fq, wid, lane, l; };

template <class Epi>
DI void gemm_tile(const bf16_t* __restrict__ A, const bf16_t* __restrict__ Bt, int K, TileCtx tc, ldsp_t shm, const Params& p) {
    int tid_ = threadIdx.x;
    asm volatile("" : "+v"(tid_));
    tc.wid = tid_ >> 6; tc.lane = tid_ & 63; tc.wr = tc.wid >> 2; tc.wc = tc.wid & 3; tc.fr = tc.lane & 15; tc.fq = tc.lane >> 4;
    const int wid = tc.wid, lane = tc.lane, wr = tc.wr, wc = tc.wc, fr = tc.fr, fq = tc.fq;
    const bf16_t* Ab = A + (size_t)tc.brow * K;
    const bf16_t* Bb = Bt + (size_t)tc.bcol * K;
    int sR[4], sC[4];
#pragma unroll
    for (int i = 0; i < 4; ++i) stage_rc2(wid * 1024 + i * 8192 + lane * 16, sR[i], sC[i]);
    f32x4 acc[8][4];
#pragma unroll
    for (int m = 0; m < 8; ++m)
#pragma unroll
        for (int n = 0; n < 4; ++n) acc[m][n] = (f32x4){0.f, 0.f, 0.f, 0.f};
#define G_SA(b) (shm + (b) * G_STAGE_B)
#define G_SB(b) (shm + (b) * G_STAGE_B + G_TILE_B)
#define G_STAGE(buf, kt) do { _Pragma("unroll") for (int i = 0; i < 4; ++i) { \
        __builtin_amdgcn_global_load_lds((const unsigned*)(Ab + (size_t)sR[i] * K + (kt) * 64 + sC[i]), (LDSP unsigned*)(G_SA(buf) + wid * 1024 + i * 8192), 16, 0, 0); \
        __builtin_amdgcn_global_load_lds((const unsigned*)(Bb + (size_t)sR[i] * K + (kt) * 64 + sC[i]), (LDSP unsigned*)(G_SB(buf) + wid * 1024 + i * 8192), 16, 0, 0); } } while (0)
    const int nt = K / 64;
    G_STAGE(0, 0); WAIT_V0(); __syncthreads();
    for (int t = 0; t < nt; ++t) {
        const int cur = t & 1;
        if (t + 1 < nt) G_STAGE(cur ^ 1, t + 1);
#pragma unroll
        for (int ks = 0; ks < 2; ++ks) {
            bf16x8 At[8], Bf[4];
#pragma unroll
            for (int m = 0; m < 8; ++m) At[m] = *(const LDSP bf16x8*)(G_SA(cur) + lds_byte2(wr * 128 + m * 16 + fr, ks * 32 + fq * 8));
#pragma unroll
            for (int n = 0; n < 4; ++n) Bf[n] = *(const LDSP bf16x8*)(G_SB(cur) + lds_byte2(wc * 64 + n * 16 + fr, ks * 32 + fq * 8));
#pragma unroll
            for (int m = 0; m < 8; ++m)
#pragma unroll
                for (int n = 0; n < 4; ++n) acc[m][n] = __builtin_amdgcn_mfma_f32_16x16x32_bf16(Bf[n], At[m], acc[m][n], 0, 0, 0);
            __builtin_amdgcn_sched_barrier(0);
        }
        WAIT_V0(); __syncthreads();
    }
    Epi::run(acc, tc, p, shm);
}

template <int GI> struct EpiResid {
    static DI void run(f32x4 (&acc)[8][4], const TileCtx& tc, const Params& p, ldsp_t) {
        const int cond = tc.brow < NLAT ? (tc.brow >> 12) : 4;
        const float* gate = p.mod + ((size_t)tc.l * 5 + cond) * 6144 + GI * DM;
        const int col0 = tc.bcol + tc.wc * 64 + tc.fq * 4;
        f32x4 gv[4];
#pragma unroll
        for (int n = 0; n < 4; ++n) gv[n] = *(const f32x4*)(gate + col0 + n * 16);
#pragma unroll
        for (int m = 0; m < 8; ++m) {
            const int row = tc.brow + tc.wr * 128 + m * 16 + tc.fr;
            float* xr = xrow_ptr(p, row) + col0;
#pragma unroll
            for (int n = 0; n < 4; ++n) {
                f32x4 xv = *(const f32x4*)(xr + n * 16);
                xv += gv[n] * acc[m][n];
                *(f32x4*)(xr + n * 16) = xv;
            }
        }
    }
};
struct EpiFF1 {
    static DI void run(f32x4 (&acc)[8][4], const TileCtx& tc, const Params& p, ldsp_t) {
        const int col0 = tc.bcol + tc.wc * 64 + tc.fq * 4;
#pragma unroll
        for (int m = 0; m < 8; ++m) {
            const int row = tc.brow + tc.wr * 128 + m * 16 + tc.fr;
            bf16_t* ar = p.ACT + (size_t)row * FF + col0;
#pragma unroll
            for (int n = 0; n < 4; ++n) {
                f32x4 a = acc[m][n];
#pragma unroll
                for (int j = 0; j < 4; ++j) { const float r = fmaxf(a[j], 0.f); a[j] = r * r; }
                u32x2 w; w[0] = pk2(a[0], a[1]); w[1] = pk2(a[2], a[3]);
                *(u32x2*)(ar + n * 16) = w;
            }
        }
    }
};
template <int BRK> struct EpiIn {
    static DI void run(f32x4 (&acc)[8][4], const TileCtx& tc, const Params& p, ldsp_t shm) {
        const int l = tc.l, pn = tc.pn, wc = tc.wc, fr = tc.fr, fq = tc.fq;
        if (BRK == 0 || (BRK == 1 && wc < 2)) {
            constexpr bool isq = BRK == 0;
            const int head = isq ? pn * 4 + wc : wc;
            const float* gn = (isq ? p.q_norm_g : p.k_norm_g) + l * 64;
            f32x4 gv[4];
#pragma unroll
            for (int n = 0; n < 4; ++n) gv[n] = *(const f32x4*)(gn + n * 16 + fq * 4);
            const float osc = isq ? 0.125f : 1.f;
#pragma unroll
            for (int m = 0; m < 8; ++m) {
                const int row = tc.brow + tc.wr * 128 + m * 16 + fr;
                float ss = 0.f;
#pragma unroll
                for (int n = 0; n < 4; ++n)
#pragma unroll
                    for (int j = 0; j < 4; ++j) ss += acc[m][n][j] * acc[m][n][j];
                ss += __shfl_xor(ss, 16);
                ss += __shfl_xor(ss, 32);
                const float rstd = rsqrtf(ss * (1.f / 64.f) + EPS);
                f32x4 v[4];
#pragma unroll
                for (int n = 0; n < 4; ++n) v[n] = acc[m][n] * rstd * gv[n];
                bf16_t* dst;
                if (row < NLAT) {
                    const int b = row >> 12, t = row & 4095, pr = t >> 6, pc = t & 63;
                    const f32x4 c0 = *(const f32x4*)(p.rope + pr * 16 + fq * 4), s0 = *(const f32x4*)(p.rope + 1024 + pr * 16 + fq * 4);
                    const f32x4 c1 = *(const f32x4*)(p.rope + pc * 16 + fq * 4), s1 = *(const f32x4*)(p.rope + 1024 + pc * 16 + fq * 4);
                    const f32x4 a0 = v[0] * c0 - v[1] * s0, a1 = v[1] * c0 + v[0] * s0;
                    const f32x4 a2 = v[2] * c1 - v[3] * s1, a3 = v[3] * c1 + v[2] * s1;
                    v[0] = a0; v[1] = a1; v[2] = a2; v[3] = a3;
                    dst = isq ? p.Q + ((size_t)(b * 8 + head) * SEQ + t) * 64 : p.K + ((size_t)(b * 2 + head) * NKEY + CTXL + t) * 64;
                } else {
                    const int r2 = row - NLAT, b = r2 >> 8, t = r2 & 255;
                    dst = isq ? p.Qc + ((size_t)(b * 8 + head) * CTXL + t) * 64 : p.K + ((size_t)(b * 2 + head) * NKEY + t) * 64;
                }
#pragma unroll
                for (int n = 0; n < 4; ++n) {
                    u32x2 w; w[0] = pk2(v[n][0] * osc, v[n][1] * osc); w[1] = pk2(v[n][2] * osc, v[n][3] * osc);
                    *(u32x2*)(dst + n * 16 + fq * 4) = w;
                }
            }
        } else if (BRK == 1) {
            const int kvh = wc - 2;
#pragma unroll
            for (int m = 0; m < 8; ++m) {
                const int row = tc.brow + tc.wr * 128 + m * 16 + fr;
                int b, pos;
                if (row < NLAT) { b = row >> 12; pos = CTXL + (row & 4095); } else { const int r2 = row - NLAT; b = r2 >> 8; pos = r2 & 255; }
                bf16_t* dst = p.Vt + (size_t)(b * 2 + kvh) * 64 * NKEY + pos;
#pragma unroll
                for (int n = 0; n < 4; ++n)
#pragma unroll
                    for (int j = 0; j < 4; ++j) dst[(size_t)(n * 16 + fq * 4 + j) * NKEY] = f2bf(acc[m][n][j]);
            }
        } else if (BRK == 2) {
            const int ucol = (pn - 3) * 256 + wc * 64 + fq * 4;
#pragma unroll
            for (int m = 0; m < 8; ++m) {
                const int row = tc.brow + tc.wr * 128 + m * 16 + fr;
                bf16_t* dst = p.U + (size_t)row * 512 + ucol;
#pragma unroll
                for (int n = 0; n < 4; ++n) {
                    u32x2 w; w[0] = pk2(gelu_tanh(acc[m][n][0]), gelu_tanh(acc[m][n][1])); w[1] = pk2(gelu_tanh(acc[m][n][2]), gelu_tanh(acc[m][n][3]));
                    *(u32x2*)(dst + n * 16) = w;
                }
            }
        } else if (BRK == 3) {
            LDSP f32x2* ex = (LDSP f32x2*)shm;
            const int grp = (pn - 5) * 2 + (wc >> 1), cbase = (wc & 1) * 64;
            const float* gg = p.gmlp_norm_g + l * 512 + grp * 128 + cbase + fq * 4;
            f32x4 gv[4];
#pragma unroll
            for (int n = 0; n < 4; ++n) gv[n] = *(const f32x4*)(gg + n * 16);
            float s1[8], s2[8];
#pragma unroll
            for (int m = 0; m < 8; ++m) {
                float a = 0.f, b = 0.f;
#pragma unroll
                for (int n = 0; n < 4; ++n)
#pragma unroll
                    for (int j = 0; j < 4; ++j) { const float t = gelu_tanh(acc[m][n][j]); acc[m][n][j] = t; a += t; b += t * t; }
                a += __shfl_xor(a, 16); a += __shfl_xor(a, 32);
                b += __shfl_xor(b, 16); b += __shfl_xor(b, 32);
                s1[m] = a; s2[m] = b;
                if (fq == 0) ex[tc.wid * 128 + m * 16 + fr] = (f32x2){a, b};
            }
            __syncthreads();
            const int T = (tc.brow + tc.wr * 128) >> 7;
            bf16_t* dst = p.GT + ((size_t)(T * 4 + grp) * 128 + cbase + fq * 4) * 128;
#pragma unroll
            for (int m = 0; m < 8; ++m) {
                const f32x2 o = ex[(tc.wid ^ 1) * 128 + m * 16 + fr];
                const float mean = (s1[m] + o[0]) * (1.f / 128.f);
                const float var = (s2[m] + o[1]) * (1.f / 128.f) - mean * mean;
                const float rstd = rsqrtf(fmaxf(var, 0.f) + EPS);
                const int q = m * 16 + fr;
#pragma unroll
                for (int n = 0; n < 4; ++n)
#pragma unroll
                    for (int j = 0; j < 4; ++j) dst[(size_t)(n * 16 + j) * 128 + q] = f2bf((acc[m][n][j] - mean) * rstd * gv[n][j]);
            }
            __syncthreads();
        }
    }
};

template <class Epi>
DI void gemm_phase(const Params& p, int l, const bf16_t* A, const bf16_t* Bt, int M, int N, int K, ldsp_t shm) {
    const int nM = M / 256, nN = N / 256, nwg = nM * nN;
    TileCtx tc;
    tc.l = l;
    for (int L = blockIdx.x; L < nwg; L += gridDim.x) {
        int wgid = L;
        { const int q = nwg / 8, r = nwg % 8, xcd = wgid % 8, off = wgid / 8; wgid = (xcd < r ? xcd * (q + 1) : r * (q + 1) + (xcd - r) * q) + off; }
        const int nig = 8 * nN, gid = wgid / nig, fm = gid * 8, gsz = (nM - fm) < 8 ? (nM - fm) : 8;
        const int pm = fm + ((wgid % nig) % gsz), pn = (wgid % nig) / gsz;
        tc.brow = pm * 256; tc.bcol = pn * 256; tc.pn = pn;
        gemm_tile<Epi>(A, Bt, K, tc, shm, p);
    }
}
DI void inproj_phase(const Params& p, int l, ldsp_t shm) {
    const bf16_t* A = p.H; const bf16_t* Bt = p.wt_in + (size_t)l * IN_DIM * DM;
    const int nM = NTOK / 256, nN = IN_DIM / 256, nwg = nM * nN;
    TileCtx tc;
    tc.l = l;
    for (int L = blockIdx.x; L < nwg; L += gridDim.x) {
        int wgid = L;
        { const int q = nwg / 8, r = nwg % 8, xcd = wgid % 8, off = wgid / 8; wgid = (xcd < r ? xcd * (q + 1) : r * (q + 1) + (xcd - r) * q) + off; }
        const int nig = 8 * nN, gid = wgid / nig, fm = gid * 8, gsz = (nM - fm) < 8 ? (nM - fm) : 8;
        const int pm = fm + ((wgid % nig) % gsz), pn = (wgid % nig) / gsz;
        tc.brow = pm * 256; tc.bcol = pn * 256; tc.pn = pn;
        if (pn < 2) gemm_tile<EpiIn<0>>(A, Bt, DM, tc, shm, p);
        else if (pn == 2) gemm_tile<EpiIn<1>>(A, Bt, DM, tc, shm, p);
        else if (pn < 5) gemm_tile<EpiIn<2>>(A, Bt, DM, tc, shm, p);
        else gemm_tile<EpiIn<3>>(A, Bt, DM, tc, shm, p);
    }
}

DI void attn_unit(const Params& p, int b, int kvh, int qb, bool isctx, ldsp_t smem) {
    int tid = threadIdx.x;
    asm volatile("" : "+v"(tid));
    const int wid = tid >> 6, lane = tid & 63, r = lane & 31, hh = lane >> 5;
    const int head = kvh * 4 + (wid >> 1);
    const int t0 = qb * 64 + (wid & 1) * 32;
    const int nkeys = isctx ? CTXL : NKEY;
    const bf16_t* Qp = isctx ? p.Qc + ((size_t)(b * 8 + head) * CTXL + t0) * 64 : p.Q + ((size_t)(b * 8 + head) * SEQ + t0) * 64;
    const bf16_t* Kp = p.K + (size_t)(b * 2 + kvh) * NKEY * 64;
    const bf16_t* Vp = p.Vt + (size_t)(b * 2 + kvh) * 64 * NKEY;
    const int orow = isctx ? NLAT + b * CTXL + t0 : b * SEQ + t0;
    bf16_t* Op = p.MIX + (size_t)orow * DM + head * 64;

    bf16x8 qf[4];
#pragma unroll
    for (int ks = 0; ks < 4; ++ks) qf[ks] = *(const bf16x8*)(Qp + (size_t)r * 64 + ks * 16 + 8 * hh);
    f32x16 o[2];
#pragma unroll
    for (int i = 0; i < 16; ++i) { o[0][i] = 0.f; o[1][i] = 0.f; }
    float mrun = -1e30f, lrun = 0.f;

    const int srow = tid >> 3, sch = tid & 7;
    const int sw = (srow >> 1) & 7;
    const int kdst = srow * 128 + ((sch ^ sw) << 4);
    const bool vswap = (srow >> 4) & 1;
    const bf16_t* kg = Kp + (size_t)srow * 64 + sch * 8;
    const bf16_t* vg = Vp + (size_t)srow * NKEY + sch * 8;
    const int rsw = (r >> 1) & 7, rh = (r >> 4) & 1;
    const int ntile = nkeys / 64;

    u32x4 kst = *(const u32x4*)kg, vst = *(const u32x4*)vg;
    {
        *(LDSP u32x4*)(smem + kdst) = kst;
        if (vswap) vst = (u32x4){vst[2], vst[3], vst[0], vst[1]};
        *(LDSP u32x4*)(smem + 8192 + kdst) = vst;
    }
    for (int t = 0; t < ntile; ++t) {
        const int cur = t & 1;
        __syncthreads();
        if (t + 1 < ntile) { kst = *(const u32x4*)(kg + (size_t)(t + 1) * 64 * 64); vst = *(const u32x4*)(vg + (t + 1) * 64); }
        ldsp_t kb = smem + cur * 16384, vb = kb + 8192;
        f32x16 s[2];
#pragma unroll
        for (int kt = 0; kt < 2; ++kt) {
#pragma unroll
            for (int i = 0; i < 16; ++i) s[kt][i] = 0.f;
#pragma unroll
            for (int ks = 0; ks < 4; ++ks) {
                const bf16x8 a = *(const LDSP bf16x8*)(kb + (kt * 32 + r) * 128 + (((ks * 2 + hh) ^ rsw) << 4));
                s[kt] = __builtin_amdgcn_mfma_f32_32x32x16_bf16(a, qf[ks], s[kt], 0, 0, 0);
            }
        }
        float mx = s[0][0];
#pragma unroll
        for (int kt = 0; kt < 2; ++kt)
#pragma unroll
            for (int i = 0; i < 16; ++i) mx = fmaxf(mx, s[kt][i]);
        mx = fmaxf(mx, __shfl_xor(mx, 32));
        const float mnew = fmaxf(mrun, mx * LOG2E);
        const float alpha = fexp2(mrun - mnew);
        mrun = mnew;
        float rs = 0.f;
#pragma unroll
        for (int kt = 0; kt < 2; ++kt)
#pragma unroll
            for (int i = 0; i < 16; ++i) { const float pv = fexp2(s[kt][i] * LOG2E - mnew); rs += pv; s[kt][i] = pv; }
        lrun = lrun * alpha + rs;
#pragma unroll
        for (int i = 0; i < 16; ++i) { o[0][i] *= alpha; o[1][i] *= alpha; }
#pragma unroll
        for (int kt = 0; kt < 2; ++kt)
#pragma unroll
            for (int s2 = 0; s2 < 2; ++s2) {
                u32x4 pw;
                pw[0] = pk2(s[kt][8 * s2 + 0], s[kt][8 * s2 + 1]); pw[1] = pk2(s[kt][8 * s2 + 2], s[kt][8 * s2 + 3]);
                pw[2] = pk2(s[kt][8 * s2 + 4], s[kt][8 * s2 + 5]); pw[3] = pk2(s[kt][8 * s2 + 6], s[kt][8 * s2 + 7]);
                const bf16x8 pb = __builtin_bit_cast(bf16x8, pw);
#pragma unroll
                for (int dt = 0; dt < 2; ++dt) {
                    const int rowoff = (dt * 32 + r) * 128, hoff = (hh ^ rh) << 3;
                    const u32x2 lo = *(const LDSP u32x2*)(vb + rowoff + (((kt * 4 + s2 * 2) ^ rsw) << 4) + hoff);
                    const u32x2 hi = *(const LDSP u32x2*)(vb + rowoff + (((kt * 4 + s2 * 2 + 1) ^ rsw) << 4) + hoff);
                    const u32x4 va = {lo[0], lo[1], hi[0], hi[1]};
                    o[dt] = __builtin_amdgcn_mfma_f32_32x32x16_bf16(__builtin_bit_cast(bf16x8, va), pb, o[dt], 0, 0, 0);
                }
            }
        if (t + 1 < ntile) {
            ldsp_t nb = smem + (cur ^ 1) * 16384;
            *(LDSP u32x4*)(nb + kdst) = kst;
            if (vswap) vst = (u32x4){vst[2], vst[3], vst[0], vst[1]};
            *(LDSP u32x4*)(nb + 8192 + kdst) = vst;
        }
    }
    const float ltot = lrun + __shfl_xor(lrun, 32);
    const float inv = 1.f / ltot;
#pragma unroll
    for (int dt = 0; dt < 2; ++dt)
#pragma unroll
        for (int g4 = 0; g4 < 4; ++g4) {
            u32x2 w; w[0] = pk2(o[dt][4 * g4 + 0] * inv, o[dt][4 * g4 + 1] * inv); w[1] = pk2(o[dt][4 * g4 + 2] * inv, o[dt][4 * g4 + 3] * inv);
            *(u32x2*)(Op + (size_t)r * DM + dt * 32 + 8 * g4 + 4 * hh) = w;
        }
    __syncthreads();
}

DI void gmlp_unit(const Params& p, int l, int T, int g) {
    int tid = threadIdx.x;
    asm volatile("" : "+v"(tid));
    const int wid = tid >> 6, lane = tid & 63, fr = lane & 15, fq = lane >> 4;
    const int prow = wid * 16 + fr;
    const bf16_t* wsp = p.ws_bf + ((size_t)(l * 4 + g) * 128 + prow) * 128 + fq * 8;
    bf16x8 a[4];
#pragma unroll
    for (int ks = 0; ks < 4; ++ks) a[ks] = *(const bf16x8*)(wsp + ks * 32);
    const bf16_t* gt = p.GT + ((size_t)(T * 4 + g) * 128 + fr) * 128 + fq * 8;
    f32x4 acc[8];
#pragma unroll
    for (int n = 0; n < 8; ++n) {
        acc[n] = (f32x4){0.f, 0.f, 0.f, 0.f};
#pragma unroll
        for (int ks = 0; ks < 4; ++ks) {
            const bf16x8 bq = *(const bf16x8*)(gt + (size_t)n * 16 * 128 + ks * 32);
            acc[n] = __builtin_amdgcn_mfma_f32_16x16x32_bf16(bq, a[ks], acc[n], 0, 0, 0);
        }
    }
    const float bs = p.b_spatial[(size_t)(l * 4 + g) * 128 + prow];
    const int row = T * 128 + prow;
    const bf16_t* up = p.U + (size_t)row * 512 + g * 128 + fq * 4;
    bf16_t* mp = p.MIX + (size_t)row * DM + 512 + g * 128 + fq * 4;
#pragma unroll
    for (int n = 0; n < 8; ++n) {
        const u32x2 uu = *(const u32x2*)(up + n * 16);
        const float u0 = __uint_as_float(uu[0] << 16), u1 = __uint_as_float(uu[0] & 0xffff0000u), u2 = __uint_as_float(uu[1] << 16), u3 = __uint_as_float(uu[1] & 0xffff0000u);
        u32x2 w; w[0] = pk2((acc[n][0] + bs) * u0, (acc[n][1] + bs) * u1); w[1] = pk2((acc[n][2] + bs) * u2, (acc[n][3] + bs) * u3);
        *(u32x2*)(mp + n * 16) = w;
    }
}

DI void mixer_phase(const Params& p, int l, ldsp_t smem) {
    const bool last = l == DEPTH - 1;
    for (int u = blockIdx.x; u < 512; u += gridDim.x) attn_unit(p, (u & 7) >> 1, u & 1, u >> 3, false, smem);
    if (!last)
        for (int u = blockIdx.x; u < 32; u += gridDim.x) attn_unit(p, (u & 7) >> 1, u & 1, u >> 3, true, smem);
    const int nT = last ? 128 : 136;
    for (int u = blockIdx.x; u < nT * 4; u += gridDim.x) gmlp_unit(p, l, u >> 2, u & 3);
}

constexpr int N_PHASES = 1 + DEPTH * 7;
DI void run_phase(const Params& p, int ph, ldsp_t smem) {
    if (ph == 0) { phase0(p, smem); return; }
    const int l = (ph - 1) / 7, k = (ph - 1) % 7;
    const bool last = l == DEPTH - 1;
    const int Mx = last ? NLAT : NTOK;
    switch (k) {
        case 0: norm_phase(p, l, 1); break;
        case 1: inproj_phase(p, l, smem); break;
        case 2: mixer_phase(p, l, smem); break;
        case 3: gemm_phase<EpiResid<2>>(p, l, p.MIX, p.wt_out + (size_t)l * DM * DM, Mx, DM, DM, smem); break;
        case 4: norm_phase(p, l, 2); break;
        case 5: gemm_phase<EpiFF1>(p, l, p.H, p.wt_ff1 + (size_t)l * FF * DM, Mx, FF, DM, smem); break;
        default: gemm_phase<EpiResid<5>>(p, l, p.ACT, p.wt_ff2 + (size_t)l * DM * FF, Mx, DM, FF, smem); break;
    }
}

template <bool COOP>
__global__ void __launch_bounds__(512) mk_kernel(Params p, int ph_lo, int ph_hi) {
    __shared__ __attribute__((aligned(1024))) char smem_raw[2 * G_STAGE_B];
    ldsp_t smem = (ldsp_t)smem_raw;
    for (int ph = ph_lo; ph < ph_hi; ++ph) {
        run_phase(p, ph, smem);
        if (COOP && ph + 1 < ph_hi) cg::this_grid().sync();
    }
}

extern "C" void kernel_launch(void* const* d_in, const int* in_sizes, int n_in, void* d_out, int out_size, void* d_ws, size_t ws_size, hipStream_t stream) {
    Params p{};
    p.x = (const float*)d_in[0]; p.c = (const float*)d_in[1]; p.ctx = (const float*)d_in[2]; p.c_ctx = (const float*)d_in[3];
    p.w_mod = (const float*)d_in[4]; p.b_mod = (const float*)d_in[5]; p.norm1_g = (const float*)d_in[6]; p.w_in = (const float*)d_in[7];
    p.q_norm_g = (const float*)d_in[8]; p.k_norm_g = (const float*)d_in[9]; p.gmlp_norm_g = (const float*)d_in[10]; p.w_spatial = (const float*)d_in[11];
    p.b_spatial = (const float*)d_in[12]; p.w_out = (const float*)d_in[13]; p.norm2_g = (const float*)d_in[14]; p.w_ff1 = (const float*)d_in[15]; p.w_ff2 = (const float*)d_in[16];
    p.out = (float*)d_out;
    char* w = (char*)d_ws; size_t off = 0;
    auto take = [&](size_t bytes) { char* r = w + off; off += (bytes + 1023) & ~(size_t)1023; return r; };
    p.wt_in = (bf16_t*)take((size_t)DEPTH * IN_DIM * DM * 2);
    p.wt_out = (bf16_t*)take((size_t)DEPTH * DM * DM * 2);
    p.wt_ff1 = (bf16_t*)take((size_t)DEPTH * FF * DM * 2);
    p.wt_ff2 = (bf16_t*)take((size_t)DEPTH * FF * DM * 2);
    p.ws_bf = (bf16_t*)take((size_t)DEPTH * 4 * 128 * 128 * 2);
    p.mod = (float*)take((size_t)DEPTH * 5 * 6144 * 4);
    p.rope = (float*)take(2048 * 4);
    p.xc = (float*)take((size_t)NCTX * DM * 4);
    p.H = (bf16_t*)take((size_t)NTOK * DM * 2);
    p.ACT = (bf16_t*)take((size_t)NTOK * FF * 2);
    {
        char* a = (char*)p.ACT; size_t o2 = 0;
        auto take2 = [&](size_t bytes) { char* r = a + o2; o2 += (bytes + 1023) & ~(size_t)1023; return r; };
        p.Q = (bf16_t*)take2((size_t)NLAT * 512 * 2);
        p.Qc = (bf16_t*)take2((size_t)NCTX * 512 * 2);
        p.K = (bf16_t*)take2((size_t)NB * 2 * NKEY * 64 * 2);
        p.Vt = (bf16_t*)take2((size_t)NB * 2 * NKEY * 64 * 2);
        p.U = (bf16_t*)take2((size_t)NTOK * 512 * 2);
        p.GT = (bf16_t*)take2((size_t)NTOK * 512 * 2);
        p.MIX = (bf16_t*)take2((size_t)NTOK * DM * 2);
    }
    if (off > ws_size) { fprintf(stderr, "workspace too small: need %zu have %zu\n", off, ws_size); return; }
#if MK_COOP
    static int grid_blocks = 0;
    if (!grid_blocks) {
        int dev = 0, cus = 0, per_cu = 0;
        hipGetDevice(&dev);
        hipDeviceGetAttribute(&cus, hipDeviceAttributeMultiprocessorCount, dev);
        hipOccupancyMaxActiveBlocksPerMultiprocessor(&per_cu, mk_kernel<true>, 512, 0);
        if (per_cu < 1) per_cu = 1;
        grid_blocks = cus * 1;
    }
    int lo = 0, hi = N_PHASES;
    void* args[] = {&p, &lo, &hi};
    hipError_t e = hipLaunchCooperativeKernel((void*)mk_kernel<true>, dim3(grid_blocks), dim3(512), args, 0, stream);
    if (e != hipSuccess) fprintf(stderr, "cooperative launch failed: %s (grid %d)\n", hipGetErrorString(e), grid_blocks);
#else
    for (int ph = 0; ph < N_PHASES; ++ph) mk_kernel<false><<<256, 512, 0, stream>>>(p, ph, ph + 1);
#endif
}
```

```cpp
#include <hip/hip_runtime.h>
#include <hip/hip_cooperative_groups.h>
#include <stdint.h>
#include <cstdio>
namespace cg = cooperative_groups;

#ifndef MK_COOP
#define MK_COOP 1
#endif

#define DI __device__ __forceinline__
#define LDSP __attribute__((address_space(3)))
typedef LDSP char* ldsp_t;
typedef unsigned short bf16_t;
typedef short bf16x8 __attribute__((ext_vector_type(8)));
typedef float f32x2 __attribute__((ext_vector_type(2)));
typedef float f32x4 __attribute__((ext_vector_type(4)));
typedef float f32x16 __attribute__((ext_vector_type(16)));
typedef unsigned u32x2 __attribute__((ext_vector_type(2)));
typedef unsigned u32x4 __attribute__((ext_vector_type(4)));
typedef __bf16 bf2_t __attribute__((ext_vector_type(2)));

constexpr int DM = 1024, NB = 4, SEQ = 4096, DEPTH = 4, CTXL = 256;
constexpr int NLAT = NB * SEQ;
constexpr int NCTX = NB * CTXL;
constexpr int NTOK = NLAT + NCTX;
constexpr int IN_DIM = 1792, FF = 4096, NKEY = CTXL + SEQ;
constexpr float EPS = 1e-6f;
constexpr float LOG2E = 1.4426950408889634f;

struct Params {
    const float *x, *c, *ctx, *c_ctx, *w_mod, *b_mod, *norm1_g, *w_in, *q_norm_g, *k_norm_g, *gmlp_norm_g, *w_spatial, *b_spatial, *w_out, *norm2_g, *w_ff1, *w_ff2;
    float* out;
    bf16_t *wt_in, *wt_out, *wt_ff1, *wt_ff2, *ws_bf;
    float *mod, *rope, *xc;
    bf16_t *H, *Q, *Qc, *K, *Vt, *U, *MIX, *ACT;
};

DI unsigned pk2(float a, float b) { f32x2 v = {a, b}; bf2_t r = __builtin_convertvector(v, bf2_t); return __builtin_bit_cast(unsigned, r); }
DI bf16_t f2bf(float a) { return (bf16_t)(pk2(a, 0.f) & 0xffffu); }
DI float fexp2(float x) { return __builtin_amdgcn_exp2f(x); }
DI float gelu_tanh(float x) {
    const float y = 0.7978845608028654f * (x + 0.044715f * x * x * x);
    return x / (1.f + fexp2(-2.f * LOG2E * y));
}
DI float* xrow_ptr(const Params& p, int row) { return row < NLAT ? p.out + (size_t)row * DM : p.xc + (size_t)(row - NLAT) * DM; }

DI void transpose_tile(const float* __restrict__ src, bf16_t* __restrict__ dst, int K, int N, int tk, int tn, ldsp_t smem) {
    LDSP float* t = (LDSP float*)smem;
    const int tid = threadIdx.x, k0 = tk * 64, n0 = tn * 64;
#pragma unroll
    for (int i = 0; i < 2; ++i) {
        const int k = (tid >> 4) + 32 * i, n4 = (tid & 15) * 4;
        const f32x4 v = *(const f32x4*)(src + (size_t)(k0 + k) * N + n0 + n4);
        t[k * 65 + n4 + 0] = v[0]; t[k * 65 + n4 + 1] = v[1]; t[k * 65 + n4 + 2] = v[2]; t[k * 65 + n4 + 3] = v[3];
    }
    __syncthreads();
    {
        const int n = tid >> 3, k8 = (tid & 7) * 8;
        u32x4 w;
        w[0] = pk2(t[(k8 + 0) * 65 + n], t[(k8 + 1) * 65 + n]);
        w[1] = pk2(t[(k8 + 2) * 65 + n], t[(k8 + 3) * 65 + n]);
        w[2] = pk2(t[(k8 + 4) * 65 + n], t[(k8 + 5) * 65 + n]);
        w[3] = pk2(t[(k8 + 6) * 65 + n], t[(k8 + 7) * 65 + n]);
        *(u32x4*)(dst + (size_t)(n0 + n) * K + k0 + k8) = w;
    }
    __syncthreads();
}

DI void mod_unit(const Params& p, int l, int cgi, ldsp_t smem) {
    LDSP float* s = (LDSP float*)smem;
    LDSP float* red = (LDSP float*)(smem + 20480);
    const int tid = threadIdx.x;
    for (int i = tid; i < 5 * 1024; i += 512) {
        const int cnd = i >> 10, k = i & 1023;
        const float v = cnd < 4 ? p.c[cnd * 1024 + k] : p.c_ctx[k];
        s[i] = v / (1.f + fexp2(-LOG2E * v));
    }
    __syncthreads();
    const int c4 = tid & 15, ks = tid >> 4;
    f32x4 acc[5];
#pragma unroll
    for (int q = 0; q < 5; ++q) acc[q] = (f32x4){0.f, 0.f, 0.f, 0.f};
    const float* wp = p.w_mod + ((size_t)l * 1024 + ks * 32) * 6144 + cgi * 64 + c4 * 4;
#pragma unroll 4
    for (int kk = 0; kk < 32; ++kk) {
        const f32x4 w = *(const f32x4*)(wp + (size_t)kk * 6144);
        const int k = ks * 32 + kk;
#pragma unroll
        for (int q = 0; q < 5; ++q) acc[q] += w * s[q * 1024 + k];
    }
#pragma unroll
    for (int q = 0; q < 5; ++q)
#pragma unroll
        for (int j = 0; j < 4; ++j) red[(ks * 5 + q) * 64 + c4 * 4 + j] = acc[q][j];
    __syncthreads();
    if (tid < 320) {
        const int q = tid >> 6, col = tid & 63;
        float a = 0.f;
        for (int k2 = 0; k2 < 32; ++k2) a += red[(k2 * 5 + q) * 64 + col];
        const int j = cgi * 64 + col;
        p.mod[((size_t)l * 5 + q) * 6144 + j] = a + p.b_mod[(size_t)l * 6144 + j];
    }
    __syncthreads();
}

DI void phase0(const Params& p, ldsp_t smem) {
    constexpr int T_IN = 16 * 28, T_OUT = 16 * 16, T_FF1 = 16 * 64, T_FF2 = 64 * 16;
    constexpr int T_L = T_IN + T_OUT + T_FF1 + T_FF2;
    constexpr int U_T = DEPTH * T_L;
    constexpr int U_MOD = DEPTH * 96;
    constexpr int U_WS = 64;
    constexpr int U_ALL = U_MOD + U_T + U_WS + 1;
    for (int u = blockIdx.x; u < U_ALL; u += gridDim.x) {
        if (u < U_MOD) { mod_unit(p, u / 96, u % 96, smem); continue; }
        int v = u - U_MOD;
        if (v < U_T) {
            const int l = v / T_L; int r = v % T_L;
            if (r < T_IN) { transpose_tile(p.w_in + (size_t)l * DM * IN_DIM, p.wt_in + (size_t)l * IN_DIM * DM, DM, IN_DIM, r / 28, r % 28, smem); continue; }
            r -= T_IN;
            if (r < T_OUT) { transpose_tile(p.w_out + (size_t)l * DM * DM, p.wt_out + (size_t)l * DM * DM, DM, DM, r / 16, r % 16, smem); continue; }
            r -= T_OUT;
            if (r < T_FF1) { transpose_tile(p.w_ff1 + (size_t)l * DM * FF, p.wt_ff1 + (size_t)l * FF * DM, DM, FF, r / 64, r % 64, smem); continue; }
            r -= T_FF1;
            transpose_tile(p.w_ff2 + (size_t)l * FF * DM, p.wt_ff2 + (size_t)l * DM * FF, FF, DM, r / 16, r % 16, smem); continue;
        }
        v -= U_T;
        if (v < U_WS) {
            const size_t i = ((size_t)v * 512 + threadIdx.x) * 8;
            const f32x4 a = *(const f32x4*)(p.w_spatial + i), b = *(const f32x4*)(p.w_spatial + i + 4);
            u32x4 w; w[0] = pk2(a[0], a[1]); w[1] = pk2(a[2], a[3]); w[2] = pk2(b[0], b[1]); w[3] = pk2(b[2], b[3]);
            *(u32x4*)(p.ws_bf + i) = w;
            continue;
        }
        for (int i = threadIdx.x; i < 1024; i += 512) {
            const int pos = i >> 4, f = i & 15;
            const float inv = fexp2(-(float)f * (13.287712379549449f / 16.f));
            const float rev = (float)pos * inv * 0.15915494309189535f;
            p.rope[i] = __builtin_amdgcn_cosf(rev);
            p.rope[1024 + i] = __builtin_amdgcn_sinf(rev);
        }
    }
}

DI void norm_phase(const Params& p, int l, int which) {
    const int lane = threadIdx.x & 63, wid = threadIdx.x >> 6;
    const float* g = (which == 1 ? p.norm1_g : p.norm2_g) + (size_t)l * DM;
    const int si = which == 1 ? 0 : 3;
    const int M = (which == 2 && l == DEPTH - 1) ? NLAT : NTOK;
    const bool first = (which == 1 && l == 0);
    for (int row = blockIdx.x * 8 + wid; row < M; row += gridDim.x * 8) {
        const float* src;
        if (first) src = row < NLAT ? p.x + (size_t)row * DM : p.ctx + (size_t)(row - NLAT) * DM;
        else src = xrow_ptr(p, row);
        const int cond = row < NLAT ? (row >> 12) : 4;
        const float* mp = p.mod + ((size_t)l * 5 + cond) * 6144;
        f32x4 v[4];
        float ss = 0.f;
#pragma unroll
        for (int i = 0; i < 4; ++i) { v[i] = *(const f32x4*)(src + i * 256 + lane * 4); ss += v[i][0] * v[i][0] + v[i][1] * v[i][1] + v[i][2] * v[i][2] + v[i][3] * v[i][3]; }
#pragma unroll
        for (int o = 1; o < 64; o <<= 1) ss += __shfl_xor(ss, o);
        const float rstd = rsqrtf(ss * (1.f / DM) + EPS);
        bf16_t* hp = p.H + (size_t)row * DM;
        float* xw = first ? xrow_ptr(p, row) : nullptr;
#pragma unroll
        for (int i = 0; i < 4; ++i) {
            const int idx = i * 256 + lane * 4;
            const f32x4 gg = *(const f32x4*)(g + idx), sh = *(const f32x4*)(mp + si * DM + idx), sc = *(const f32x4*)(mp + (si + 1) * DM + idx);
            f32x4 y;
#pragma unroll
            for (int j = 0; j < 4; ++j) y[j] = v[i][j] * rstd * gg[j] * (1.f + sc[j]) + sh[j];
            u32x2 w; w[0] = pk2(y[0], y[1]); w[1] = pk2(y[2], y[3]);
            *(u32x2*)(hp + idx) = w;
            if (first) *(f32x4*)(xw + idx) = v[i];
        }
    }
}

constexpr int G_TILE_B = 256 * 64 * 2, G_STAGE_B = 2 * G_TILE_B;
DI int lds_byte2(int r, int c) {
    const int st = (r >> 4) * 2 + (c >> 5), ob = (r & 15) * 64 + (c & 31) * 2;
    return st * 1024 + (ob ^ (((ob >> 9) & 1) << 5));
}
DI void stage_rc2(int b, int& R, int& C) {
    const int st = b >> 10, sb = b & 1023, swz = sb ^ (((sb >> 9) & 1) << 5);
    R = (st >> 1) * 16 + swz / 64;
    C = (st & 1) * 32 + (swz % 64) / 2;
}
#define WAIT_V0() asm volatile("s_waitcnt vmcnt(0)" ::: "memory")

struct TileCtx { int brow, bcol, pn, wr, wc, fr, fq, wid, lane, l; };

DI void tile_coords(int L, int nM, int nN, int& pm, int& pn) {
    const int nwg = nM * nN;
    int wgid = L;
    { const int q = nwg / 8, r = nwg % 8, xcd = wgid % 8, off = wgid / 8; wgid = (xcd < r ? xcd * (q + 1) : r * (q + 1) + (xcd - r) * q) + off; }
    const int nig = 8 * nN, gid = wgid / nig, fm = gid * 8, gsz = (nM - fm) < 8 ? (nM - fm) : 8;
    pm = fm + ((wgid % nig) % gsz); pn = (wgid % nig) / gsz;
}

template <int GI> struct EpiResid {
    static DI void run(const f32x4 (&acc)[8][4], const TileCtx& tc, const Params& p, ldsp_t) {
        const int cond = tc.brow < NLAT ? (tc.brow >> 12) : 4;
        const float* gate = p.mod + ((size_t)tc.l * 5 + cond) * 6144 + GI * DM;
        const int col0 = tc.bcol + tc.wc * 64 + tc.fq * 4;
        f32x4 gv[4];
#pragma unroll
        for (int n = 0; n < 4; ++n) gv[n] = *(const f32x4*)(gate + col0 + n * 16);
#pragma unroll
        for (int m = 0; m < 8; ++m) { __builtin_amdgcn_sched_barrier(0);
            const int row = tc.brow + tc.wr * 128 + m * 16 + tc.fr;
            float* xr = xrow_ptr(p, row) + col0;
#pragma unroll
            for (int n = 0; n < 4; ++n) {
                f32x4 xv = *(const f32x4*)(xr + n * 16);
                xv += gv[n] * acc[m][n];
                *(f32x4*)(xr + n * 16) = xv;
            }
        }
    }
};
struct EpiFF1 {
    static DI void run(const f32x4 (&acc)[8][4], const TileCtx& tc, const Params& p, ldsp_t) {
        const int col0 = tc.bcol + tc.wc * 64 + tc.fq * 4;
#pragma unroll
        for (int m = 0; m < 8; ++m) { __builtin_amdgcn_sched_barrier(0);
            const int row = tc.brow + tc.wr * 128 + m * 16 + tc.fr;
            bf16_t* ar = p.ACT + (size_t)row * FF + col0;
#pragma unroll
            for (int n = 0; n < 4; ++n) {
                f32x4 a = acc[m][n];
#pragma unroll
                for (int j = 0; j < 4; ++j) { const float r = fmaxf(a[j], 0.f); a[j] = r * r; }
                u32x2 w; w[0] = pk2(a[0], a[1]); w[1] = pk2(a[2], a[3]);
                *(u32x2*)(ar + n * 16) = w;
            }
        }
    }
};
template <int BRK> struct EpiIn {
    static DI void run(const f32x4 (&acc)[8][4], const TileCtx& tc, const Params& p, ldsp_t shm) {
        const int l = tc.l, pn = tc.pn, wc = tc.wc, fr = tc.fr, fq = tc.fq;
        if (BRK == 0 || (BRK == 1 && wc < 2)) {
            constexpr bool isq = BRK == 0;
            const int head = isq ? pn * 4 + wc : wc;
            const float* gn = (isq ? p.q_norm_g : p.k_norm_g) + l * 64;
            f32x4 gv[4];
#pragma unroll
            for (int n = 0; n < 4; ++n) gv[n] = *(const f32x4*)(gn + n * 16 + fq * 4);
            const float osc = isq ? 0.125f : 1.f;
            const bool lat = tc.brow < NLAT;
#pragma unroll
            for (int m = 0; m < 8; ++m) { __builtin_amdgcn_sched_barrier(0);
                const int row = tc.brow + tc.wr * 128 + m * 16 + fr;
                float ss = 0.f;
#pragma unroll
                for (int n = 0; n < 4; ++n)
#pragma unroll
                    for (int j = 0; j < 4; ++j) ss += acc[m][n][j] * acc[m][n][j];
                ss += __shfl_xor(ss, 16);
                ss += __shfl_xor(ss, 32);
                const float rstd = rsqrtf(ss * (1.f / 64.f) + EPS) * osc;
                bf16_t* dst;
                int t = 0;
                if (lat) {
                    const int b = row >> 12; t = row & 4095;
                    dst = isq ? p.Q + ((size_t)(b * 8 + head) * SEQ + t) * 64 : p.K + ((size_t)(b * 2 + head) * NKEY + CTXL + t) * 64;
                } else {
                    const int r2 = row - NLAT, b = r2 >> 8, tt = r2 & 255;
                    dst = isq ? p.Qc + ((size_t)(b * 8 + head) * CTXL + tt) * 64 : p.K + ((size_t)(b * 2 + head) * NKEY + tt) * 64;
                }
#pragma unroll
                for (int ax = 0; ax < 2; ++ax) {
                    f32x4 x1 = acc[m][2 * ax] * rstd * gv[2 * ax], x2 = acc[m][2 * ax + 1] * rstd * gv[2 * ax + 1];
                    if (lat) {
                        const int pos = ax == 0 ? (t >> 6) : (t & 63);
                        const f32x4 cs = *(const f32x4*)(p.rope + pos * 16 + fq * 4), sn = *(const f32x4*)(p.rope + 1024 + pos * 16 + fq * 4);
                        const f32x4 o1 = x1 * cs - x2 * sn, o2 = x2 * cs + x1 * sn;
                        x1 = o1; x2 = o2;
                    }
                    u32x2 w; w[0] = pk2(x1[0], x1[1]); w[1] = pk2(x1[2], x1[3]);
                    *(u32x2*)(dst + (2 * ax) * 16 + fq * 4) = w;
                    w[0] = pk2(x2[0], x2[1]); w[1] = pk2(x2[2], x2[3]);
                    *(u32x2*)(dst + (2 * ax + 1) * 16 + fq * 4) = w;
                }
            }
        } else if (BRK == 1) {
            const int kvh = wc - 2;
#pragma unroll
            for (int m = 0; m < 8; ++m) { __builtin_amdgcn_sched_barrier(0);
                const int row = tc.brow + tc.wr * 128 + m * 16 + fr;
                int b, pos;
                if (row < NLAT) { b = row >> 12; pos = CTXL + (row & 4095); } else { const int r2 = row - NLAT; b = r2 >> 8; pos = r2 & 255; }
                bf16_t* dst = p.Vt + (size_t)(b * 2 + kvh) * 64 * NKEY + pos;
#pragma unroll
                for (int n = 0; n < 4; ++n)
#pragma unroll
                    for (int j = 0; j < 4; ++j) dst[(size_t)(n * 16 + fq * 4 + j) * NKEY] = f2bf(acc[m][n][j]);
            }
        } else if (BRK == 2) {
            const int ucol = (pn - 3) * 256 + wc * 64 + fq * 4;
#pragma unroll
            for (int m = 0; m < 8; ++m) { __builtin_amdgcn_sched_barrier(0);
                const int row = tc.brow + tc.wr * 128 + m * 16 + fr;
                bf16_t* dst = p.U + (size_t)row * 1024 + ucol;
#pragma unroll
                for (int n = 0; n < 4; ++n) {
                    u32x2 w; w[0] = pk2(gelu_tanh(acc[m][n][0]), gelu_tanh(acc[m][n][1])); w[1] = pk2(gelu_tanh(acc[m][n][2]), gelu_tanh(acc[m][n][3]));
                    *(u32x2*)(dst + n * 16) = w;
                }
            }
        }
    }
};

template <int EK>
DI void gemm_stream(const Params& p, int l, const bf16_t* __restrict__ A, const bf16_t* __restrict__ Bt, int M, int N, int K, ldsp_t shm) {
    const int nM = M / 256, nN = N / 256, nwg = nM * nN;
    int L = blockIdx.x;
    if (L >= nwg) return;
#define G_SA(b) (shm + (b) * G_STAGE_B)
#define G_SB(b) (shm + (b) * G_STAGE_B + G_TILE_B)
#define G_LANE_SETUP() \
    int tid_ = threadIdx.x; \
    asm volatile("" : "+v"(tid_));    \
    const int wid = tid_ >> 6, lane = tid_ & 63, wr = wid >> 2, wc = wid & 3, fr = lane & 15, fq = lane >> 4; \
    unsigned soff[4];        \
    _Pragma("unroll") for (int i = 0; i < 4; ++i) { int sR, sC; stage_rc2(wid * 1024 + i * 8192 + lane * 16, sR, sC); soff[i] = (unsigned)(sR * K + sC) * 2u; }
#define G_STAGE(Ap, Bp, buf, kt) do { const char* ab_ = (const char*)(Ap) + (size_t)(kt) * 128; const char* bb_ = (const char*)(Bp) + (size_t)(kt) * 128; \
      _Pragma("unroll") for (int i = 0; i < 4; ++i) { \
        __builtin_amdgcn_global_load_lds((const unsigned*)(ab_ + soff[i]), (LDSP unsigned*)(G_SA(buf) + wid * 1024 + i * 8192), 16, 0, 0); \
        __builtin_amdgcn_global_load_lds((const unsigned*)(bb_ + soff[i]), (LDSP unsigned*)(G_SB(buf) + wid * 1024 + i * 8192), 16, 0, 0); } } while (0)
    const int nt = K / 64;
    int pm, pn;
    tile_coords(L, nM, nN, pm, pn);
    const bf16_t* Ab = A + (size_t)pm * 256 * K;
    const bf16_t* Bb = Bt + (size_t)pn * 256 * K;
    { G_LANE_SETUP(); (void)wr; (void)wc; (void)fr; (void)fq; G_STAGE(Ab, Bb, 0, 0); WAIT_V0(); __syncthreads(); }
    while (true) {
        G_LANE_SETUP();
        f32x4 acc[8][4];
#pragma unroll
        for (int m = 0; m < 8; ++m)
#pragma unroll
            for (int n = 0; n < 4; ++n) acc[m][n] = (f32x4){0.f, 0.f, 0.f, 0.f};
        const int Ln = L + gridDim.x;
        const bool has_next = Ln < nwg;
        int pm2 = pm, pn2 = pn;
        if (has_next) tile_coords(Ln, nM, nN, pm2, pn2);
        const bf16_t* Ab2 = A + (size_t)pm2 * 256 * K;
        const bf16_t* Bb2 = Bt + (size_t)pn2 * 256 * K;
        for (int t = 0; t < nt; ++t) {
            const int cur = t & 1;
            if (t + 1 < nt) G_STAGE(Ab, Bb, cur ^ 1, t + 1);
            else if (has_next) G_STAGE(Ab2, Bb2, cur ^ 1, 0);
#pragma unroll
            for (int ks = 0; ks < 2; ++ks) {
                bf16x8 At[8], Bf[4];
#pragma unroll
                for (int m = 0; m < 8; ++m) At[m] = *(const LDSP bf16x8*)(G_SA(cur) + lds_byte2(wr * 128 + m * 16 + fr, ks * 32 + fq * 8));
#pragma unroll
                for (int n = 0; n < 4; ++n) Bf[n] = *(const LDSP bf16x8*)(G_SB(cur) + lds_byte2(wc * 64 + n * 16 + fr, ks * 32 + fq * 8));
#pragma unroll
                for (int m = 0; m < 8; ++m)
#pragma unroll
                    for (int n = 0; n < 4; ++n) acc[m][n] = __builtin_amdgcn_mfma_f32_16x16x32_bf16(Bf[n], At[m], acc[m][n], 0, 0, 0);
                __builtin_amdgcn_sched_barrier(0);
            }
            WAIT_V0(); __syncthreads();
        }
        {
            int tid2 = threadIdx.x, pme = pm, pne = pn;
            asm volatile("" : "+v"(tid2), "+s"(pme), "+s"(pne));
            TileCtx tc;
            tc.wid = tid2 >> 6; tc.lane = tid2 & 63; tc.wr = tc.wid >> 2; tc.wc = tc.wid & 3; tc.fr = tc.lane & 15; tc.fq = tc.lane >> 4; tc.l = l;
            tc.brow = pme * 256; tc.bcol = pne * 256; tc.pn = pne;
            ldsp_t ex = shm + 2 * G_STAGE_B;
            if (EK == 0) {
                if (pne < 2) EpiIn<0>::run(acc, tc, p, ex);
                else if (pne == 2) EpiIn<1>::run(acc, tc, p, ex);
                else EpiIn<2>::run(acc, tc, p, ex);
            } else if (EK == 1) EpiResid<2>::run(acc, tc, p, ex);
            else if (EK == 2) EpiFF1::run(acc, tc, p, ex);
            else EpiResid<5>::run(acc, tc, p, ex);
        }
        if (!has_next) break;
        L = Ln; pm = pm2; pn = pn2; Ab = Ab2; Bb = Bb2;
    }
}

template <int EK>
DI void ctx_small_tiles(const Params& p, int l, const bf16_t* __restrict__ A, const bf16_t* __restrict__ Bt, int N, int K, ldsp_t shm) {
    const int ntn = N / 64, ntiles = 16 * ntn;
    for (int u = blockIdx.x; u < ntiles; u += gridDim.x) {
        const int tm = u / ntn, tn = u % ntn;
        int tid = threadIdx.x;
        asm volatile("" : "+v"(tid));
        const int wid = tid >> 6, lane = tid & 63, fr = lane & 15, fq = lane >> 4;
        const int kw = K / 8;
        const bf16_t* ap = A + (size_t)(tm * 64 + fr) * K + wid * kw + fq * 8;
        const bf16_t* bp = Bt + (size_t)(tn * 64 + fr) * K + wid * kw + fq * 8;
        f32x4 acc[4][4];
#pragma unroll
        for (int m = 0; m < 4; ++m)
#pragma unroll
            for (int n = 0; n < 4; ++n) acc[m][n] = (f32x4){0.f, 0.f, 0.f, 0.f};
#pragma unroll 2
        for (int ks = 0; ks < kw / 32; ++ks) {
            bf16x8 a[4], b[4];
#pragma unroll
            for (int m = 0; m < 4; ++m) a[m] = *(const bf16x8*)(ap + (size_t)m * 16 * K + ks * 32);
#pragma unroll
            for (int n = 0; n < 4; ++n) b[n] = *(const bf16x8*)(bp + (size_t)n * 16 * K + ks * 32);
#pragma unroll
            for (int m = 0; m < 4; ++m)
#pragma unroll
                for (int n = 0; n < 4; ++n) acc[m][n] = __builtin_amdgcn_mfma_f32_16x16x32_bf16(b[n], a[m], acc[m][n], 0, 0, 0);
        }
#pragma unroll
        for (int m = 0; m < 4; ++m)
#pragma unroll
            for (int n = 0; n < 4; ++n) {
                const int row = m * 16 + fr, ch = (n * 4 + fq) ^ (row & 15);
                *(LDSP f32x4*)(shm + wid * 16384 + row * 256 + ch * 16) = acc[m][n];
            }
        __syncthreads();
        {
            const int row = tid >> 3, c8 = tid & 7;
            f32x4 s0 = {0.f, 0.f, 0.f, 0.f}, s1 = {0.f, 0.f, 0.f, 0.f};
#pragma unroll
            for (int w = 0; w < 8; ++w) {
                s0 += *(const LDSP f32x4*)(shm + w * 16384 + row * 256 + (((2 * c8) ^ (row & 15)) << 4));
                s1 += *(const LDSP f32x4*)(shm + w * 16384 + row * 256 + (((2 * c8 + 1) ^ (row & 15)) << 4));
            }
            const int grow = tm * 64 + row, gcol = tn * 64 + c8 * 8;
            if (EK == 2) {
#pragma unroll
                for (int j = 0; j < 4; ++j) { float r0 = fmaxf(s0[j], 0.f), r1 = fmaxf(s1[j], 0.f); s0[j] = r0 * r0; s1[j] = r1 * r1; }
                u32x4 w; w[0] = pk2(s0[0], s0[1]); w[1] = pk2(s0[2], s0[3]); w[2] = pk2(s1[0], s1[1]); w[3] = pk2(s1[2], s1[3]);
                *(u32x4*)(p.ACT + (size_t)(NLAT + grow) * FF + gcol) = w;
            } else {
                const float* gate = p.mod + ((size_t)l * 5 + 4) * 6144 + (EK == 1 ? 2 : 5) * DM + gcol;
                float* xr = p.xc + (size_t)grow * DM + gcol;
                const f32x4 g0 = *(const f32x4*)gate, g1 = *(const f32x4*)(gate + 4);
                f32x4 x0 = *(const f32x4*)xr, x1 = *(const f32x4*)(xr + 4);
                x0 += g0 * s0; x1 += g1 * s1;
                *(f32x4*)xr = x0; *(f32x4*)(xr + 4) = x1;
            }
        }
        __syncthreads();
    }
}

DI void attn_unit(const Params& p, int b, int kvh, int qb, bool isctx, ldsp_t smem) {
    int tid = threadIdx.x;
    asm volatile("" : "+v"(tid));
    const int wid = tid >> 6, lane = tid & 63, r = lane & 31, hh = lane >> 5;
    const int head = kvh * 4 + (wid >> 1);
    const int t0 = qb * 64 + (wid & 1) * 32;
    const int nkeys = isctx ? CTXL : NKEY;
    const bf16_t* Qp = isctx ? p.Qc + ((size_t)(b * 8 + head) * CTXL + t0) * 64 : p.Q + ((size_t)(b * 8 + head) * SEQ + t0) * 64;
    const bf16_t* Kp = p.K + (size_t)(b * 2 + kvh) * NKEY * 64;
    const bf16_t* Vp = p.Vt + (size_t)(b * 2 + kvh) * 64 * NKEY;
    const int orow = isctx ? NLAT + b * CTXL + t0 : b * SEQ + t0;
    bf16_t* Op = p.MIX + (size_t)orow * DM + head * 64;

    bf16x8 qf[4];
#pragma unroll
    for (int ks = 0; ks < 4; ++ks) qf[ks] = *(const bf16x8*)(Qp + (size_t)r * 64 + ks * 16 + 8 * hh);
    f32x16 o[2];
#pragma unroll
    for (int i = 0; i < 16; ++i) { o[0][i] = 0.f; o[1][i] = 0.f; }
    float mrun = -1e30f, lrun = 0.f;

    const int srow = tid >> 3, sch = tid & 7;
    const int sw = (srow >> 1) & 7;
    const int kdst = srow * 128 + ((sch ^ sw) << 4);
    const bool vswap = (srow >> 4) & 1;
    const bf16_t* kg = Kp + (size_t)srow * 64 + sch * 8;
    const bf16_t* vg = Vp + (size_t)srow * NKEY + sch * 8;
    const int rsw = (r >> 1) & 7, rh = (r >> 4) & 1;
    const int ntile = nkeys / 64;

    u32x4 kst = *(const u32x4*)kg, vst = *(const u32x4*)vg;
    {
        *(LDSP u32x4*)(smem + kdst) = kst;
        if (vswap) vst = (u32x4){vst[2], vst[3], vst[0], vst[1]};
        *(LDSP u32x4*)(smem + 8192 + kdst) = vst;
    }
    for (int t = 0; t < ntile; ++t) {
        const int cur = t & 1;
        __syncthreads();
        if (t + 1 < ntile) { kst = *(const u32x4*)(kg + (size_t)(t + 1) * 64 * 64); vst = *(const u32x4*)(vg + (t + 1) * 64); }
        ldsp_t kb = smem + cur * 16384, vb = kb + 8192;
        f32x16 s[2];
#pragma unroll
        for (int kt = 0; kt < 2; ++kt) {
#pragma unroll
            for (int i = 0; i < 16; ++i) s[kt][i] = 0.f;
#pragma unroll
            for (int ks = 0; ks < 4; ++ks) {
                const bf16x8 a = *(const LDSP bf16x8*)(kb + (kt * 32 + r) * 128 + (((ks * 2 + hh) ^ rsw) << 4));
                s[kt] = __builtin_amdgcn_mfma_f32_32x32x16_bf16(a, qf[ks], s[kt], 0, 0, 0);
            }
        }
        float mx = s[0][0];
#pragma unroll
        for (int kt = 0; kt < 2; ++kt)
#pragma unroll
            for (int i = 0; i < 16; ++i) mx = fmaxf(mx, s[kt][i]);
        mx = fmaxf(mx, __shfl_xor(mx, 32));
        const float mnew = fmaxf(mrun, mx * LOG2E);
        const float alpha = fexp2(mrun - mnew);
        mrun = mnew;
        float rs = 0.f;
#pragma unroll
        for (int kt = 0; kt < 2; ++kt)
#pragma unroll
            for (int i = 0; i < 16; ++i) { const float pv = fexp2(s[kt][i] * LOG2E - mnew); rs += pv; s[kt][i] = pv; }
        lrun = lrun * alpha + rs;
#pragma unroll
        for (int i = 0; i < 16; ++i) { o[0][i] *= alpha; o[1][i] *= alpha; }
#pragma unroll
        for (int kt = 0; kt < 2; ++kt)
#pragma unroll
            for (int s2 = 0; s2 < 2; ++s2) {
                u32x4 pw;
                pw[0] = pk2(s[kt][8 * s2 + 0], s[kt][8 * s2 + 1]); pw[1] = pk2(s[kt][8 * s2 + 2], s[kt][8 * s2 + 3]);
                pw[2] = pk2(s[kt][8 * s2 + 4], s[kt][8 * s2 + 5]); pw[3] = pk2(s[kt][8 * s2 + 6], s[kt][8 * s2 + 7]);
                const bf16x8 pb = __builtin_bit_cast(bf16x8, pw);
#pragma unroll
                for (int dt = 0; dt < 2; ++dt) {
                    const int rowoff = (dt * 32 + r) * 128, hoff = (hh ^ rh) << 3;
                    const u32x2 lo = *(const LDSP u32x2*)(vb + rowoff + (((kt * 4 + s2 * 2) ^ rsw) << 4) + hoff);
                    const u32x2 hi = *(const LDSP u32x2*)(vb + rowoff + (((kt * 4 + s2 * 2 + 1) ^ rsw) << 4) + hoff);
                    const u32x4 va = {lo[0], lo[1], hi[0], hi[1]};
                    o[dt] = __builtin_amdgcn_mfma_f32_32x32x16_bf16(__builtin_bit_cast(bf16x8, va), pb, o[dt], 0, 0, 0);
                }
            }
        if (t + 1 < ntile) {
            ldsp_t nb = smem + (cur ^ 1) * 16384;
            *(LDSP u32x4*)(nb + kdst) = kst;
            if (vswap) vst = (u32x4){vst[2], vst[3], vst[0], vst[1]};
            *(LDSP u32x4*)(nb + 8192 + kdst) = vst;
        }
    }
    const float ltot = lrun + __shfl_xor(lrun, 32);
    const float inv = 1.f / ltot;
#pragma unroll
    for (int dt = 0; dt < 2; ++dt)
#pragma unroll
        for (int g4 = 0; g4 < 4; ++g4) {
            u32x2 w; w[0] = pk2(o[dt][4 * g4 + 0] * inv, o[dt][4 * g4 + 1] * inv); w[1] = pk2(o[dt][4 * g4 + 2] * inv, o[dt][4 * g4 + 3] * inv);
            *(u32x2*)(Op + (size_t)r * DM + dt * 32 + 8 * g4 + 4 * hh) = w;
        }
    __syncthreads();
}

DI void gmlp_unit(const Params& p, int l, int T, int g, ldsp_t smem) {
    int tid = threadIdx.x;
    asm volatile("" : "+v"(tid));
    const int wid = tid >> 6, lane = tid & 63, fr = lane & 15, fq = lane >> 4;
    {
        const int q = tid >> 2, part = tid & 3;
        const bf16_t* src = p.U + (size_t)(T * 128 + q) * 1024 + 512 + g * 128 + part * 32;
        u32x4 raw[4];
#pragma unroll
        for (int i = 0; i < 4; ++i) raw[i] = *(const u32x4*)(src + i * 8);
        float a = 0.f, b = 0.f;
#pragma unroll
        for (int i = 0; i < 4; ++i)
#pragma unroll
            for (int j = 0; j < 4; ++j) {
                const float lo = __uint_as_float(raw[i][j] << 16), hi = __uint_as_float(raw[i][j] & 0xffff0000u);
                a += lo + hi; b += lo * lo + hi * hi;
            }
        a += __shfl_xor(a, 1); a += __shfl_xor(a, 2);
        b += __shfl_xor(b, 1); b += __shfl_xor(b, 2);
        const float mean = a * (1.f / 128.f);
        const float rstd = rsqrtf(fmaxf(b * (1.f / 128.f) - mean * mean, 0.f) + EPS);
        const float* gn = p.gmlp_norm_g + l * 512 + g * 128 + part * 32;
#pragma unroll
        for (int i = 0; i < 4; ++i)
#pragma unroll
            for (int j = 0; j < 4; ++j) {
                const int c0 = part * 32 + i * 8 + j * 2;
                const float lo = __uint_as_float(raw[i][j] << 16), hi = __uint_as_float(raw[i][j] & 0xffff0000u);
                const unsigned w = pk2((lo - mean) * rstd * gn[i * 8 + j * 2], (hi - mean) * rstd * gn[i * 8 + j * 2 + 1]);
                *(LDSP bf16_t*)(smem + c0 * 256 + (((q >> 3) ^ (c0 & 15)) << 4) + (q & 7) * 2) = (bf16_t)(w & 0xffffu);
                *(LDSP bf16_t*)(smem + (c0 + 1) * 256 + (((q >> 3) ^ ((c0 + 1) & 15)) << 4) + (q & 7) * 2) = (bf16_t)(w >> 16);
            }
    }
    __syncthreads();
    const int prow = wid * 16 + fr;
    const bf16_t* wsp = p.ws_bf + ((size_t)(l * 4 + g) * 128 + prow) * 128 + fq * 8;
    bf16x8 a[4];
#pragma unroll
    for (int ks = 0; ks < 4; ++ks) a[ks] = *(const bf16x8*)(wsp + ks * 32);
    f32x4 acc[8];
#pragma unroll
    for (int n = 0; n < 8; ++n) {
        acc[n] = (f32x4){0.f, 0.f, 0.f, 0.f};
        const int c = n * 16 + fr;
#pragma unroll
        for (int ks = 0; ks < 4; ++ks) {
            const bf16x8 bq = *(const LDSP bf16x8*)(smem + c * 256 + (((ks * 4 + fq) ^ (c & 15)) << 4));
            acc[n] = __builtin_amdgcn_mfma_f32_16x16x32_bf16(bq, a[ks], acc[n], 0, 0, 0);
        }
    }
    const float bs = p.b_spatial[(size_t)(l * 4 + g) * 128 + prow];
    const int row = T * 128 + prow;
    const bf16_t* up = p.U + (size_t)row * 1024 + g * 128 + fq * 4;
    bf16_t* mp = p.MIX + (size_t)row * DM + 512 + g * 128 + fq * 4;
#pragma unroll
    for (int n = 0; n < 8; ++n) {
        const u32x2 uu = *(const u32x2*)(up + n * 16);
        const float u0 = __uint_as_float(uu[0] << 16), u1 = __uint_as_float(uu[0] & 0xffff0000u), u2 = __uint_as_float(uu[1] << 16), u3 = __uint_as_float(uu[1] & 0xffff0000u);
        u32x2 w; w[0] = pk2((acc[n][0] + bs) * u0, (acc[n][1] + bs) * u1); w[1] = pk2((acc[n][2] + bs) * u2, (acc[n][3] + bs) * u3);
        *(u32x2*)(mp + n * 16) = w;
    }
    __syncthreads();
}

DI void mixer_phase(const Params& p, int l, ldsp_t smem) {
    const bool last = l == DEPTH - 1;
    for (int u = blockIdx.x; u < 512; u += gridDim.x) attn_unit(p, (u & 7) >> 1, u & 1, u >> 3, false, smem);
    if (!last)
        for (int u = blockIdx.x; u < 32; u += gridDim.x) attn_unit(p, (u & 7) >> 1, u & 1, u >> 3, true, smem);
    const int nT = last ? 128 : 136;
    for (int u = blockIdx.x; u < nT * 4; u += gridDim.x) gmlp_unit(p, l, u >> 2, u & 3, smem);
}

constexpr int N_PHASES = 1 + DEPTH * 7;
DI void run_phase(const Params& p, int ph, ldsp_t smem) {
    if (ph == 0) { phase0(p, smem); return; }
    const int l = (ph - 1) / 7, k = (ph - 1) % 7;
    const bool last = l == DEPTH - 1;
    switch (k) {
        case 0: norm_phase(p, l, 1); break;
        case 1: gemm_stream<0>(p, l, p.H, p.wt_in + (size_t)l * IN_DIM * DM, NTOK, IN_DIM, DM, smem); break;
        case 2: mixer_phase(p, l, smem); break;
        case 3: gemm_stream<1>(p, l, p.MIX, p.wt_out + (size_t)l * DM * DM, NLAT, DM, DM, smem);
                if (!last) ctx_small_tiles<1>(p, l, p.MIX + (size_t)NLAT * DM, p.wt_out + (size_t)l * DM * DM, DM, DM, smem);
                break;
        case 4: norm_phase(p, l, 2); break;
        case 5: gemm_stream<2>(p, l, p.H, p.wt_ff1 + (size_t)l * FF * DM, NLAT, FF, DM, smem);
                if (!last) ctx_small_tiles<2>(p, l, p.H + (size_t)NLAT * DM, p.wt_ff1 + (size_t)l * FF * DM, FF, DM, smem);
                break;
        default: gemm_stream<3>(p, l, p.ACT, p.wt_ff2 + (size_t)l * DM * FF, NLAT, DM, FF, smem);
                if (!last) ctx_small_tiles<3>(p, l, p.ACT + (size_t)NLAT * FF, p.wt_ff2 + (size_t)l * DM * FF, DM, FF, smem);
                break;
    }
}

template <bool COOP>
__global__ void __launch_bounds__(512) mk_kernel(Params p, int ph_lo, int ph_hi) {
    __shared__ __attribute__((aligned(1024))) char smem_raw[2 * G_STAGE_B + 8192];
    ldsp_t smem = (ldsp_t)smem_raw;
    for (int ph = ph_lo; ph < ph_hi; ++ph) {
        run_phase(p, ph, smem);
#ifdef DUP_K
        if (ph > 0 && (ph - 1) % 7 == DUP_K) { cg::this_grid().sync(); run_phase(p, ph, smem); }
#endif
        if (COOP && ph + 1 < ph_hi) cg::this_grid().sync();
    }
}

extern "C" void kernel_launch(void* const* d_in, const int* in_sizes, int n_in, void* d_out, int out_size, void* d_ws, size_t ws_size, hipStream_t stream) {
    Params p{};
    p.x = (const float*)d_in[0]; p.c = (const float*)d_in[1]; p.ctx = (const float*)d_in[2]; p.c_ctx = (const float*)d_in[3];
    p.w_mod = (const float*)d_in[4]; p.b_mod = (const float*)d_in[5]; p.norm1_g = (const float*)d_in[6]; p.w_in = (const float*)d_in[7];
    p.q_norm_g = (const float*)d_in[8]; p.k_norm_g = (const float*)d_in[9]; p.gmlp_norm_g = (const float*)d_in[10]; p.w_spatial = (const float*)d_in[11];
    p.b_spatial = (const float*)d_in[12]; p.w_out = (const float*)d_in[13]; p.norm2_g = (const float*)d_in[14]; p.w_ff1 = (const float*)d_in[15]; p.w_ff2 = (const float*)d_in[16];
    p.out = (float*)d_out;
    char* w = (char*)d_ws; size_t off = 0;
    auto take = [&](size_t bytes) { char* r = w + off; off += (bytes + 1023) & ~(size_t)1023; return r; };
    p.wt_in = (bf16_t*)take((size_t)DEPTH * IN_DIM * DM * 2);
    p.wt_out = (bf16_t*)take((size_t)DEPTH * DM * DM * 2);
    p.wt_ff1 = (bf16_t*)take((size_t)DEPTH * FF * DM * 2);
    p.wt_ff2 = (bf16_t*)take((size_t)DEPTH * FF * DM * 2);
    p.ws_bf = (bf16_t*)take((size_t)DEPTH * 4 * 128 * 128 * 2);
    p.mod = (float*)take((size_t)DEPTH * 5 * 6144 * 4);
    p.rope = (float*)take(2048 * 4);
    p.xc = (float*)take((size_t)NCTX * DM * 4);
    p.H = (bf16_t*)take((size_t)NTOK * DM * 2);
    p.ACT = (bf16_t*)take((size_t)NTOK * FF * 2);
    {
        char* a = (char*)p.ACT; size_t o2 = 0;
        auto take2 = [&](size_t bytes) { char* r = a + o2; o2 += (bytes + 1023) & ~(size_t)1023; return r; };
        p.Q = (bf16_t*)take2((size_t)NLAT * 512 * 2);
        p.Qc = (bf16_t*)take2((size_t)NCTX * 512 * 2);
        p.K = (bf16_t*)take2((size_t)NB * 2 * NKEY * 64 * 2);
        p.Vt = (bf16_t*)take2((size_t)NB * 2 * NKEY * 64 * 2);
        p.U = (bf16_t*)take2((size_t)NTOK * 1024 * 2);
        p.MIX = (bf16_t*)take2((size_t)NTOK * DM * 2);
    }
    if (off > ws_size) { fprintf(stderr, "workspace too small: need %zu have %zu\n", off, ws_size); return; }
#if MK_COOP
    static int grid_blocks = 0;
    if (!grid_blocks) {
        int dev = 0, cus = 0, per_cu = 0;
        hipGetDevice(&dev);
        hipDeviceGetAttribute(&cus, hipDeviceAttributeMultiprocessorCount, dev);
        hipOccupancyMaxActiveBlocksPerMultiprocessor(&per_cu, mk_kernel<true>, 512, 0);
        if (per_cu < 1) per_cu = 1;
        grid_blocks = cus * 1;
    }
    int lo = 0, hi = N_PHASES;
    void* args[] = {&p, &lo, &hi};
    hipError_t e = hipLaunchCooperativeKernel((void*)mk_kernel<true>, dim3(grid_blocks), dim3(512), args, 0, stream);
    if (e != hipSuccess) fprintf(stderr, "cooperative launch failed: %s (grid %d)\n", hipGetErrorString(e), grid_blocks);
#else
    for (int ph = 0; ph < N_PHASES; ++ph) mk_kernel<false><<<256, 512, 0, stream>>>(p, ph, ph + 1);
#endif
}
```

```cpp
#include <hip/hip_runtime.h>
#include <hip/hip_cooperative_groups.h>
#include <stdint.h>
#include <cstdio>
namespace cg = cooperative_groups;

#ifndef MK_COOP
#define MK_COOP 1
#endif

#define DI __device__ __forceinline__
#define LDSP __attribute__((address_space(3)))
typedef LDSP char* ldsp_t;
typedef unsigned short bf16_t;
typedef short bf16x8 __attribute__((ext_vector_type(8)));
typedef float f32x2 __attribute__((ext_vector_type(2)));
typedef float f32x4 __attribute__((ext_vector_type(4)));
typedef float f32x16 __attribute__((ext_vector_type(16)));
typedef unsigned u32x2 __attribute__((ext_vector_type(2)));
typedef unsigned u32x4 __attribute__((ext_vector_type(4)));
typedef __bf16 bf2_t __attribute__((ext_vector_type(2)));

constexpr int DM = 1024, NB = 4, SEQ = 4096, DEPTH = 4, CTXL = 256;
constexpr int NLAT = NB * SEQ;
constexpr int NCTX = NB * CTXL;
constexpr int NTOK = NLAT + NCTX;
constexpr int IN_DIM = 1792, FF = 4096, NKEY = CTXL + SEQ;
constexpr float EPS = 1e-6f;
constexpr float LOG2E = 1.4426950408889634f;

struct Params {
    const float *x, *c, *ctx, *c_ctx, *w_mod, *b_mod, *norm1_g, *w_in, *q_norm_g, *k_norm_g, *gmlp_norm_g, *w_spatial, *b_spatial, *w_out, *norm2_g, *w_ff1, *w_ff2;
    float* out;
    bf16_t *wt_in, *wt_out, *wt_ff1, *wt_ff2, *ws_bf;
    float *mod, *rope, *xc, *smax, *ss, *shw_in, *shw_ff1;
    bf16_t *H, *Q, *Qc, *K, *Vt, *U, *MIX, *ACT;
};

DI unsigned pk2(float a, float b) { f32x2 v = {a, b}; bf2_t r = __builtin_convertvector(v, bf2_t); return __builtin_bit_cast(unsigned, r); }
DI bf16_t f2bf(float a) { return (bf16_t)(pk2(a, 0.f) & 0xffffu); }
DI float fexp2(float x) { return __builtin_amdgcn_exp2f(x); }
DI float gelu_tanh(float x) {
    const float y = 0.7978845608028654f * (x + 0.044715f * x * x * x);
    return x / (1.f + fexp2(-2.f * LOG2E * y));
}
DI float* xrow_ptr(const Params& p, int row) { return row < NLAT ? p.out + (size_t)row * DM : p.xc + (size_t)(row - NLAT) * DM; }

DI void transpose_tile(const float* __restrict__ src, bf16_t* __restrict__ dst, int K, int N, int tk, int tn, ldsp_t smem) {
    LDSP float* t = (LDSP float*)smem;
    const int tid = threadIdx.x, k0 = tk * 64, n0 = tn * 64;
#pragma unroll
    for (int i = 0; i < 2; ++i) {
        const int k = (tid >> 4) + 32 * i, n4 = (tid & 15) * 4;
        const f32x4 v = *(const f32x4*)(src + (size_t)(k0 + k) * N + n0 + n4);
        t[k * 65 + n4 + 0] = v[0]; t[k * 65 + n4 + 1] = v[1]; t[k * 65 + n4 + 2] = v[2]; t[k * 65 + n4 + 3] = v[3];
    }
    __syncthreads();
    {
        const int n = tid >> 3, k8 = (tid & 7) * 8;
        u32x4 w;
        w[0] = pk2(t[(k8 + 0) * 65 + n], t[(k8 + 1) * 65 + n]);
        w[1] = pk2(t[(k8 + 2) * 65 + n], t[(k8 + 3) * 65 + n]);
        w[2] = pk2(t[(k8 + 4) * 65 + n], t[(k8 + 5) * 65 + n]);
        w[3] = pk2(t[(k8 + 6) * 65 + n], t[(k8 + 7) * 65 + n]);
        *(u32x4*)(dst + (size_t)(n0 + n) * K + k0 + k8) = w;
    }
    __syncthreads();
}

DI void mod_unit(const Params& p, int l, int cgi, ldsp_t smem) {
    LDSP float* s = (LDSP float*)smem;
    LDSP float* red = (LDSP float*)(smem + 20480);
    const int tid = threadIdx.x;
    for (int i = tid; i < 5 * 1024; i += 512) {
        const int cnd = i >> 10, k = i & 1023;
        const float v = cnd < 4 ? p.c[cnd * 1024 + k] : p.c_ctx[k];
        s[i] = v / (1.f + fexp2(-LOG2E * v));
    }
    __syncthreads();
    const int c4 = tid & 15, ks = tid >> 4;
    f32x4 acc[5];
#pragma unroll
    for (int q = 0; q < 5; ++q) acc[q] = (f32x4){0.f, 0.f, 0.f, 0.f};
    const float* wp = p.w_mod + ((size_t)l * 1024 + ks * 32) * 6144 + cgi * 64 + c4 * 4;
#pragma unroll 4
    for (int kk = 0; kk < 32; ++kk) {
        const f32x4 w = *(const f32x4*)(wp + (size_t)kk * 6144);
        const int k = ks * 32 + kk;
#pragma unroll
        for (int q = 0; q < 5; ++q) acc[q] += w * s[q * 1024 + k];
    }
#pragma unroll
    for (int q = 0; q < 5; ++q)
#pragma unroll
        for (int j = 0; j < 4; ++j) red[(ks * 5 + q) * 64 + c4 * 4 + j] = acc[q][j];
    __syncthreads();
    if (tid < 320) {
        const int q = tid >> 6, col = tid & 63;
        float a = 0.f;
        for (int k2 = 0; k2 < 32; ++k2) a += red[(k2 * 5 + q) * 64 + col];
        const int j = cgi * 64 + col;
        p.mod[((size_t)l * 5 + q) * 6144 + j] = a + p.b_mod[(size_t)l * 6144 + j];
    }
    __syncthreads();
}

DI void phase0(const Params& p, ldsp_t smem) {
    constexpr int T_IN = 16 * 28, T_OUT = 16 * 16, T_FF1 = 16 * 64, T_FF2 = 64 * 16;
    constexpr int T_L = T_IN + T_OUT + T_FF1 + T_FF2;
    constexpr int U_T = DEPTH * T_L;
    constexpr int U_MOD = DEPTH * 96;
    constexpr int U_WS = 64;
    constexpr int U_ALL = U_MOD + U_T + U_WS + 1;
    for (int u = blockIdx.x; u < U_ALL; u += gridDim.x) {
        if (u < U_MOD) { mod_unit(p, u / 96, u % 96, smem); continue; }
        int v = u - U_MOD;
        if (v < U_T) {
            const int l = v / T_L; int r = v % T_L;
            if (r < T_IN) { transpose_tile(p.w_in + (size_t)l * DM * IN_DIM, p.wt_in + (size_t)l * IN_DIM * DM, DM, IN_DIM, r / 28, r % 28, smem); continue; }
            r -= T_IN;
            if (r < T_OUT) { transpose_tile(p.w_out + (size_t)l * DM * DM, p.wt_out + (size_t)l * DM * DM, DM, DM, r / 16, r % 16, smem); continue; }
            r -= T_OUT;
            if (r < T_FF1) { transpose_tile(p.w_ff1 + (size_t)l * DM * FF, p.wt_ff1 + (size_t)l * FF * DM, DM, FF, r / 64, r % 64, smem); continue; }
            r -= T_FF1;
            transpose_tile(p.w_ff2 + (size_t)l * FF * DM, p.wt_ff2 + (size_t)l * DM * FF, FF, DM, r / 16, r % 16, smem); continue;
        }
        v -= U_T;
        if (v < U_WS) {
            const size_t i = ((size_t)v * 512 + threadIdx.x) * 8;
            const f32x4 a = *(const f32x4*)(p.w_spatial + i), b = *(const f32x4*)(p.w_spatial + i + 4);
            u32x4 w; w[0] = pk2(a[0], a[1]); w[1] = pk2(a[2], a[3]); w[2] = pk2(b[0], b[1]); w[3] = pk2(b[2], b[3]);
            *(u32x4*)(p.ws_bf + i) = w;
            continue;
        }
        if (threadIdx.x < DEPTH) {
            float mq = 0.f, mk = 0.f;
            for (int i = 0; i < 64; ++i) { mq = fmaxf(mq, fabsf(p.q_norm_g[threadIdx.x * 64 + i])); mk = fmaxf(mk, fabsf(p.k_norm_g[threadIdx.x * 64 + i])); }
            p.smax[threadIdx.x] = 8.f * mq * mk;
        }
        for (int i = threadIdx.x; i < 1024; i += 512) {
            const int pos = i >> 4, f = i & 15;
            const float inv = fexp2(-(float)f * (13.287712379549449f / 16.f));
            const float rev = (float)pos * inv * 0.15915494309189535f;
            p.rope[i] = __builtin_amdgcn_cosf(rev);
            p.rope[1024 + i] = __builtin_amdgcn_sinf(rev);
        }
    }
}

DI void phase1(const Params& p) {
    int tid = threadIdx.x;
    asm volatile("" : "+v"(tid));
    const int lane = tid & 63, wid = tid >> 6;
    const int gw = blockIdx.x * 8 + wid, nw = gridDim.x * 8;
    for (int row = gw; row < NTOK; row += nw) {
        const float* src = row < NLAT ? p.x + (size_t)row * DM : p.ctx + (size_t)(row - NLAT) * DM;
        const int cond = row < NLAT ? (row >> 12) : 4;
        const float* mp = p.mod + ((size_t)cond) * 6144;
        f32x4 v[4];
        float ss = 0.f;
#pragma unroll
        for (int i = 0; i < 4; ++i) { v[i] = *(const f32x4*)(src + i * 256 + lane * 4); ss += v[i][0] * v[i][0] + v[i][1] * v[i][1] + v[i][2] * v[i][2] + v[i][3] * v[i][3]; }
#pragma unroll
        for (int o = 1; o < 64; o <<= 1) ss += __shfl_xor(ss, o);
        if (lane < 16) p.ss[(size_t)row * 16 + lane] = lane == 0 ? ss : 0.f;
        bf16_t* hp = p.H + (size_t)row * DM;
        float* xw = xrow_ptr(p, row);
#pragma unroll
        for (int i = 0; i < 4; ++i) {
            const int idx = i * 256 + lane * 4;
            const f32x4 gg = *(const f32x4*)(p.norm1_g + idx), sc = *(const f32x4*)(mp + DM + idx);
            f32x4 y;
#pragma unroll
            for (int j = 0; j < 4; ++j) y[j] = v[i][j] * gg[j] * (1.f + sc[j]);
            u32x2 w; w[0] = pk2(y[0], y[1]); w[1] = pk2(y[2], y[3]);
            *(u32x2*)(hp + idx) = w;
            *(f32x4*)(xw + idx) = v[i];
        }
    }
    for (int grp = 0; grp < DEPTH * 2; ++grp) {
        const int l = grp >> 1, which = grp & 1;
        const int N = which ? FF : IN_DIM;
        const bf16_t* W = which ? p.wt_ff1 + (size_t)l * FF * DM : p.wt_in + (size_t)l * IN_DIM * DM;
        float* dst = which ? p.shw_ff1 + (size_t)l * 5 * FF : p.shw_in + (size_t)l * 5 * IN_DIM;
        for (int n = gw; n < N; n += nw) {
            const u32x4 w0 = *(const u32x4*)(W + (size_t)n * DM + lane * 16), w1 = *(const u32x4*)(W + (size_t)n * DM + lane * 16 + 8);
            float wf[16];
#pragma unroll
            for (int j = 0; j < 4; ++j) { wf[2 * j] = __uint_as_float(w0[j] << 16); wf[2 * j + 1] = __uint_as_float(w0[j] & 0xffff0000u); wf[8 + 2 * j] = __uint_as_float(w1[j] << 16); wf[8 + 2 * j + 1] = __uint_as_float(w1[j] & 0xffff0000u); }
#pragma unroll
            for (int c = 0; c < 5; ++c) {
                const float* sh = p.mod + ((size_t)l * 5 + c) * 6144 + (which ? 3 : 0) * DM + lane * 16;
                float a = 0.f;
#pragma unroll
                for (int q = 0; q < 4; ++q) { const f32x4 sv = *(const f32x4*)(sh + q * 4); a += sv[0] * wf[q * 4] + sv[1] * wf[q * 4 + 1] + sv[2] * wf[q * 4 + 2] + sv[3] * wf[q * 4 + 3]; }
#pragma unroll
                for (int o = 1; o < 64; o <<= 1) a += __shfl_xor(a, o);
                if (lane == 0) dst[(size_t)c * N + n] = a;
            }
        }
    }
}

constexpr int G_TILE_B = 256 * 64 * 2, G_STAGE_B = 2 * G_TILE_B;
DI int lds_byte2(int r, int c) {
    const int st = (r >> 4) * 2 + (c >> 5), ob = (r & 15) * 64 + (c & 31) * 2;
    return st * 1024 + (ob ^ (((ob >> 9) & 1) << 5));
}
DI void stage_rc2(int b, int& R, int& C) {
    const int st = b >> 10, sb = b & 1023, swz = sb ^ (((sb >> 9) & 1) << 5);
    R = (st >> 1) * 16 + swz / 64;
    C = (st & 1) * 32 + (swz % 64) / 2;
}
#define WAIT_V0() asm volatile("s_waitcnt vmcnt(0)" ::: "memory")

struct TileCtx { int brow, bcol, pn, wr, wc, fr, fq, wid, lane, l; };

DI void tile_coords(int L, int nM, int nN, int& pm, int& pn) {
    const int nwg = nM * nN;
    int wgid = L;
    { const int q = nwg / 8, r = nwg % 8, xcd = wgid % 8, off = wgid / 8; wgid = (xcd < r ? xcd * (q + 1) : r * (q + 1) + (xcd - r) * q) + off; }
    const int nig = 8 * nN, gid = wgid / nig, fm = gid * 8, gsz = (nM - fm) < 8 ? (nM - fm) : 8;
    pm = fm + ((wgid % nig) % gsz); pn = (wgid % nig) / gsz;
}

template <int EK> struct EpiResid {
    static DI void run(const f32x4 (&acc)[8][4], const TileCtx& tc, const Params& p, ldsp_t) {
        constexpr int GI = EK == 1 ? 2 : 5;
        const int cond = tc.brow < NLAT ? (tc.brow >> 12) : 4;
        const float* gate = p.mod + ((size_t)tc.l * 5 + cond) * 6144 + GI * DM;
        const int col0 = tc.bcol + tc.wc * 64 + tc.fq * 4;
        const bool has_next = EK == 1 || tc.l + 1 < DEPTH;
        const int ln = EK == 1 ? tc.l : (has_next ? tc.l + 1 : tc.l);
        const float* gnx = (EK == 1 ? p.norm2_g : p.norm1_g) + (size_t)ln * DM + col0;
        const float* scn = p.mod + ((size_t)ln * 5 + cond) * 6144 + (EK == 1 ? 4 : 1) * DM + col0;
        float* ssp = p.ss + (size_t)(ln * 2 + (EK == 1 ? 1 : 0)) * NTOK * 16 + (tc.bcol >> 8) * 4 + tc.wc;
        f32x4 gv[4], av[4];
#pragma unroll
        for (int n = 0; n < 4; ++n) {
            gv[n] = *(const f32x4*)(gate + col0 + n * 16);
            const f32x4 g1 = *(const f32x4*)(gnx + n * 16), s1 = *(const f32x4*)(scn + n * 16);
            av[n] = g1 * (1.f + s1);
        }
#pragma unroll
        for (int m = 0; m < 8; ++m) { __builtin_amdgcn_sched_barrier(0);
            const int row = tc.brow + tc.wr * 128 + m * 16 + tc.fr;
            float* xr = xrow_ptr(p, row) + col0;
            bf16_t* hr = p.H + (size_t)row * DM + col0;
            float part = 0.f;
#pragma unroll
            for (int n = 0; n < 4; ++n) {
                f32x4 xv = *(const f32x4*)(xr + n * 16);
                xv += gv[n] * acc[m][n];
                *(f32x4*)(xr + n * 16) = xv;
                if (has_next) {
                    part += xv[0] * xv[0] + xv[1] * xv[1] + xv[2] * xv[2] + xv[3] * xv[3];
                    const f32x4 hv = xv * av[n];
                    u32x2 w; w[0] = pk2(hv[0], hv[1]); w[1] = pk2(hv[2], hv[3]);
                    *(u32x2*)(hr + n * 16) = w;
                }
            }
            if (has_next) {
                part += __shfl_xor(part, 16);
                part += __shfl_xor(part, 32);
                if (tc.fq == 0) ssp[(size_t)row * 16] = part;
            }
        }
    }
};
struct EpiFF1 {
    static DI void run(const f32x4 (&acc)[8][4], const TileCtx& tc, const Params& p, ldsp_t) {
        const int col0 = tc.bcol + tc.wc * 64 + tc.fq * 4;
#pragma unroll
        for (int m = 0; m < 8; ++m) { __builtin_amdgcn_sched_barrier(0);
            const int row = tc.brow + tc.wr * 128 + m * 16 + tc.fr;
            bf16_t* ar = p.ACT + (size_t)row * FF + col0;
#pragma unroll
            for (int n = 0; n < 4; ++n) {
                f32x4 a = acc[m][n];
#pragma unroll
                for (int j = 0; j < 4; ++j) { const float r = fmaxf(a[j], 0.f); a[j] = r * r; }
                u32x2 w; w[0] = pk2(a[0], a[1]); w[1] = pk2(a[2], a[3]);
                *(u32x2*)(ar + n * 16) = w;
            }
        }
    }
};
template <int BRK> struct EpiIn {
    static DI void run(const f32x4 (&acc)[8][4], const TileCtx& tc, const Params& p, ldsp_t shm) {
        const int l = tc.l, pn = tc.pn, wc = tc.wc, fr = tc.fr, fq = tc.fq;
        if (BRK == 0 || (BRK == 1 && wc < 2)) {
            constexpr bool isq = BRK == 0;
            const int head = isq ? pn * 4 + wc : wc;
            const float* gn = (isq ? p.q_norm_g : p.k_norm_g) + l * 64;
            f32x4 gv[4];
#pragma unroll
            for (int n = 0; n < 4; ++n) gv[n] = *(const f32x4*)(gn + n * 16 + fq * 4);
            const float osc = isq ? 0.125f : 1.f;
            const bool lat = tc.brow < NLAT;
#pragma unroll
            for (int m = 0; m < 8; ++m) { __builtin_amdgcn_sched_barrier(0);
                const int row = tc.brow + tc.wr * 128 + m * 16 + fr;
                float ss = 0.f;
#pragma unroll
                for (int n = 0; n < 4; ++n)
#pragma unroll
                    for (int j = 0; j < 4; ++j) ss += acc[m][n][j] * acc[m][n][j];
                ss += __shfl_xor(ss, 16);
                ss += __shfl_xor(ss, 32);
                const float rstd = rsqrtf(ss * (1.f / 64.f) + EPS) * osc;
                bf16_t* dst;
                int t = 0;
                if (lat) {
                    const int b = row >> 12; t = row & 4095;
                    dst = isq ? p.Q + ((size_t)(b * 8 + head) * SEQ + t) * 64 : p.K + ((size_t)(b * 2 + head) * NKEY + CTXL + t) * 64;
                } else {
                    const int r2 = row - NLAT, b = r2 >> 8, tt = r2 & 255;
                    dst = isq ? p.Qc + ((size_t)(b * 8 + head) * CTXL + tt) * 64 : p.K + ((size_t)(b * 2 + head) * NKEY + tt) * 64;
                }
#pragma unroll
                for (int ax = 0; ax < 2; ++ax) {
                    f32x4 x1 = acc[m][2 * ax] * rstd * gv[2 * ax], x2 = acc[m][2 * ax + 1] * rstd * gv[2 * ax + 1];
                    if (lat) {
                        const int pos = ax == 0 ? (t >> 6) : (t & 63);
                        const f32x4 cs = *(const f32x4*)(p.rope + pos * 16 + fq * 4), sn = *(const f32x4*)(p.rope + 1024 + pos * 16 + fq * 4);
                        const f32x4 o1 = x1 * cs - x2 * sn, o2 = x2 * cs + x1 * sn;
                        x1 = o1; x2 = o2;
                    }
                    u32x2 w; w[0] = pk2(x1[0], x1[1]); w[1] = pk2(x1[2], x1[3]);
                    *(u32x2*)(dst + (2 * ax) * 16 + fq * 4) = w;
                    w[0] = pk2(x2[0], x2[1]); w[1] = pk2(x2[2], x2[3]);
                    *(u32x2*)(dst + (2 * ax + 1) * 16 + fq * 4) = w;
                }
            }
        } else if (BRK == 1) {
            const int kvh = wc - 2;
#pragma unroll
            for (int m = 0; m < 8; ++m) { __builtin_amdgcn_sched_barrier(0);
                const int row = tc.brow + tc.wr * 128 + m * 16 + fr;
                int b, pos;
                if (row < NLAT) { b = row >> 12; pos = CTXL + (row & 4095); } else { const int r2 = row - NLAT; b = r2 >> 8; pos = r2 & 255; }
                const int k16 = pos & 15;
                pos = (pos & ~15) | ((((k16 >> 2) & 1) << 3) + (k16 & 3) + ((k16 >> 3) << 2));
                bf16_t* dst = p.Vt + (size_t)(b * 2 + kvh) * 64 * NKEY + pos;
#pragma unroll
                for (int n = 0; n < 4; ++n)
#pragma unroll
                    for (int j = 0; j < 4; ++j) dst[(size_t)(n * 16 + fq * 4 + j) * NKEY] = f2bf(acc[m][n][j]);
            }
        } else if (BRK == 2) {
            const int ucol = (pn - 3) * 256 + wc * 64 + fq * 4;
#pragma unroll
            for (int m = 0; m < 8; ++m) { __builtin_amdgcn_sched_barrier(0);
                const int row = tc.brow + tc.wr * 128 + m * 16 + fr;
                bf16_t* dst = p.U + (size_t)row * 1024 + ucol;
#pragma unroll
                for (int n = 0; n < 4; ++n) {
                    u32x2 w; w[0] = pk2(gelu_tanh(acc[m][n][0]), gelu_tanh(acc[m][n][1])); w[1] = pk2(gelu_tanh(acc[m][n][2]), gelu_tanh(acc[m][n][3]));
                    *(u32x2*)(dst + n * 16) = w;
                }
            }
        }
    }
};

template <int EK>
DI void gemm_stream(const Params& p, int l, const bf16_t* __restrict__ A, const bf16_t* __restrict__ Bt, int M, int N, int K, ldsp_t shm) {
    const int nM = M / 256, nN = N / 256, nwg = nM * nN;
    int L = blockIdx.x;
    if (L >= nwg) return;
#define G_SA(b) (shm + (b) * G_STAGE_B)
#define G_SB(b) (shm + (b) * G_STAGE_B + G_TILE_B)
#define G_LANE_SETUP() \
    int tid_ = threadIdx.x; \
    asm volatile("" : "+v"(tid_));    \
    const int wid = tid_ >> 6, lane = tid_ & 63, wr = wid >> 2, wc = wid & 3, fr = lane & 15, fq = lane >> 4; \
    unsigned soff[4];        \
    _Pragma("unroll") for (int i = 0; i < 4; ++i) { int sR, sC; stage_rc2(wid * 1024 + i * 8192 + lane * 16, sR, sC); soff[i] = (unsigned)(sR * K + sC) * 2u; }
#define G_STAGE(Ap, Bp, buf, kt) do { const char* ab_ = (const char*)(Ap) + (size_t)(kt) * 128; const char* bb_ = (const char*)(Bp) + (size_t)(kt) * 128; \
      _Pragma("unroll") for (int i = 0; i < 4; ++i) { \
        __builtin_amdgcn_global_load_lds((const unsigned*)(ab_ + soff[i]), (LDSP unsigned*)(G_SA(buf) + wid * 1024 + i * 8192), 16, 0, 0); \
        __builtin_amdgcn_global_load_lds((const unsigned*)(bb_ + soff[i]), (LDSP unsigned*)(G_SB(buf) + wid * 1024 + i * 8192), 16, 0, 0); } } while (0)
    const int nt = K / 64;
    int pm, pn;
    tile_coords(L, nM, nN, pm, pn);
    const bf16_t* Ab = A + (size_t)pm * 256 * K;
    const bf16_t* Bb = Bt + (size_t)pn * 256 * K;
    { G_LANE_SETUP(); (void)wr; (void)wc; (void)fr; (void)fq; G_STAGE(Ab, Bb, 0, 0); WAIT_V0(); __syncthreads(); }
    while (true) {
        G_LANE_SETUP();
        f32x4 acc[8][4];
#pragma unroll
        for (int m = 0; m < 8; ++m)
#pragma unroll
            for (int n = 0; n < 4; ++n) acc[m][n] = (f32x4){0.f, 0.f, 0.f, 0.f};
        const int Ln = L + gridDim.x;
        const bool has_next = Ln < nwg;
        int pm2 = pm, pn2 = pn;
        if (has_next) tile_coords(Ln, nM, nN, pm2, pn2);
        const bf16_t* Ab2 = A + (size_t)pm2 * 256 * K;
        const bf16_t* Bb2 = Bt + (size_t)pn2 * 256 * K;
        for (int t = 0; t < nt; ++t) {
            const int cur = t & 1;
            if (t + 1 < nt) G_STAGE(Ab, Bb, cur ^ 1, t + 1);
            else if (has_next) G_STAGE(Ab2, Bb2, cur ^ 1, 0);
#pragma unroll
            for (int ks = 0; ks < 2; ++ks) {
                bf16x8 At[8], Bf[4];
#pragma unroll
                for (int m = 0; m < 8; ++m) At[m] = *(const LDSP bf16x8*)(G_SA(cur) + lds_byte2(wr * 128 + m * 16 + fr, ks * 32 + fq * 8));
#pragma unroll
                for (int n = 0; n < 4; ++n) Bf[n] = *(const LDSP bf16x8*)(G_SB(cur) + lds_byte2(wc * 64 + n * 16 + fr, ks * 32 + fq * 8));
#pragma unroll
                for (int m = 0; m < 8; ++m)
#pragma unroll
                    for (int n = 0; n < 4; ++n) acc[m][n] = __builtin_amdgcn_mfma_f32_16x16x32_bf16(Bf[n], At[m], acc[m][n], 0, 0, 0);
                __builtin_amdgcn_sched_barrier(0);
            }
            WAIT_V0(); __syncthreads();
        }
        {
            int tid2 = threadIdx.x, pme = pm, pne = pn;
            asm volatile("" : "+v"(tid2), "+s"(pme), "+s"(pne));
            TileCtx tc;
            tc.wid = tid2 >> 6; tc.lane = tid2 & 63; tc.wr = tc.wid >> 2; tc.wc = tc.wid & 3; tc.fr = tc.lane & 15; tc.fq = tc.lane >> 4; tc.l = l;
            tc.brow = pme * 256; tc.bcol = pne * 256; tc.pn = pne;
            ldsp_t ex = shm + 2 * G_STAGE_B;
            if (EK == 0 || EK == 2) {
                const int cond = tc.brow < NLAT ? (tc.brow >> 12) : 4;
                const float* ssp = p.ss + ((size_t)(l * 2 + (EK == 0 ? 0 : 1)) * NTOK + tc.brow + tc.wr * 128 + tc.fr) * 16 + tc.fq * 4;
                const float* shw = (EK == 0 ? p.shw_in + ((size_t)l * 5 + cond) * IN_DIM : p.shw_ff1 + ((size_t)l * 5 + cond) * FF) + tc.bcol + tc.wc * 64 + tc.fq * 4;
                f32x4 shv[4];
#pragma unroll
                for (int n = 0; n < 4; ++n) shv[n] = *(const f32x4*)(shw + n * 16);
#pragma unroll
                for (int m = 0; m < 8; ++m) {
                    const f32x4 pp = *(const f32x4*)(ssp + m * 256);
                    float sq = pp[0] + pp[1] + pp[2] + pp[3];
                    sq += __shfl_xor(sq, 16);
                    sq += __shfl_xor(sq, 32);
                    const float rstd = rsqrtf(sq * (1.f / DM) + EPS);
#pragma unroll
                    for (int n = 0; n < 4; ++n) acc[m][n] = acc[m][n] * rstd + shv[n];
                }
            }
            if (EK == 0) {
                if (pne < 2) EpiIn<0>::run(acc, tc, p, ex);
                else if (pne == 2) EpiIn<1>::run(acc, tc, p, ex);
                else EpiIn<2>::run(acc, tc, p, ex);
            } else if (EK == 1) EpiResid<1>::run(acc, tc, p, ex);
            else if (EK == 2) EpiFF1::run(acc, tc, p, ex);
            else EpiResid<3>::run(acc, tc, p, ex);
        }
        if (!has_next) break;
        L = Ln; pm = pm2; pn = pn2; Ab = Ab2; Bb = Bb2;
    }
}

template <int EK>
DI void ctx_small_tiles(const Params& p, int l, const bf16_t* __restrict__ A, const bf16_t* __restrict__ Bt, int N, int K, ldsp_t shm) {
    const int ntn = N / 64, ntiles = 16 * ntn;
    for (int u = blockIdx.x; u < ntiles; u += gridDim.x) {
        const int tm = u / ntn, tn = u % ntn;
        int tid = threadIdx.x;
        asm volatile("" : "+v"(tid));
        const int wid = tid >> 6, lane = tid & 63, fr = lane & 15, fq = lane >> 4;
        const int kw = K / 8;
        const bf16_t* ap = A + (size_t)(tm * 64 + fr) * K + wid * kw + fq * 8;
        const bf16_t* bp = Bt + (size_t)(tn * 64 + fr) * K + wid * kw + fq * 8;
        f32x4 acc[4][4];
#pragma unroll
        for (int m = 0; m < 4; ++m)
#pragma unroll
            for (int n = 0; n < 4; ++n) acc[m][n] = (f32x4){0.f, 0.f, 0.f, 0.f};
#pragma unroll 2
        for (int ks = 0; ks < kw / 32; ++ks) {
            bf16x8 a[4], b[4];
#pragma unroll
            for (int m = 0; m < 4; ++m) a[m] = *(const bf16x8*)(ap + (size_t)m * 16 * K + ks * 32);
#pragma unroll
            for (int n = 0; n < 4; ++n) b[n] = *(const bf16x8*)(bp + (size_t)n * 16 * K + ks * 32);
#pragma unroll
            for (int m = 0; m < 4; ++m)
#pragma unroll
                for (int n = 0; n < 4; ++n) acc[m][n] = __builtin_amdgcn_mfma_f32_16x16x32_bf16(b[n], a[m], acc[m][n], 0, 0, 0);
        }
#pragma unroll
        for (int m = 0; m < 4; ++m)
#pragma unroll
            for (int n = 0; n < 4; ++n) {
                const int row = m * 16 + fr, ch = (n * 4 + fq) ^ (row & 15);
                *(LDSP f32x4*)(shm + wid * 16384 + row * 256 + ch * 16) = acc[m][n];
            }
        __syncthreads();
        {
            const int row = tid >> 3, c8 = tid & 7;
            f32x4 s0 = {0.f, 0.f, 0.f, 0.f}, s1 = {0.f, 0.f, 0.f, 0.f};
#pragma unroll
            for (int w = 0; w < 8; ++w) {
                s0 += *(const LDSP f32x4*)(shm + w * 16384 + row * 256 + (((2 * c8) ^ (row & 15)) << 4));
                s1 += *(const LDSP f32x4*)(shm + w * 16384 + row * 256 + (((2 * c8 + 1) ^ (row & 15)) << 4));
            }
            const int grow = tm * 64 + row, gcol = tn * 64 + c8 * 8;
            if (EK == 2) {
                const float* pp = p.ss + ((size_t)(l * 2 + 1) * NTOK + NLAT + grow) * 16 + c8 * 2;
                float sq = pp[0] + pp[1];
                sq += __shfl_xor(sq, 1); sq += __shfl_xor(sq, 2); sq += __shfl_xor(sq, 4);
                const float rstd = rsqrtf(sq * (1.f / DM) + EPS);
                const float* shw = p.shw_ff1 + ((size_t)l * 5 + 4) * FF + gcol;
                const f32x4 h0 = *(const f32x4*)shw, h1 = *(const f32x4*)(shw + 4);
                s0 = s0 * rstd + h0; s1 = s1 * rstd + h1;
#pragma unroll
                for (int j = 0; j < 4; ++j) { float r0 = fmaxf(s0[j], 0.f), r1 = fmaxf(s1[j], 0.f); s0[j] = r0 * r0; s1[j] = r1 * r1; }
                u32x4 w; w[0] = pk2(s0[0], s0[1]); w[1] = pk2(s0[2], s0[3]); w[2] = pk2(s1[0], s1[1]); w[3] = pk2(s1[2], s1[3]);
                *(u32x4*)(p.ACT + (size_t)(NLAT + grow) * FF + gcol) = w;
            } else {
                const float* gate = p.mod + ((size_t)l * 5 + 4) * 6144 + (EK == 1 ? 2 : 5) * DM + gcol;
                float* xr = p.xc + (size_t)grow * DM + gcol;
                const f32x4 g0 = *(const f32x4*)gate, g1 = *(const f32x4*)(gate + 4);
                f32x4 x0 = *(const f32x4*)xr, x1 = *(const f32x4*)(xr + 4);
                x0 += g0 * s0; x1 += g1 * s1;
                *(f32x4*)xr = x0; *(f32x4*)(xr + 4) = x1;
                const int ln = EK == 1 ? l : l + 1;
                const float* gnx = (EK == 1 ? p.norm2_g : p.norm1_g) + (size_t)ln * DM + gcol;
                const float* scn = p.mod + ((size_t)ln * 5 + 4) * 6144 + (EK == 1 ? 4 : 1) * DM + gcol;
                const f32x4 a0 = *(const f32x4*)gnx * (1.f + *(const f32x4*)scn), a1 = *(const f32x4*)(gnx + 4) * (1.f + *(const f32x4*)(scn + 4));
                const f32x4 y0 = x0 * a0, y1 = x1 * a1;
                u32x4 w; w[0] = pk2(y0[0], y0[1]); w[1] = pk2(y0[2], y0[3]); w[2] = pk2(y1[0], y1[1]); w[3] = pk2(y1[2], y1[3]);
                *(u32x4*)(p.H + (size_t)(NLAT + grow) * DM + gcol) = w;
                float part = x0[0] * x0[0] + x0[1] * x0[1] + x0[2] * x0[2] + x0[3] * x0[3] + x1[0] * x1[0] + x1[1] * x1[1] + x1[2] * x1[2] + x1[3] * x1[3];
                part += __shfl_xor(part, 1); part += __shfl_xor(part, 2); part += __shfl_xor(part, 4);
                if (c8 == 0) p.ss[((size_t)(ln * 2 + (EK == 1 ? 1 : 0)) * NTOK + NLAT + grow) * 16 + tn] = part;
            }
        }
        __syncthreads();
    }
}

DI void attn_unit(const Params& p, int l, int b, int kvh, int qb, bool isctx, ldsp_t smem) {
    int tid = threadIdx.x;
    asm volatile("" : "+v"(tid));
    const int wid = tid >> 6, lane = tid & 63, r = lane & 31, hh = lane >> 5;
    const int head = kvh * 4 + (wid >> 1);
    const int t0 = qb * 64 + (wid & 1) * 32;
    const int nkeys = isctx ? CTXL : NKEY;
    const bf16_t* Qp = isctx ? p.Qc + ((size_t)(b * 8 + head) * CTXL + t0) * 64 : p.Q + ((size_t)(b * 8 + head) * SEQ + t0) * 64;
    const bf16_t* Kp = p.K + (size_t)(b * 2 + kvh) * NKEY * 64;
    const bf16_t* Vp = p.Vt + (size_t)(b * 2 + kvh) * 64 * NKEY;
    const int orow = isctx ? NLAT + b * CTXL + t0 : b * SEQ + t0;
    bf16_t* Op = p.MIX + (size_t)orow * DM + head * 64;
    const float cexp = p.smax[l] * LOG2E;

    bf16x8 qf[4];
#pragma unroll
    for (int ks = 0; ks < 4; ++ks) qf[ks] = *(const bf16x8*)(Qp + (size_t)r * 64 + ks * 16 + 8 * hh);
    f32x16 o[2];
#pragma unroll
    for (int i = 0; i < 16; ++i) { o[0][i] = 0.f; o[1][i] = 0.f; }
    float rs0 = 0.f, rs1 = 0.f;

    const int srow = tid >> 3, sch = tid & 7;
    const int kdst = srow * 128 + ((sch ^ ((srow >> 1) & 7)) << 4);
    const bf16_t* kg = Kp + (size_t)srow * 64 + sch * 8;
    const bf16_t* vg = Vp + (size_t)srow * NKEY + sch * 8;
    const int rsw = (r >> 1) & 7;
    const int ntile = nkeys / 64;

#define ATT_QK(SD, kb) do { _Pragma("unroll") for (int kt = 0; kt < 2; ++kt) { \
        _Pragma("unroll") for (int i = 0; i < 16; ++i) SD[kt][i] = 0.f; \
        _Pragma("unroll") for (int ks = 0; ks < 4; ++ks) { \
            const bf16x8 a_ = *(const LDSP bf16x8*)((kb) + (kt * 32 + r) * 128 + (((ks * 2 + hh) ^ rsw) << 4)); \
            SD[kt] = __builtin_amdgcn_mfma_f32_32x32x16_bf16(a_, qf[ks], SD[kt], 0, 0, 0); } } } while (0)

    u32x4 kst, vst;
    f32x16 sA[2], sB[2];
    {
        kst = *(const u32x4*)kg;
        *(LDSP u32x4*)(smem + kdst) = kst;
        kst = *(const u32x4*)(kg + (size_t)64 * 64);
        vst = *(const u32x4*)vg;
        __syncthreads();
        ATT_QK(sA, smem);
        *(LDSP u32x4*)(smem + 8192 + kdst) = kst;
        *(LDSP u32x4*)(smem + 16384 + kdst) = vst;
    }
#define ATT_STEP(t, SC, SN) do { \
        const int par = (t) & 1; \
        __syncthreads(); \
        { const int t2_ = (t) + 2 < ntile ? (t) + 2 : ntile - 1, t1_ = (t) + 1 < ntile ? (t) + 1 : ntile - 1; \
          kst = *(const u32x4*)(kg + (size_t)t2_ * 64 * 64); vst = *(const u32x4*)(vg + t1_ * 64); } \
        bf16x8 kf[8], vf[4], vh[4]; \
        ldsp_t kb_ = smem + (par ^ 1) * 8192; ldsp_t vb_ = smem + 16384 + par * 8192; \
        _Pragma("unroll") for (int kt = 0; kt < 2; ++kt) _Pragma("unroll") for (int ks = 0; ks < 4; ++ks) \
            kf[kt * 4 + ks] = *(const LDSP bf16x8*)(kb_ + (kt * 32 + r) * 128 + (((ks * 2 + hh) ^ rsw) << 4)); \
        _Pragma("unroll") for (int c = 0; c < 2; ++c) _Pragma("unroll") for (int dt = 0; dt < 2; ++dt) \
            vf[c * 2 + dt] = *(const LDSP bf16x8*)(vb_ + (dt * 32 + r) * 128 + (((c * 2 + hh) ^ rsw) << 4)); \
        __builtin_amdgcn_sched_barrier(0); \
        _Pragma("unroll") for (int kt = 0; kt < 2; ++kt) _Pragma("unroll") for (int i = 0; i < 16; ++i) SN[kt][i] = 0.f; \
        _Pragma("unroll") for (int ks = 0; ks < 4; ++ks) _Pragma("unroll") for (int kt = 0; kt < 2; ++kt) \
            SN[kt] = __builtin_amdgcn_mfma_f32_32x32x16_bf16(kf[kt * 4 + ks], qf[ks], SN[kt], 0, 0, 0); \
        _Pragma("unroll") for (int c = 2; c < 4; ++c) _Pragma("unroll") for (int dt = 0; dt < 2; ++dt) \
            vh[(c - 2) * 2 + dt] = *(const LDSP bf16x8*)(vb_ + (dt * 32 + r) * 128 + (((c * 2 + hh) ^ rsw) << 4)); \
        __builtin_amdgcn_sched_barrier(0); \
        _Pragma("unroll") for (int kt = 0; kt < 2; ++kt) { \
            _Pragma("unroll") for (int i = 0; i < 16; ++i) { \
                const float e_ = fexp2(SC[kt][i] * LOG2E - cexp); \
                if (i & 1) rs1 += e_; else rs0 += e_; \
                SC[kt][i] = e_; } } \
        _Pragma("unroll") for (int c = 0; c < 4; ++c) { \
            u32x4 pw; \
            pw[0] = pk2(SC[c >> 1][8 * (c & 1) + 0], SC[c >> 1][8 * (c & 1) + 1]); pw[1] = pk2(SC[c >> 1][8 * (c & 1) + 2], SC[c >> 1][8 * (c & 1) + 3]); \
            pw[2] = pk2(SC[c >> 1][8 * (c & 1) + 4], SC[c >> 1][8 * (c & 1) + 5]); pw[3] = pk2(SC[c >> 1][8 * (c & 1) + 6], SC[c >> 1][8 * (c & 1) + 7]); \
            const bf16x8 pb = __builtin_bit_cast(bf16x8, pw); \
            _Pragma("unroll") for (int dt = 0; dt < 2; ++dt) o[dt] = __builtin_amdgcn_mfma_f32_32x32x16_bf16(c < 2 ? vf[c * 2 + dt] : vh[(c - 2) * 2 + dt], pb, o[dt], 0, 0, 0); } \
        *(LDSP u32x4*)(smem + par * 8192 + kdst) = kst; \
        *(LDSP u32x4*)(smem + 16384 + (par ^ 1) * 8192 + kdst) = vst; \
    } while (0)

    for (int t = 0; t < ntile; t += 2) {
        ATT_STEP(t, sA, sB);
        ATT_STEP(t + 1, sB, sA);
    }
    const float lrun = rs0 + rs1;
    const float ltot = lrun + __shfl_xor(lrun, 32);
    const float inv = 1.f / ltot;
#pragma unroll
    for (int dt = 0; dt < 2; ++dt)
#pragma unroll
        for (int g4 = 0; g4 < 4; ++g4) {
            u32x2 w; w[0] = pk2(o[dt][4 * g4 + 0] * inv, o[dt][4 * g4 + 1] * inv); w[1] = pk2(o[dt][4 * g4 + 2] * inv, o[dt][4 * g4 + 3] * inv);
            *(u32x2*)(Op + (size_t)r * DM + dt * 32 + 8 * g4 + 4 * hh) = w;
        }
    __syncthreads();
}

DI void gmlp_unit(const Params& p, int l, int T, int g, ldsp_t smem) {
    int tid = threadIdx.x;
    asm volatile("" : "+v"(tid));
    const int wid = tid >> 6, lane = tid & 63, fr = lane & 15, fq = lane >> 4;
    {
        const int q = tid >> 2, part = tid & 3;
        const bf16_t* src = p.U + (size_t)(T * 128 + q) * 1024 + 512 + g * 128 + part * 32;
        u32x4 raw[4];
#pragma unroll
        for (int i = 0; i < 4; ++i) raw[i] = *(const u32x4*)(src + i * 8);
        float a = 0.f, b = 0.f;
#pragma unroll
        for (int i = 0; i < 4; ++i)
#pragma unroll
            for (int j = 0; j < 4; ++j) {
                const float lo = __uint_as_float(raw[i][j] << 16), hi = __uint_as_float(raw[i][j] & 0xffff0000u);
                a += lo + hi; b += lo * lo + hi * hi;
            }
        a += __shfl_xor(a, 1); a += __shfl_xor(a, 2);
        b += __shfl_xor(b, 1); b += __shfl_xor(b, 2);
        const float mean = a * (1.f / 128.f);
        const float rstd = rsqrtf(fmaxf(b * (1.f / 128.f) - mean * mean, 0.f) + EPS);
        const float* gn = p.gmlp_norm_g + l * 512 + g * 128 + part * 32;
#pragma unroll
        for (int i = 0; i < 4; ++i)
#pragma unroll
            for (int j = 0; j < 4; ++j) {
                const int c0 = part * 32 + i * 8 + j * 2;
                const float lo = __uint_as_float(raw[i][j] << 16), hi = __uint_as_float(raw[i][j] & 0xffff0000u);
                const unsigned w = pk2((lo - mean) * rstd * gn[i * 8 + j * 2], (hi - mean) * rstd * gn[i * 8 + j * 2 + 1]);
                *(LDSP bf16_t*)(smem + c0 * 256 + (((q >> 3) ^ (c0 & 15)) << 4) + (q & 7) * 2) = (bf16_t)(w & 0xffffu);
                *(LDSP bf16_t*)(smem + (c0 + 1) * 256 + (((q >> 3) ^ ((c0 + 1) & 15)) << 4) + (q & 7) * 2) = (bf16_t)(w >> 16);
            }
    }
    __syncthreads();
    const int prow = wid * 16 + fr;
    const bf16_t* wsp = p.ws_bf + ((size_t)(l * 4 + g) * 128 + prow) * 128 + fq * 8;
    bf16x8 a[4];
#pragma unroll
    for (int ks = 0; ks < 4; ++ks) a[ks] = *(const bf16x8*)(wsp + ks * 32);
    f32x4 acc[8];
#pragma unroll
    for (int n = 0; n < 8; ++n) {
        acc[n] = (f32x4){0.f, 0.f, 0.f, 0.f};
        const int c = n * 16 + fr;
#pragma unroll
        for (int ks = 0; ks < 4; ++ks) {
            const bf16x8 bq = *(const LDSP bf16x8*)(smem + c * 256 + (((ks * 4 + fq) ^ (c & 15)) << 4));
            acc[n] = __builtin_amdgcn_mfma_f32_16x16x32_bf16(bq, a[ks], acc[n], 0, 0, 0);
        }
    }
    const float bs = p.b_spatial[(size_t)(l * 4 + g) * 128 + prow];
    const int row = T * 128 + prow;
    const bf16_t* up = p.U + (size_t)row * 1024 + g * 128 + fq * 4;
    bf16_t* mp = p.MIX + (size_t)row * DM + 512 + g * 128 + fq * 4;
#pragma unroll
    for (int n = 0; n < 8; ++n) {
        const u32x2 uu = *(const u32x2*)(up + n * 16);
        const float u0 = __uint_as_float(uu[0] << 16), u1 = __uint_as_float(uu[0] & 0xffff0000u), u2 = __uint_as_float(uu[1] << 16), u3 = __uint_as_float(uu[1] & 0xffff0000u);
        u32x2 w; w[0] = pk2((acc[n][0] + bs) * u0, (acc[n][1] + bs) * u1); w[1] = pk2((acc[n][2] + bs) * u2, (acc[n][3] + bs) * u3);
        *(u32x2*)(mp + n * 16) = w;
    }
    __syncthreads();
}

DI void mixer_phase(const Params& p, int l, ldsp_t smem) {
    const bool last = l == DEPTH - 1;
    for (int u = blockIdx.x; u < 512; u += gridDim.x) attn_unit(p, l, (u & 7) >> 1, u & 1, u >> 3, false, smem);
    if (!last)
        for (int u = blockIdx.x; u < 32; u += gridDim.x) attn_unit(p, l, (u & 7) >> 1, u & 1, u >> 3, true, smem);
    const int nT = last ? 128 : 136;
    for (int u = blockIdx.x; u < nT * 4; u += gridDim.x) gmlp_unit(p, l, u >> 2, u & 3, smem);
}

constexpr int N_PHASES = 2 + DEPTH * 5;
DI void run_phase(const Params& p, int ph, ldsp_t smem) {
    if (ph == 0) { phase0(p, smem); return; }
    if (ph == 1) { phase1(p); return; }
    const int l = (ph - 2) / 5, k = (ph - 2) % 5;
    const bool last = l == DEPTH - 1;
    switch (k) {
        case 0: gemm_stream<0>(p, l, p.H, p.wt_in + (size_t)l * IN_DIM * DM, NTOK, IN_DIM, DM, smem); break;
        case 1: mixer_phase(p, l, smem); break;
        case 2: gemm_stream<1>(p, l, p.MIX, p.wt_out + (size_t)l * DM * DM, NLAT, DM, DM, smem);
                if (!last) ctx_small_tiles<1>(p, l, p.MIX + (size_t)NLAT * DM, p.wt_out + (size_t)l * DM * DM, DM, DM, smem);
                break;
        case 3: gemm_stream<2>(p, l, p.H, p.wt_ff1 + (size_t)l * FF * DM, NLAT, FF, DM, smem);
                if (!last) ctx_small_tiles<2>(p, l, p.H + (size_t)NLAT * DM, p.wt_ff1 + (size_t)l * FF * DM, FF, DM, smem);
                break;
        default: gemm_stream<3>(p, l, p.ACT, p.wt_ff2 + (size_t)l * DM * FF, NLAT, DM, FF, smem);
                if (!last) ctx_small_tiles<3>(p, l, p.ACT + (size_t)NLAT * FF, p.wt_ff2 + (size_t)l * DM * FF, DM, FF, smem);
                break;
    }
}

template <bool COOP>
__global__ void __launch_bounds__(512) mk_kernel(Params p, int ph_lo, int ph_hi) {
    __shared__ __attribute__((aligned(1024))) char smem_raw[2 * G_STAGE_B + 8192];
    ldsp_t smem = (ldsp_t)smem_raw;
    for (int ph = ph_lo; ph < ph_hi; ++ph) {
        run_phase(p, ph, smem);
#ifdef DUP_K
        if (ph > 1 && (ph - 2) % 5 == DUP_K) { cg::this_grid().sync(); run_phase(p, ph, smem); }
#endif
        if (COOP && ph + 1 < ph_hi) cg::this_grid().sync();
    }
}

extern "C" void kernel_launch(void* const* d_in, const int* in_sizes, int n_in, void* d_out, int out_size, void* d_ws, size_t ws_size, hipStream_t stream) {
    Params p{};
    p.x = (const float*)d_in[0]; p.c = (const float*)d_in[1]; p.ctx = (const float*)d_in[2]; p.c_ctx = (const float*)d_in[3];
    p.w_mod = (const float*)d_in[4]; p.b_mod = (const float*)d_in[5]; p.norm1_g = (const float*)d_in[6]; p.w_in = (const float*)d_in[7];
    p.q_norm_g = (const float*)d_in[8]; p.k_norm_g = (const float*)d_in[9]; p.gmlp_norm_g = (const float*)d_in[10]; p.w_spatial = (const float*)d_in[11];
    p.b_spatial = (const float*)d_in[12]; p.w_out = (const float*)d_in[13]; p.norm2_g = (const float*)d_in[14]; p.w_ff1 = (const float*)d_in[15]; p.w_ff2 = (const float*)d_in[16];
    p.out = (float*)d_out;
    char* w = (char*)d_ws; size_t off = 0;
    auto take = [&](size_t bytes) { char* r = w + off; off += (bytes + 1023) & ~(size_t)1023; return r; };
    p.wt_in = (bf16_t*)take((size_t)DEPTH * IN_DIM * DM * 2);
    p.wt_out = (bf16_t*)take((size_t)DEPTH * DM * DM * 2);
    p.wt_ff1 = (bf16_t*)take((size_t)DEPTH * FF * DM * 2);
    p.wt_ff2 = (bf16_t*)take((size_t)DEPTH * FF * DM * 2);
    p.ws_bf = (bf16_t*)take((size_t)DEPTH * 4 * 128 * 128 * 2);
    p.mod = (float*)take((size_t)DEPTH * 5 * 6144 * 4);
    p.rope = (float*)take(2048 * 4);
    p.xc = (float*)take((size_t)NCTX * DM * 4);
    p.smax = (float*)take(1024);
    p.ss = (float*)take((size_t)DEPTH * 2 * NTOK * 16 * 4);
    p.shw_in = (float*)take((size_t)DEPTH * 5 * IN_DIM * 4);
    p.shw_ff1 = (float*)take((size_t)DEPTH * 5 * FF * 4);
    p.H = (bf16_t*)take((size_t)NTOK * DM * 2);
    p.ACT = (bf16_t*)take((size_t)NTOK * FF * 2);
    {
        char* a = (char*)p.ACT; size_t o2 = 0;
        auto take2 = [&](size_t bytes) { char* r = a + o2; o2 += (bytes + 1023) & ~(size_t)1023; return r; };
        p.Q = (bf16_t*)take2((size_t)NLAT * 512 * 2);
        p.Qc = (bf16_t*)take2((size_t)NCTX * 512 * 2);
        p.K = (bf16_t*)take2((size_t)NB * 2 * NKEY * 64 * 2);
        p.Vt = (bf16_t*)take2((size_t)NB * 2 * NKEY * 64 * 2);
        p.U = (bf16_t*)take2((size_t)NTOK * 1024 * 2);
        p.MIX = (bf16_t*)take2((size_t)NTOK * DM * 2);
    }
    if (off > ws_size) { fprintf(stderr, "workspace too small: need %zu have %zu\n", off, ws_size); return; }
#if MK_COOP
    static int grid_blocks = 0;
    if (!grid_blocks) {
        int dev = 0, cus = 0, per_cu = 0;
        hipGetDevice(&dev);
        hipDeviceGetAttribute(&cus, hipDeviceAttributeMultiprocessorCount, dev);
        hipOccupancyMaxActiveBlocksPerMultiprocessor(&per_cu, mk_kernel<true>, 512, 0);
        if (per_cu < 1) per_cu = 1;
        grid_blocks = cus * 1;
    }
    int lo = 0, hi = N_PHASES;
    void* args[] = {&p, &lo, &hi};
    hipError_t e = hipLaunchCooperativeKernel((void*)mk_kernel<true>, dim3(grid_blocks), dim3(512), args, 0, stream);
    if (e != hipSuccess) fprintf(stderr, "cooperative launch failed: %s (grid %d)\n", hipGetErrorString(e), grid_blocks);
#else
    for (int ph = 0; ph < N_PHASES; ++ph) mk_kernel<false><<<256, 512, 0, stream>>>(p, ph, ph + 1);
#endif
}
```

```cpp
#include <hip/hip_runtime.h>
#include <hip/hip_cooperative_groups.h>
#include <stdint.h>
#include <cstdio>
namespace cg = cooperative_groups;

#ifndef MK_COOP
#define MK_COOP 1
#endif

#define DI __device__ __forceinline__
#define LDSP __attribute__((address_space(3)))
typedef LDSP char* ldsp_t;
typedef unsigned short bf16_t;
typedef short bf16x8 __attribute__((ext_vector_type(8)));
typedef float f32x2 __attribute__((ext_vector_type(2)));
typedef float f32x4 __attribute__((ext_vector_type(4)));
typedef float f32x16 __attribute__((ext_vector_type(16)));
typedef unsigned u32x2 __attribute__((ext_vector_type(2)));
typedef unsigned u32x4 __attribute__((ext_vector_type(4)));
typedef __bf16 bf2_t __attribute__((ext_vector_type(2)));

constexpr int DM = 1024, NB = 4, SEQ = 4096, DEPTH = 4, CTXL = 256;
constexpr int NLAT = NB * SEQ;
constexpr int NCTX = NB * CTXL;
constexpr int NTOK = NLAT + NCTX;
constexpr int IN_DIM = 1792, FF = 4096, NKEY = CTXL + SEQ;
constexpr float EPS = 1e-6f;
constexpr float LOG2E = 1.4426950408889634f;

struct Params {
    const float *x, *c, *ctx, *c_ctx, *w_mod, *b_mod, *norm1_g, *w_in, *q_norm_g, *k_norm_g, *gmlp_norm_g, *w_spatial, *b_spatial, *w_out, *norm2_g, *w_ff1, *w_ff2;
    float* out;
    bf16_t *wt_in, *wt_out, *wt_ff1, *wt_ff2, *ws_bf;
    float *mod, *rope, *xc, *smax, *ss, *shw_in, *shw_ff1;
    bf16_t *H, *Q, *Qc, *K, *Vt, *U, *MIX, *ACT;
};

DI unsigned pk2(float a, float b) { f32x2 v = {a, b}; bf2_t r = __builtin_convertvector(v, bf2_t); return __builtin_bit_cast(unsigned, r); }
DI bf16_t f2bf(float a) { return (bf16_t)(pk2(a, 0.f) & 0xffffu); }
DI float fexp2(float x) { return __builtin_amdgcn_exp2f(x); }
DI float gelu_tanh(float x) {
    const float y = 0.7978845608028654f * (x + 0.044715f * x * x * x);
    return x / (1.f + fexp2(-2.f * LOG2E * y));
}
DI float* xrow_ptr(const Params& p, int row) { return row < NLAT ? p.out + (size_t)row * DM : p.xc + (size_t)(row - NLAT) * DM; }

DI void transpose_tile(const float* __restrict__ src, bf16_t* __restrict__ dst, int K, int N, int tk, int tn, ldsp_t smem) {
    LDSP float* t = (LDSP float*)smem;
    const int tid = threadIdx.x, k0 = tk * 64, n0 = tn * 256;
    f32x4 v[8];
#pragma unroll
    for (int i = 0; i < 8; ++i) v[i] = *(const f32x4*)(src + (size_t)(k0 + (tid >> 6) + 8 * i) * N + n0 + (tid & 63) * 4);
#pragma unroll
    for (int i = 0; i < 8; ++i) {
        const int k = (tid >> 6) + 8 * i, n4 = (tid & 63) * 4;
        t[k * 257 + n4 + 0] = v[i][0]; t[k * 257 + n4 + 1] = v[i][1]; t[k * 257 + n4 + 2] = v[i][2]; t[k * 257 + n4 + 3] = v[i][3];
    }
    __syncthreads();
#pragma unroll
    for (int j = 0; j < 4; ++j) {
        const int n = (tid >> 3) + 64 * j, k8 = (tid & 7) * 8;
        u32x4 w;
        w[0] = pk2(t[(k8 + 0) * 257 + n], t[(k8 + 1) * 257 + n]);
        w[1] = pk2(t[(k8 + 2) * 257 + n], t[(k8 + 3) * 257 + n]);
        w[2] = pk2(t[(k8 + 4) * 257 + n], t[(k8 + 5) * 257 + n]);
        w[3] = pk2(t[(k8 + 6) * 257 + n], t[(k8 + 7) * 257 + n]);
        *(u32x4*)(dst + (size_t)(n0 + n) * K + k0 + k8) = w;
    }
    __syncthreads();
}

DI void mod_unit(const Params& p, int l, int cgi, ldsp_t smem) {
    LDSP float* s = (LDSP float*)smem;
    LDSP float* red = (LDSP float*)(smem + 20480);
    const int tid = threadIdx.x;
    for (int i = tid; i < 5 * 1024; i += 512) {
        const int cnd = i >> 10, k = i & 1023;
        const float v = cnd < 4 ? p.c[cnd * 1024 + k] : p.c_ctx[k];
        s[i] = v / (1.f + fexp2(-LOG2E * v));
    }
    __syncthreads();
    const int c4 = tid & 15, ks = tid >> 4;
    f32x4 acc[5];
#pragma unroll
    for (int q = 0; q < 5; ++q) acc[q] = (f32x4){0.f, 0.f, 0.f, 0.f};
    const float* wp = p.w_mod + ((size_t)l * 1024 + ks * 32) * 6144 + cgi * 64 + c4 * 4;
#pragma unroll 8
    for (int kk = 0; kk < 32; ++kk) {
        const f32x4 w = *(const f32x4*)(wp + (size_t)kk * 6144);
        const int k = ks * 32 + kk;
#pragma unroll
        for (int q = 0; q < 5; ++q) acc[q] += w * s[q * 1024 + k];
    }
#pragma unroll
    for (int q = 0; q < 5; ++q)
#pragma unroll
        for (int j = 0; j < 4; ++j) red[(ks * 5 + q) * 64 + c4 * 4 + j] = acc[q][j];
    __syncthreads();
    if (tid < 320) {
        const int q = tid >> 6, col = tid & 63;
        float a = 0.f;
        for (int k2 = 0; k2 < 32; ++k2) a += red[(k2 * 5 + q) * 64 + col];
        const int j = cgi * 64 + col;
        p.mod[((size_t)l * 5 + q) * 6144 + j] = a + p.b_mod[(size_t)l * 6144 + j];
    }
    __syncthreads();
}

DI void phase0(const Params& p, ldsp_t smem) {
    constexpr int T_IN = 16 * 7, T_OUT = 16 * 4, T_FF1 = 16 * 16, T_FF2 = 64 * 4;
    constexpr int T_L = T_IN + T_OUT + T_FF1 + T_FF2;
    constexpr int U_T = DEPTH * T_L;
    constexpr int U_MOD = DEPTH * 96;
    constexpr int U_WS = 64;
    constexpr int U_ALL = U_MOD + U_T + U_WS + 1;
    for (int u = blockIdx.x; u < U_ALL; u += gridDim.x) {
        if (u < U_MOD) { mod_unit(p, u / 96, u % 96, smem); continue; }
        int v = u - U_MOD;
        if (v < U_T) {
            const int l = v / T_L; int r = v % T_L;
            if (r < T_IN) { transpose_tile(p.w_in + (size_t)l * DM * IN_DIM, p.wt_in + (size_t)l * IN_DIM * DM, DM, IN_DIM, r / 7, r % 7, smem); continue; }
            r -= T_IN;
            if (r < T_OUT) { transpose_tile(p.w_out + (size_t)l * DM * DM, p.wt_out + (size_t)l * DM * DM, DM, DM, r / 4, r % 4, smem); continue; }
            r -= T_OUT;
            if (r < T_FF1) { transpose_tile(p.w_ff1 + (size_t)l * DM * FF, p.wt_ff1 + (size_t)l * FF * DM, DM, FF, r / 16, r % 16, smem); continue; }
            r -= T_FF1;
            transpose_tile(p.w_ff2 + (size_t)l * FF * DM, p.wt_ff2 + (size_t)l * DM * FF, FF, DM, r / 4, r % 4, smem); continue;
        }
        v -= U_T;
        if (v < U_WS) {
            const size_t i = ((size_t)v * 512 + threadIdx.x) * 8;
            const f32x4 a = *(const f32x4*)(p.w_spatial + i), b = *(const f32x4*)(p.w_spatial + i + 4);
            u32x4 w; w[0] = pk2(a[0], a[1]); w[1] = pk2(a[2], a[3]); w[2] = pk2(b[0], b[1]); w[3] = pk2(b[2], b[3]);
            *(u32x4*)(p.ws_bf + i) = w;
            continue;
        }
        int ti = threadIdx.x;
        asm volatile("" : "+v"(ti));
        if (ti < DEPTH) {
            float mq = 0.f, mk = 0.f;
            for (int i = 0; i < 64; ++i) { mq = fmaxf(mq, fabsf(p.q_norm_g[ti * 64 + i])); mk = fmaxf(mk, fabsf(p.k_norm_g[ti * 64 + i])); }
            p.smax[ti] = 8.f * mq * mk;
        }
        for (int i = threadIdx.x; i < 1024; i += 512) {
            const int pos = i >> 4, f = i & 15;
            const float inv = fexp2(-(float)f * (13.287712379549449f / 16.f));
            const float rev = (float)pos * inv * 0.15915494309189535f;
            p.rope[i] = __builtin_amdgcn_cosf(rev);
            p.rope[1024 + i] = __builtin_amdgcn_sinf(rev);
        }
    }
}

DI void phase1(const Params& p) {
    int tid = threadIdx.x;
    asm volatile("" : "+v"(tid));
    const int lane = tid & 63, wid = tid >> 6;
    const int gw = blockIdx.x * 8 + wid, nw = gridDim.x * 8;
    for (int row = gw; row < NTOK; row += nw) {
        const float* src = row < NLAT ? p.x + (size_t)row * DM : p.ctx + (size_t)(row - NLAT) * DM;
        const int cond = row < NLAT ? (row >> 12) : 4;
        const float* mp = p.mod + ((size_t)cond) * 6144;
        f32x4 v[4];
        float ss = 0.f;
#pragma unroll
        for (int i = 0; i < 4; ++i) { v[i] = *(const f32x4*)(src + i * 256 + lane * 4); ss += v[i][0] * v[i][0] + v[i][1] * v[i][1] + v[i][2] * v[i][2] + v[i][3] * v[i][3]; }
#pragma unroll
        for (int o = 1; o < 64; o <<= 1) ss += __shfl_xor(ss, o);
        if (lane < 16) p.ss[(size_t)row * 16 + lane] = lane == 0 ? ss : 0.f;
        bf16_t* hp = p.H + (size_t)row * DM;
        float* xw = xrow_ptr(p, row);
#pragma unroll
        for (int i = 0; i < 4; ++i) {
            const int idx = i * 256 + lane * 4;
            const f32x4 gg = *(const f32x4*)(p.norm1_g + idx), sc = *(const f32x4*)(mp + DM + idx);
            f32x4 y;
#pragma unroll
            for (int j = 0; j < 4; ++j) y[j] = v[i][j] * gg[j] * (1.f + sc[j]);
            u32x2 w; w[0] = pk2(y[0], y[1]); w[1] = pk2(y[2], y[3]);
            *(u32x2*)(hp + idx) = w;
            *(f32x4*)(xw + idx) = v[i];
        }
    }
    {
        const int fr = lane & 15, fq = lane >> 4;
        constexpr int G_IN = IN_DIM / 16, G_FF = FF / 16, G_L = G_IN + G_FF;
        for (int gi = gw; gi < DEPTH * G_L; gi += nw) {
            const int l = gi / G_L, r = gi % G_L;
            const bool which = r >= G_IN;
            const int n0 = (which ? r - G_IN : r) * 16;
            const int N = which ? FF : IN_DIM;
            const bf16_t* W = (which ? p.wt_ff1 + (size_t)l * FF * DM : p.wt_in + (size_t)l * IN_DIM * DM) + (size_t)(n0 + fr) * DM + fq * 8;
            float* dst = which ? p.shw_ff1 + (size_t)l * 5 * FF : p.shw_in + (size_t)l * 5 * IN_DIM;
            const int c = fr < 5 ? fr : fr - 5;
            const float* sh = p.mod + ((size_t)l * 5 + (c < 5 ? c : 0)) * 6144 + (which ? 3 : 0) * DM + fq * 8;
            f32x4 acc = {0.f, 0.f, 0.f, 0.f};
#pragma unroll 8
            for (int ks = 0; ks < 32; ++ks) {
                const bf16x8 wv = *(const bf16x8*)(W + ks * 32);
                const f32x4 s0 = *(const f32x4*)(sh + ks * 32), s1 = *(const f32x4*)(sh + ks * 32 + 4);
                float sv[8] = {s0[0], s0[1], s0[2], s0[3], s1[0], s1[1], s1[2], s1[3]};
                u32x4 aw;
#pragma unroll
                for (int j = 0; j < 4; ++j) {
                    float a0 = sv[2 * j], a1 = sv[2 * j + 1];
                    const unsigned hi = pk2(a0, a1);
                    if (fr >= 5) { a0 -= __uint_as_float(hi << 16); a1 -= __uint_as_float(hi & 0xffff0000u); }
                    aw[j] = fr < 5 ? hi : (fr < 10 ? pk2(a0, a1) : 0u);
                }
                acc = __builtin_amdgcn_mfma_f32_16x16x32_bf16(__builtin_bit_cast(bf16x8, aw), wv, acc, 0, 0, 0);
            }
            const float r4 = __shfl(acc[0], fr + 16);
            const float r5 = __shfl(acc[1], fr + 16), r6 = __shfl(acc[2], fr + 16), r7 = __shfl(acc[3], fr + 16);
            const float r8 = __shfl(acc[0], fr + 32), r9 = __shfl(acc[1], fr + 32);
            if (fq == 0) {
                dst[(size_t)0 * N + n0 + fr] = acc[0] + r5;
                dst[(size_t)1 * N + n0 + fr] = acc[1] + r6;
                dst[(size_t)2 * N + n0 + fr] = acc[2] + r7;
                dst[(size_t)3 * N + n0 + fr] = acc[3] + r8;
                dst[(size_t)4 * N + n0 + fr] = r4 + r9;
            }
        }
    }
}

constexpr int G_TILE_B = 256 * 64 * 2, G_STAGE_B = 2 * G_TILE_B;
DI int lds_byte2(int r, int c) {
    const int st = (r >> 4) * 2 + (c >> 5), ob = (r & 15) * 64 + (c & 31) * 2;
    return st * 1024 + (ob ^ (((ob >> 9) & 1) << 5));
}
DI void stage_rc2(int b, int& R, int& C) {
    const int st = b >> 10, sb = b & 1023, swz = sb ^ (((sb >> 9) & 1) << 5);
    R = (st >> 1) * 16 + swz / 64;
    C = (st & 1) * 32 + (swz % 64) / 2;
}
#define WAIT_V0() asm volatile("s_waitcnt vmcnt(0)" ::: "memory")

struct TileCtx { int brow, bcol, pn, wr, wc, fr, fq, wid, lane, l; };

DI void tile_coords(int L, int nM, int nN, int& pm, int& pn) {
    const int nwg = nM * nN;
    int wgid = L;
    { const int q = nwg / 8, r = nwg % 8, xcd = wgid % 8, off = wgid / 8; wgid = (xcd < r ? xcd * (q + 1) : r * (q + 1) + (xcd - r) * q) + off; }
    const int nig = 8 * nN, gid = wgid / nig, fm = gid * 8, gsz = (nM - fm) < 8 ? (nM - fm) : 8;
    pm = fm + ((wgid % nig) % gsz); pn = (wgid % nig) / gsz;
}

DI void wave_put(ldsp_t wb, int rowl, int n, int fq, u32x2 w) {
    const int chunk = n * 2 + (fq >> 1);
    *(LDSP u32x2*)(wb + rowl * 128 + ((chunk ^ (rowl & 7)) << 4) + (fq & 1) * 8) = w;
}
DI void wave_rows_store(ldsp_t wb, int lane, bf16_t* dst0, size_t ld) {
#pragma unroll
    for (int i = 0; i < 8; ++i) {
        const int row = i * 8 + (lane >> 3), ch = lane & 7;
        const u32x4 v = *(const LDSP u32x4*)(wb + row * 128 + ((ch ^ (row & 7)) << 4));
        *(u32x4*)(dst0 + (size_t)row * ld + ch * 8) = v;
    }
}

template <int EK> struct EpiResid {
    static DI void run(const f32x4 (&acc)[8][4], const TileCtx& tc, const Params& p, ldsp_t wb) {
        constexpr int GI = EK == 1 ? 2 : 5;
        const int cond = tc.brow < NLAT ? (tc.brow >> 12) : 4;
        const float* gate = p.mod + ((size_t)tc.l * 5 + cond) * 6144 + GI * DM;
        const int col0 = tc.bcol + tc.wc * 64 + tc.fq * 4;
        const bool has_next = EK == 1 || tc.l + 1 < DEPTH;
        const int ln = EK == 1 ? tc.l : (has_next ? tc.l + 1 : tc.l);
        const float* gnx = (EK == 1 ? p.norm2_g : p.norm1_g) + (size_t)ln * DM + col0;
        const float* scn = p.mod + ((size_t)ln * 5 + cond) * 6144 + (EK == 1 ? 4 : 1) * DM + col0;
        float* ssp = p.ss + (size_t)(ln * 2 + (EK == 1 ? 1 : 0)) * NTOK * 16 + (tc.bcol >> 8) * 4 + tc.wc;
        f32x4 gv[4], av[4];
#pragma unroll
        for (int n = 0; n < 4; ++n) {
            gv[n] = *(const f32x4*)(gate + col0 + n * 16);
            const f32x4 g1 = *(const f32x4*)(gnx + n * 16), s1 = *(const f32x4*)(scn + n * 16);
            av[n] = g1 * (1.f + s1);
        }
#pragma unroll
        for (int h = 0; h < 2; ++h) {
#pragma unroll
            for (int mm = 0; mm < 4; ++mm) { __builtin_amdgcn_sched_barrier(0);
                const int m = h * 4 + mm;
                const int row = tc.brow + tc.wr * 128 + m * 16 + tc.fr;
                float* xr = xrow_ptr(p, row) + col0;
                float part = 0.f;
#pragma unroll
                for (int n = 0; n < 4; ++n) {
                    f32x4 xv = *(const f32x4*)(xr + n * 16);
                    xv += gv[n] * acc[m][n];
                    *(f32x4*)(xr + n * 16) = xv;
                    if (has_next) {
                        part += xv[0] * xv[0] + xv[1] * xv[1] + xv[2] * xv[2] + xv[3] * xv[3];
                        const f32x4 hv = xv * av[n];
                        u32x2 w; w[0] = pk2(hv[0], hv[1]); w[1] = pk2(hv[2], hv[3]);
                        wave_put(wb, mm * 16 + tc.fr, n, tc.fq, w);
                    }
                }
                if (has_next) {
                    part += __shfl_xor(part, 16);
                    part += __shfl_xor(part, 32);
                    if (tc.fq == 0) ssp[(size_t)row * 16] = part;
                }
            }
            if (has_next) wave_rows_store(wb, tc.lane, p.H + (size_t)(tc.brow + tc.wr * 128 + h * 64) * DM + tc.bcol + tc.wc * 64, DM);
        }
    }
};
struct EpiFF1 {
    static DI void run(const f32x4 (&acc)[8][4], const TileCtx& tc, const Params& p, ldsp_t wb) {
#pragma unroll
        for (int h = 0; h < 2; ++h) {
#pragma unroll
            for (int mm = 0; mm < 4; ++mm) {
                const int m = h * 4 + mm;
#pragma unroll
                for (int n = 0; n < 4; ++n) {
                    f32x4 a = acc[m][n];
#pragma unroll
                    for (int j = 0; j < 4; ++j) { const float r = fmaxf(a[j], 0.f); a[j] = r * r; }
                    u32x2 w; w[0] = pk2(a[0], a[1]); w[1] = pk2(a[2], a[3]);
                    wave_put(wb, mm * 16 + tc.fr, n, tc.fq, w);
                }
            }
            wave_rows_store(wb, tc.lane, p.ACT + (size_t)(tc.brow + tc.wr * 128 + h * 64) * FF + tc.bcol + tc.wc * 64, FF);
        }
    }
};
template <int BRK> struct EpiIn {
    static DI void run(const f32x4 (&acc)[8][4], const TileCtx& tc, const Params& p, ldsp_t wb) {
        const int l = tc.l, pn = tc.pn, wc = tc.wc, fr = tc.fr, fq = tc.fq;
        if (BRK == 0 || (BRK == 1 && wc < 2)) {
            constexpr bool isq = BRK == 0;
            const int head = isq ? pn * 4 + wc : wc;
            const float* gn = (isq ? p.q_norm_g : p.k_norm_g) + l * 64;
            f32x4 gv[4];
#pragma unroll
            for (int n = 0; n < 4; ++n) gv[n] = *(const f32x4*)(gn + n * 16 + fq * 4);
            const float osc = isq ? 0.125f : 1.f;
            const bool lat = tc.brow < NLAT;
#pragma unroll
            for (int h = 0; h < 2; ++h) {
#pragma unroll
                for (int mm = 0; mm < 4; ++mm) { __builtin_amdgcn_sched_barrier(0);
                    const int m = h * 4 + mm;
                    const int row = tc.brow + tc.wr * 128 + m * 16 + fr;
                    float ss = 0.f;
#pragma unroll
                    for (int n = 0; n < 4; ++n)
#pragma unroll
                        for (int j = 0; j < 4; ++j) ss += acc[m][n][j] * acc[m][n][j];
                    ss += __shfl_xor(ss, 16);
                    ss += __shfl_xor(ss, 32);
                    const float rstd = rsqrtf(ss * (1.f / 64.f) + EPS) * osc;
                    const int t = row & 4095;
#pragma unroll
                    for (int ax = 0; ax < 2; ++ax) {
                        f32x4 x1 = acc[m][2 * ax] * rstd * gv[2 * ax], x2 = acc[m][2 * ax + 1] * rstd * gv[2 * ax + 1];
                        if (lat) {
                            const int pos = ax == 0 ? (t >> 6) : (t & 63);
                            const f32x4 cs = *(const f32x4*)(p.rope + pos * 16 + fq * 4), sn = *(const f32x4*)(p.rope + 1024 + pos * 16 + fq * 4);
                            const f32x4 o1 = x1 * cs - x2 * sn, o2 = x2 * cs + x1 * sn;
                            x1 = o1; x2 = o2;
                        }
                        u32x2 w; w[0] = pk2(x1[0], x1[1]); w[1] = pk2(x1[2], x1[3]);
                        wave_put(wb, mm * 16 + fr, 2 * ax, fq, w);
                        w[0] = pk2(x2[0], x2[1]); w[1] = pk2(x2[2], x2[3]);
                        wave_put(wb, mm * 16 + fr, 2 * ax + 1, fq, w);
                    }
                }
                const int row0 = tc.brow + tc.wr * 128 + h * 64;
                bf16_t* dst0;
                if (lat) {
                    const int b = row0 >> 12, t0 = row0 & 4095;
                    dst0 = isq ? p.Q + ((size_t)(b * 8 + head) * SEQ + t0) * 64 : p.K + ((size_t)(b * 2 + head) * NKEY + CTXL + t0) * 64;
                } else {
                    const int r2 = row0 - NLAT, b = r2 >> 8, t0 = r2 & 255;
                    dst0 = isq ? p.Qc + ((size_t)(b * 8 + head) * CTXL + t0) * 64 : p.K + ((size_t)(b * 2 + head) * NKEY + t0) * 64;
                }
                wave_rows_store(wb, tc.lane, dst0, 64);
            }
        } else if (BRK == 1) {
            const int kvh = wc - 2;
#pragma unroll
            for (int m = 0; m < 8; ++m) { __builtin_amdgcn_sched_barrier(0);
                const int row = tc.brow + tc.wr * 128 + m * 16 + fr;
                int b, pos;
                if (row < NLAT) { b = row >> 12; pos = CTXL + (row & 4095); } else { const int r2 = row - NLAT; b = r2 >> 8; pos = r2 & 255; }
                const int k16 = pos & 15;
                pos = (pos & ~15) | ((((k16 >> 2) & 1) << 3) + (k16 & 3) + ((k16 >> 3) << 2));
                bf16_t* dst = p.Vt + (size_t)(b * 2 + kvh) * 64 * NKEY + pos;
#pragma unroll
                for (int n = 0; n < 4; ++n)
#pragma unroll
                    for (int j = 0; j < 4; ++j) dst[(size_t)(n * 16 + fq * 4 + j) * NKEY] = f2bf(acc[m][n][j]);
            }
        } else if (BRK == 2) {
#pragma unroll
            for (int h = 0; h < 2; ++h) {
#pragma unroll
                for (int mm = 0; mm < 4; ++mm) {
                    const int m = h * 4 + mm;
#pragma unroll
                    for (int n = 0; n < 4; ++n) {
                        u32x2 w; w[0] = pk2(gelu_tanh(acc[m][n][0]), gelu_tanh(acc[m][n][1])); w[1] = pk2(gelu_tanh(acc[m][n][2]), gelu_tanh(acc[m][n][3]));
                        wave_put(wb, mm * 16 + fr, n, fq, w);
                    }
                }
                wave_rows_store(wb, tc.lane, p.U + (size_t)(tc.brow + tc.wr * 128 + h * 64) * 1024 + (pn - 3) * 256 + wc * 64, 1024);
            }
        }
    }
};

template <int EK>
DI void gemm_stream(const Params& p, int l, const bf16_t* __restrict__ A, const bf16_t* __restrict__ Bt, int M, int N, int K, ldsp_t shm) {
    const int nM = M / 256, nN = N / 256, nwg = nM * nN;
    int L = blockIdx.x;
    if (L >= nwg) return;
#define G_SA(b) (shm + (b) * G_STAGE_B)
#define G_SB(b) (shm + (b) * G_STAGE_B + G_TILE_B)
#define G_LANE_SETUP() \
    int tid_ = threadIdx.x; \
    asm volatile("" : "+v"(tid_));    \
    const int wid = tid_ >> 6, lane = tid_ & 63, wr = wid >> 2, wc = wid & 3, fr = lane & 15, fq = lane >> 4; \
    unsigned soff[4];        \
    _Pragma("unroll") for (int i = 0; i < 4; ++i) { int sR, sC; stage_rc2(wid * 1024 + i * 8192 + lane * 16, sR, sC); soff[i] = (unsigned)(sR * K + sC) * 2u; }
#define G_STAGE(Ap, Bp, buf, kt) do { const char* ab_ = (const char*)(Ap) + (size_t)(kt) * 128; const char* bb_ = (const char*)(Bp) + (size_t)(kt) * 128; \
      _Pragma("unroll") for (int i = 0; i < 4; ++i) { \
        __builtin_amdgcn_global_load_lds((const unsigned*)(ab_ + soff[i]), (LDSP unsigned*)(G_SA(buf) + wid * 1024 + i * 8192), 16, 0, 0); \
        __builtin_amdgcn_global_load_lds((const unsigned*)(bb_ + soff[i]), (LDSP unsigned*)(G_SB(buf) + wid * 1024 + i * 8192), 16, 0, 0); } } while (0)
    const int nt = K / 64;
    int pm, pn;
    tile_coords(L, nM, nN, pm, pn);
    const bf16_t* Ab = A + (size_t)pm * 256 * K;
    const bf16_t* Bb = Bt + (size_t)pn * 256 * K;
    { G_LANE_SETUP(); (void)wr; (void)wc; (void)fr; (void)fq; G_STAGE(Ab, Bb, 0, 0); WAIT_V0(); __syncthreads(); }
    while (true) {
        G_LANE_SETUP();
        const int aoff = lds_byte2(wr * 128 + fr, fq * 8), boff = lds_byte2(wc * 64 + fr, fq * 8);
        f32x4 acc[8][4];
#pragma unroll
        for (int m = 0; m < 8; ++m)
#pragma unroll
            for (int n = 0; n < 4; ++n) acc[m][n] = (f32x4){0.f, 0.f, 0.f, 0.f};
        const int Ln = L + gridDim.x;
        const bool has_next = Ln < nwg;
        int pm2 = pm, pn2 = pn;
        if (has_next) tile_coords(Ln, nM, nN, pm2, pn2);
        const bf16_t* Ab2 = A + (size_t)pm2 * 256 * K;
        const bf16_t* Bb2 = Bt + (size_t)pn2 * 256 * K;
        for (int t = 0; t < nt; ++t) {
            const int cur = t & 1;
            if (t + 1 < nt) G_STAGE(Ab, Bb, cur ^ 1, t + 1);
            else if (has_next) G_STAGE(Ab2, Bb2, cur ^ 1, 0);
#pragma unroll
            for (int ks = 0; ks < 2; ++ks) {
                bf16x8 At[8], Bf[4];
#pragma unroll
                for (int m = 0; m < 8; ++m) At[m] = *(const LDSP bf16x8*)(G_SA(cur) + aoff + m * 2048 + ks * 1024);
#pragma unroll
                for (int n = 0; n < 4; ++n) Bf[n] = *(const LDSP bf16x8*)(G_SB(cur) + boff + n * 2048 + ks * 1024);
                __builtin_amdgcn_sched_barrier(0);
#pragma unroll
                for (int m = 0; m < 8; ++m)
#pragma unroll
                    for (int n = 0; n < 4; ++n) acc[m][n] = __builtin_amdgcn_mfma_f32_16x16x32_bf16(Bf[n], At[m], acc[m][n], 0, 0, 0);
                __builtin_amdgcn_sched_barrier(0);
            }
            WAIT_V0(); __syncthreads();
        }
        {
            int tid2 = threadIdx.x, pme = pm, pne = pn;
            asm volatile("" : "+v"(tid2), "+s"(pme), "+s"(pne));
            TileCtx tc;
            tc.wid = tid2 >> 6; tc.lane = tid2 & 63; tc.wr = tc.wid >> 2; tc.wc = tc.wid & 3; tc.fr = tc.lane & 15; tc.fq = tc.lane >> 4; tc.l = l;
            tc.brow = pme * 256; tc.bcol = pne * 256; tc.pn = pne;
            ldsp_t ex = shm + G_STAGE_B + tc.wid * 8192;
            if (EK == 0 || EK == 2) {
                const int cond = tc.brow < NLAT ? (tc.brow >> 12) : 4;
                const float* ssp = p.ss + ((size_t)(l * 2 + (EK == 0 ? 0 : 1)) * NTOK + tc.brow + tc.wr * 128 + tc.fr) * 16 + tc.fq * 4;
                const float* shw = (EK == 0 ? p.shw_in + ((size_t)l * 5 + cond) * IN_DIM : p.shw_ff1 + ((size_t)l * 5 + cond) * FF) + tc.bcol + tc.wc * 64 + tc.fq * 4;
                f32x4 shv[4];
#pragma unroll
                for (int n = 0; n < 4; ++n) shv[n] = *(const f32x4*)(shw + n * 16);
#pragma unroll
                for (int m = 0; m < 8; ++m) {
                    const f32x4 pp = *(const f32x4*)(ssp + m * 256);
                    float sq = pp[0] + pp[1] + pp[2] + pp[3];
                    sq += __shfl_xor(sq, 16);
                    sq += __shfl_xor(sq, 32);
                    const float rstd = rsqrtf(sq * (1.f / DM) + EPS);
#pragma unroll
                    for (int n = 0; n < 4; ++n) acc[m][n] = acc[m][n] * rstd + shv[n];
                }
            }
            if (EK == 0) {
                if (pne < 2) EpiIn<0>::run(acc, tc, p, ex);
                else if (pne == 2) EpiIn<1>::run(acc, tc, p, ex);
                else EpiIn<2>::run(acc, tc, p, ex);
            } else if (EK == 1) EpiResid<1>::run(acc, tc, p, ex);
            else if (EK == 2) EpiFF1::run(acc, tc, p, ex);
            else EpiResid<3>::run(acc, tc, p, ex);
        }
        __syncthreads();
        if (!has_next) break;
        L = Ln; pm = pm2; pn = pn2; Ab = Ab2; Bb = Bb2;
    }
}

template <int EK>
DI void ctx_item(const Params& p, int l, int grow, int gcol, int slot, f32x4 s0, f32x4 s1, bool lead) {
    if (EK == 2) {
        const float* pp = p.ss + ((size_t)(l * 2 + 1) * NTOK + NLAT + grow) * 16;
        const f32x4 q0 = *(const f32x4*)pp, q1 = *(const f32x4*)(pp + 4), q2 = *(const f32x4*)(pp + 8), q3 = *(const f32x4*)(pp + 12);
        const f32x4 qs = q0 + q1 + q2 + q3;
        const float rstd = rsqrtf((qs[0] + qs[1] + qs[2] + qs[3]) * (1.f / DM) + EPS);
        const float* shw = p.shw_ff1 + ((size_t)l * 5 + 4) * FF + gcol;
        const f32x4 h0 = *(const f32x4*)shw, h1 = *(const f32x4*)(shw + 4);
        s0 = s0 * rstd + h0; s1 = s1 * rstd + h1;
#pragma unroll
        for (int j = 0; j < 4; ++j) { float r0 = fmaxf(s0[j], 0.f), r1 = fmaxf(s1[j], 0.f); s0[j] = r0 * r0; s1[j] = r1 * r1; }
        u32x4 w; w[0] = pk2(s0[0], s0[1]); w[1] = pk2(s0[2], s0[3]); w[2] = pk2(s1[0], s1[1]); w[3] = pk2(s1[2], s1[3]);
        *(u32x4*)(p.ACT + (size_t)(NLAT + grow) * FF + gcol) = w;
    } else {
        const float* gate = p.mod + ((size_t)l * 5 + 4) * 6144 + (EK == 1 ? 2 : 5) * DM + gcol;
        float* xr = p.xc + (size_t)grow * DM + gcol;
        const f32x4 g0 = *(const f32x4*)gate, g1 = *(const f32x4*)(gate + 4);
        f32x4 x0 = *(const f32x4*)xr, x1 = *(const f32x4*)(xr + 4);
        x0 += g0 * s0; x1 += g1 * s1;
        *(f32x4*)xr = x0; *(f32x4*)(xr + 4) = x1;
        const int ln = EK == 1 ? l : l + 1;
        const float* gnx = (EK == 1 ? p.norm2_g : p.norm1_g) + (size_t)ln * DM + gcol;
        const float* scn = p.mod + ((size_t)ln * 5 + 4) * 6144 + (EK == 1 ? 4 : 1) * DM + gcol;
        const f32x4 a0 = *(const f32x4*)gnx * (1.f + *(const f32x4*)scn), a1 = *(const f32x4*)(gnx + 4) * (1.f + *(const f32x4*)(scn + 4));
        const f32x4 y0 = x0 * a0, y1 = x1 * a1;
        u32x4 w; w[0] = pk2(y0[0], y0[1]); w[1] = pk2(y0[2], y0[3]); w[2] = pk2(y1[0], y1[1]); w[3] = pk2(y1[2], y1[3]);
        *(u32x4*)(p.H + (size_t)(NLAT + grow) * DM + gcol) = w;
        float part = x0[0] * x0[0] + x0[1] * x0[1] + x0[2] * x0[2] + x0[3] * x0[3] + x1[0] * x1[0] + x1[1] * x1[1] + x1[2] * x1[2] + x1[3] * x1[3];
        part += __shfl_xor(part, 1); part += __shfl_xor(part, 2); part += __shfl_xor(part, 4);
        if (lead) p.ss[((size_t)(ln * 2 + (EK == 1 ? 1 : 0)) * NTOK + NLAT + grow) * 16 + slot] = part;
    }
}

template <int EK, int TS>
DI void ctx_tiles(const Params& p, int l, const bf16_t* __restrict__ A, const bf16_t* __restrict__ Bt, int N, int K, ldsp_t shm) {
    constexpr int WM = TS / 2, WN = TS / 4, MT = WM / 16, NT = WN / 16;
    constexpr int TILE_A = TS * 64 * 2, PP = TILE_A / 8192;
    const int ntn = N / TS, ntiles = (NCTX / TS) * ntn, nt = K / 64;
    for (int u = blockIdx.x; u < ntiles; u += gridDim.x) {
        const int tm = u / ntn, tn = u % ntn;
        int tid = threadIdx.x;
        asm volatile("" : "+v"(tid));
        const int wid = tid >> 6, lane = tid & 63, wr = wid >> 2, wc = wid & 3, fr = lane & 15, fq = lane >> 4;
        unsigned soff[PP];
#pragma unroll
        for (int i = 0; i < PP; ++i) { int sR, sC; stage_rc2((wid * PP + i) * 1024 + lane * 16, sR, sC); soff[i] = (unsigned)(sR * K + sC) * 2u; }
        const bf16_t* Ab = A + (size_t)tm * TS * K;
        const bf16_t* Bb = Bt + (size_t)tn * TS * K;
#define C_STAGE(buf, kt) do { const char* ab_ = (const char*)Ab + (size_t)(kt) * 128; const char* bb_ = (const char*)Bb + (size_t)(kt) * 128; \
      _Pragma("unroll") for (int i = 0; i < PP; ++i) { \
        __builtin_amdgcn_global_load_lds((const unsigned*)(ab_ + soff[i]), (LDSP unsigned*)(shm + (buf) * 2 * TILE_A + (wid * PP + i) * 1024), 16, 0, 0); \
        __builtin_amdgcn_global_load_lds((const unsigned*)(bb_ + soff[i]), (LDSP unsigned*)(shm + (buf) * 2 * TILE_A + TILE_A + (wid * PP + i) * 1024), 16, 0, 0); } } while (0)
        f32x4 acc[MT][NT];
#pragma unroll
        for (int m = 0; m < MT; ++m)
#pragma unroll
            for (int n = 0; n < NT; ++n) acc[m][n] = (f32x4){0.f, 0.f, 0.f, 0.f};
        C_STAGE(0, 0); WAIT_V0(); __syncthreads();
        for (int t = 0; t < nt; ++t) {
            const int cur = t & 1;
            if (t + 1 < nt) C_STAGE(cur ^ 1, t + 1);
            ldsp_t sa = shm + cur * 2 * TILE_A, sb = sa + TILE_A;
#pragma unroll
            for (int ks = 0; ks < 2; ++ks) {
                bf16x8 At[MT], Bf[NT];
#pragma unroll
                for (int m = 0; m < MT; ++m) At[m] = *(const LDSP bf16x8*)(sa + lds_byte2(wr * WM + m * 16 + fr, ks * 32 + fq * 8));
#pragma unroll
                for (int n = 0; n < NT; ++n) Bf[n] = *(const LDSP bf16x8*)(sb + lds_byte2(wc * WN + n * 16 + fr, ks * 32 + fq * 8));
#pragma unroll
                for (int m = 0; m < MT; ++m)
#pragma unroll
                    for (int n = 0; n < NT; ++n) acc[m][n] = __builtin_amdgcn_mfma_f32_16x16x32_bf16(Bf[n], At[m], acc[m][n], 0, 0, 0);
            }
            WAIT_V0(); __syncthreads();
        }
#pragma unroll
        for (int m = 0; m < MT; ++m)
#pragma unroll
            for (int n = 0; n < NT; ++n) {
                const int row = wr * WM + m * 16 + fr, ch = (wc * WN + n * 16 + fq * 4) >> 2;
                *(LDSP f32x4*)(shm + row * (TS * 4) + ((ch ^ (row & 15)) << 4)) = acc[m][n];
            }
        __syncthreads();
#pragma unroll
        for (int it = 0; it < (TS * TS / 8) / 512; ++it) {
            const int item = it * 512 + tid, row = item / (TS / 8), c8 = item % (TS / 8);
            const f32x4 s0 = *(const LDSP f32x4*)(shm + row * (TS * 4) + (((2 * c8) ^ (row & 15)) << 4));
            const f32x4 s1 = *(const LDSP f32x4*)(shm + row * (TS * 4) + (((2 * c8 + 1) ^ (row & 15)) << 4));
            ctx_item<EK>(p, l, tm * TS + row, tn * TS + c8 * 8, tn, s0, s1, c8 == 0);
        }
        __syncthreads();
    }
}

DI void attn_unit(const Params& p, int l, int b, int kvh, int qb, bool isctx, ldsp_t smem) {
    int tid = threadIdx.x;
    asm volatile("" : "+v"(tid));
    const int wid = tid >> 6, lane = tid & 63, r = lane & 31, hh = lane >> 5;
    const int head = kvh * 4 + (wid >> 1);
    const int t0 = qb * 64 + (wid & 1) * 32;
    const int nkeys = isctx ? CTXL : NKEY;
    const bf16_t* Qp = isctx ? p.Qc + ((size_t)(b * 8 + head) * CTXL + t0) * 64 : p.Q + ((size_t)(b * 8 + head) * SEQ + t0) * 64;
    const bf16_t* Kp = p.K + (size_t)(b * 2 + kvh) * NKEY * 64;
    const bf16_t* Vp = p.Vt + (size_t)(b * 2 + kvh) * 64 * NKEY;
    const int orow = isctx ? NLAT + b * CTXL + t0 : b * SEQ + t0;
    bf16_t* Op = p.MIX + (size_t)orow * DM + head * 64;
    const float cexp = p.smax[l] * LOG2E;

    bf16x8 qf[4];
#pragma unroll
    for (int ks = 0; ks < 4; ++ks) qf[ks] = *(const bf16x8*)(Qp + (size_t)r * 64 + ks * 16 + 8 * hh);
    f32x16 o[2];
#pragma unroll
    for (int i = 0; i < 16; ++i) { o[0][i] = 0.f; o[1][i] = 0.f; }
    float rs0 = 0.f, rs1 = 0.f;

    const int srow = tid >> 3, sch = tid & 7;
    const int kdst = srow * 128 + ((sch ^ ((srow >> 1) & 7)) << 4);
    const bf16_t* kg = Kp + (size_t)srow * 64 + sch * 8;
    const bf16_t* vg = Vp + (size_t)srow * NKEY + sch * 8;
    const int rsw = (r >> 1) & 7;
    const int ntile = nkeys / 64;

#define ATT_QK(SD, kb) do { _Pragma("unroll") for (int kt = 0; kt < 2; ++kt) { \
        _Pragma("unroll") for (int i = 0; i < 16; ++i) SD[kt][i] = 0.f; \
        _Pragma("unroll") for (int ks = 0; ks < 4; ++ks) { \
            const bf16x8 a_ = *(const LDSP bf16x8*)((kb) + (kt * 32 + r) * 128 + (((ks * 2 + hh) ^ rsw) << 4)); \
            SD[kt] = __builtin_amdgcn_mfma_f32_32x32x16_bf16(a_, qf[ks], SD[kt], 0, 0, 0); } } } while (0)

    u32x4 kst, vst;
    f32x16 sA[2], sB[2];
    {
        kst = *(const u32x4*)kg;
        *(LDSP u32x4*)(smem + kdst) = kst;
        kst = *(const u32x4*)(kg + (size_t)64 * 64);
        vst = *(const u32x4*)vg;
        __syncthreads();
        ATT_QK(sA, smem);
        *(LDSP u32x4*)(smem + 8192 + kdst) = kst;
        *(LDSP u32x4*)(smem + 16384 + kdst) = vst;
    }
#define ATT_STEP(t, SC, SN) do { \
        const int par = (t) & 1; \
        __syncthreads(); \
        { const int t2_ = (t) + 2 < ntile ? (t) + 2 : ntile - 1, t1_ = (t) + 1 < ntile ? (t) + 1 : ntile - 1; \
          kst = *(const u32x4*)(kg + (size_t)t2_ * 64 * 64); vst = *(const u32x4*)(vg + t1_ * 64); } \
        bf16x8 kf[8], vf[4], vh[4]; \
        ldsp_t kb_ = smem + (par ^ 1) * 8192; ldsp_t vb_ = smem + 16384 + par * 8192; \
        _Pragma("unroll") for (int kt = 0; kt < 2; ++kt) _Pragma("unroll") for (int ks = 0; ks < 4; ++ks) \
            kf[kt * 4 + ks] = *(const LDSP bf16x8*)(kb_ + (kt * 32 + r) * 128 + (((ks * 2 + hh) ^ rsw) << 4)); \
        _Pragma("unroll") for (int c = 0; c < 2; ++c) _Pragma("unroll") for (int dt = 0; dt < 2; ++dt) \
            vf[c * 2 + dt] = *(const LDSP bf16x8*)(vb_ + (dt * 32 + r) * 128 + (((c * 2 + hh) ^ rsw) << 4)); \
        __builtin_amdgcn_sched_barrier(0); \
        _Pragma("unroll") for (int kt = 0; kt < 2; ++kt) _Pragma("unroll") for (int i = 0; i < 16; ++i) SN[kt][i] = 0.f; \
        _Pragma("unroll") for (int ks = 0; ks < 4; ++ks) _Pragma("unroll") for (int kt = 0; kt < 2; ++kt) \
            SN[kt] = __builtin_amdgcn_mfma_f32_32x32x16_bf16(kf[kt * 4 + ks], qf[ks], SN[kt], 0, 0, 0); \
        _Pragma("unroll") for (int c = 2; c < 4; ++c) _Pragma("unroll") for (int dt = 0; dt < 2; ++dt) \
            vh[(c - 2) * 2 + dt] = *(const LDSP bf16x8*)(vb_ + (dt * 32 + r) * 128 + (((c * 2 + hh) ^ rsw) << 4)); \
        __builtin_amdgcn_sched_barrier(0); \
        _Pragma("unroll") for (int kt = 0; kt < 2; ++kt) { \
            _Pragma("unroll") for (int i = 0; i < 16; ++i) { \
                const float e_ = fexp2(SC[kt][i] * LOG2E - cexp); \
                if (i & 1) rs1 += e_; else rs0 += e_; \
                SC[kt][i] = e_; } } \
        _Pragma("unroll") for (int c = 0; c < 4; ++c) { \
            u32x4 pw; \
            pw[0] = pk2(SC[c >> 1][8 * (c & 1) + 0], SC[c >> 1][8 * (c & 1) + 1]); pw[1] = pk2(SC[c >> 1][8 * (c & 1) + 2], SC[c >> 1][8 * (c & 1) + 3]); \
            pw[2] = pk2(SC[c >> 1][8 * (c & 1) + 4], SC[c >> 1][8 * (c & 1) + 5]); pw[3] = pk2(SC[c >> 1][8 * (c & 1) + 6], SC[c >> 1][8 * (c & 1) + 7]); \
            const bf16x8 pb = __builtin_bit_cast(bf16x8, pw); \
            _Pragma("unroll") for (int dt = 0; dt < 2; ++dt) o[dt] = __builtin_amdgcn_mfma_f32_32x32x16_bf16(c < 2 ? vf[c * 2 + dt] : vh[(c - 2) * 2 + dt], pb, o[dt], 0, 0, 0); } \
        *(LDSP u32x4*)(smem + par * 8192 + kdst) = kst; \
        *(LDSP u32x4*)(smem + 16384 + (par ^ 1) * 8192 + kdst) = vst; \
    } while (0)

    for (int t = 0; t < ntile; t += 2) {
        ATT_STEP(t, sA, sB);
        ATT_STEP(t + 1, sB, sA);
    }
    const float lrun = rs0 + rs1;
    const float ltot = lrun + __shfl_xor(lrun, 32);
    const float inv = 1.f / ltot;
#pragma unroll
    for (int dt = 0; dt < 2; ++dt)
#pragma unroll
        for (int g4 = 0; g4 < 4; ++g4) {
            u32x2 w; w[0] = pk2(o[dt][4 * g4 + 0] * inv, o[dt][4 * g4 + 1] * inv); w[1] = pk2(o[dt][4 * g4 + 2] * inv, o[dt][4 * g4 + 3] * inv);
            *(u32x2*)(Op + (size_t)r * DM + dt * 32 + 8 * g4 + 4 * hh) = w;
        }
    __syncthreads();
}

DI void gmlp_unit(const Params& p, int l, int T, int g, ldsp_t smem) {
    int tid = threadIdx.x;
    asm volatile("" : "+v"(tid));
    const int wid = tid >> 6, lane = tid & 63, fr = lane & 15, fq = lane >> 4;
    {
        const int q = tid >> 2, part = tid & 3;
        const bf16_t* src = p.U + (size_t)(T * 128 + q) * 1024 + 512 + g * 128 + part * 32;
        u32x4 raw[4];
#pragma unroll
        for (int i = 0; i < 4; ++i) raw[i] = *(const u32x4*)(src + i * 8);
        float a = 0.f, b = 0.f;
#pragma unroll
        for (int i = 0; i < 4; ++i)
#pragma unroll
            for (int j = 0; j < 4; ++j) {
                const float lo = __uint_as_float(raw[i][j] << 16), hi = __uint_as_float(raw[i][j] & 0xffff0000u);
                a += lo + hi; b += lo * lo + hi * hi;
            }
        a += __shfl_xor(a, 1); a += __shfl_xor(a, 2);
        b += __shfl_xor(b, 1); b += __shfl_xor(b, 2);
        const float mean = a * (1.f / 128.f);
        const float rstd = rsqrtf(fmaxf(b * (1.f / 128.f) - mean * mean, 0.f) + EPS);
        const float* gn = p.gmlp_norm_g + l * 512 + g * 128 + part * 32;
#pragma unroll
        for (int i = 0; i < 4; ++i)
#pragma unroll
            for (int j = 0; j < 4; ++j) {
                const int c0 = part * 32 + i * 8 + j * 2;
                const float lo = __uint_as_float(raw[i][j] << 16), hi = __uint_as_float(raw[i][j] & 0xffff0000u);
                const unsigned w = pk2((lo - mean) * rstd * gn[i * 8 + j * 2], (hi - mean) * rstd * gn[i * 8 + j * 2 + 1]);
                *(LDSP bf16_t*)(smem + c0 * 256 + (((q >> 3) ^ (c0 & 15)) << 4) + (q & 7) * 2) = (bf16_t)(w & 0xffffu);
                *(LDSP bf16_t*)(smem + (c0 + 1) * 256 + (((q >> 3) ^ ((c0 + 1) & 15)) << 4) + (q & 7) * 2) = (bf16_t)(w >> 16);
            }
    }
    __syncthreads();
    const int prow = wid * 16 + fr;
    const bf16_t* wsp = p.ws_bf + ((size_t)(l * 4 + g) * 128 + prow) * 128 + fq * 8;
    bf16x8 a[4];
#pragma unroll
    for (int ks = 0; ks < 4; ++ks) a[ks] = *(const bf16x8*)(wsp + ks * 32);
    f32x4 acc[8];
#pragma unroll
    for (int n = 0; n < 8; ++n) {
        acc[n] = (f32x4){0.f, 0.f, 0.f, 0.f};
        const int c = n * 16 + fr;
#pragma unroll
        for (int ks = 0; ks < 4; ++ks) {
            const bf16x8 bq = *(const LDSP bf16x8*)(smem + c * 256 + (((ks * 4 + fq) ^ (c & 15)) << 4));
            acc[n] = __builtin_amdgcn_mfma_f32_16x16x32_bf16(bq, a[ks], acc[n], 0, 0, 0);
        }
    }
    const float bs = p.b_spatial[(size_t)(l * 4 + g) * 128 + prow];
    const int row = T * 128 + prow;
    const bf16_t* up = p.U + (size_t)row * 1024 + g * 128 + fq * 4;
    bf16_t* mp = p.MIX + (size_t)row * DM + 512 + g * 128 + fq * 4;
#pragma unroll
    for (int n = 0; n < 8; ++n) {
        const u32x2 uu = *(const u32x2*)(up + n * 16);
        const float u0 = __uint_as_float(uu[0] << 16), u1 = __uint_as_float(uu[0] & 0xffff0000u), u2 = __uint_as_float(uu[1] << 16), u3 = __uint_as_float(uu[1] & 0xffff0000u);
        u32x2 w; w[0] = pk2((acc[n][0] + bs) * u0, (acc[n][1] + bs) * u1); w[1] = pk2((acc[n][2] + bs) * u2, (acc[n][3] + bs) * u3);
        *(u32x2*)(mp + n * 16) = w;
    }
    __syncthreads();
}

DI void mixer_phase(const Params& p, int l, ldsp_t smem) {
    const bool last = l == DEPTH - 1;
    for (int u = blockIdx.x; u < 512; u += gridDim.x) attn_unit(p, l, (u & 7) >> 1, u & 1, u >> 3, false, smem);
    if (!last)
        for (int u = blockIdx.x; u < 32; u += gridDim.x) attn_unit(p, l, (u & 7) >> 1, u & 1, u >> 3, true, smem);
    const int nT = last ? 128 : 136;
    for (int u = blockIdx.x; u < nT * 4; u += gridDim.x) gmlp_unit(p, l, u >> 2, u & 3, smem);
}

constexpr int N_PHASES = 2 + DEPTH * 5;
DI void run_phase(const Params& p, int ph, ldsp_t smem) {
    if (ph == 0) { phase0(p, smem); return; }
    if (ph == 1) { phase1(p); return; }
    const int l = (ph - 2) / 5, k = (ph - 2) % 5;
    const bool last = l == DEPTH - 1;
    switch (k) {
        case 0: gemm_stream<0>(p, l, p.H, p.wt_in + (size_t)l * IN_DIM * DM, NTOK, IN_DIM, DM, smem); break;
        case 1: mixer_phase(p, l, smem); break;
        case 2: gemm_stream<1>(p, l, p.MIX, p.wt_out + (size_t)l * DM * DM, NLAT, DM, DM, smem);
                if (!last) ctx_tiles<1, 64>(p, l, p.MIX + (size_t)NLAT * DM, p.wt_out + (size_t)l * DM * DM, DM, DM, smem);
                break;
        case 3: gemm_stream<2>(p, l, p.H, p.wt_ff1 + (size_t)l * FF * DM, NLAT, FF, DM, smem);
                if (!last) ctx_tiles<2, 128>(p, l, p.H + (size_t)NLAT * DM, p.wt_ff1 + (size_t)l * FF * DM, FF, DM, smem);
                break;
        default: gemm_stream<3>(p, l, p.ACT, p.wt_ff2 + (size_t)l * DM * FF, NLAT, DM, FF, smem);
                if (!last) ctx_tiles<3, 64>(p, l, p.ACT + (size_t)NLAT * FF, p.wt_ff2 + (size_t)l * DM * FF, DM, FF, smem);
                break;
    }
}

template <bool COOP>
__global__ void __launch_bounds__(512) mk_kernel(Params p, int ph_lo, int ph_hi) {
    __shared__ __attribute__((aligned(1024))) char smem_raw[2 * G_STAGE_B + 8192];
    ldsp_t smem = (ldsp_t)smem_raw;
    for (int ph = ph_lo; ph < ph_hi; ++ph) {
        run_phase(p, ph, smem);
#ifdef DUP_K
        if (ph > 1 && (ph - 2) % 5 == DUP_K) { cg::this_grid().sync(); run_phase(p, ph, smem); }
#endif
        if (COOP && ph + 1 < ph_hi) cg::this_grid().sync();
    }
}

extern "C" void kernel_launch(void* const* d_in, const int* in_sizes, int n_in, void* d_out, int out_size, void* d_ws, size_t ws_size, hipStream_t stream) {
    Params p{};
    p.x = (const float*)d_in[0]; p.c = (const float*)d_in[1]; p.ctx = (const float*)d_in[2]; p.c_ctx = (const float*)d_in[3];
    p.w_mod = (const float*)d_in[4]; p.b_mod = (const float*)d_in[5]; p.norm1_g = (const float*)d_in[6]; p.w_in = (const float*)d_in[7];
    p.q_norm_g = (const float*)d_in[8]; p.k_norm_g = (const float*)d_in[9]; p.gmlp_norm_g = (const float*)d_in[10]; p.w_spatial = (const float*)d_in[11];
    p.b_spatial = (const float*)d_in[12]; p.w_out = (const float*)d_in[13]; p.norm2_g = (const float*)d_in[14]; p.w_ff1 = (const float*)d_in[15]; p.w_ff2 = (const float*)d_in[16];
    p.out = (float*)d_out;
    char* w = (char*)d_ws; size_t off = 0;
    auto take = [&](size_t bytes) { char* r = w + off; off += (bytes + 1023) & ~(size_t)1023; return r; };
    p.wt_in = (bf16_t*)take((size_t)DEPTH * IN_DIM * DM * 2);
    p.wt_out = (bf16_t*)take((size_t)DEPTH * DM * DM * 2);
    p.wt_ff1 = (bf16_t*)take((size_t)DEPTH * FF * DM * 2);
    p.wt_ff2 = (bf16_t*)take((size_t)DEPTH * FF * DM * 2);
    p.ws_bf = (bf16_t*)take((size_t)DEPTH * 4 * 128 * 128 * 2);
    p.mod = (float*)take((size_t)DEPTH * 5 * 6144 * 4);
    p.rope = (float*)take(2048 * 4);
    p.xc = (float*)take((size_t)NCTX * DM * 4);
    p.smax = (float*)take(1024);
    p.ss = (float*)take((size_t)DEPTH * 2 * NTOK * 16 * 4);
    p.shw_in = (float*)take((size_t)DEPTH * 5 * IN_DIM * 4);
    p.shw_ff1 = (float*)take((size_t)DEPTH * 5 * FF * 4);
    p.H = (bf16_t*)take((size_t)NTOK * DM * 2);
    p.ACT = (bf16_t*)take((size_t)NTOK * FF * 2);
    {
        char* a = (char*)p.ACT; size_t o2 = 0;
        auto take2 = [&](size_t bytes) { char* r = a + o2; o2 += (bytes + 1023) & ~(size_t)1023; return r; };
        p.Q = (bf16_t*)take2((size_t)NLAT * 512 * 2);
        p.Qc = (bf16_t*)take2((size_t)NCTX * 512 * 2);
        p.K = (bf16_t*)take2((size_t)NB * 2 * NKEY * 64 * 2);
        p.Vt = (bf16_t*)take2((size_t)NB * 2 * NKEY * 64 * 2);
        p.U = (bf16_t*)take2((size_t)NTOK * 1024 * 2);
        p.MIX = (bf16_t*)take2((size_t)NTOK * DM * 2);
    }
    if (off > ws_size) { fprintf(stderr, "workspace too small: need %zu have %zu\n", off, ws_size); return; }
#if MK_COOP
    static int grid_blocks = 0;
    if (!grid_blocks) {
        int dev = 0, cus = 0, per_cu = 0;
        hipGetDevice(&dev);
        hipDeviceGetAttribute(&cus, hipDeviceAttributeMultiprocessorCount, dev);
        hipOccupancyMaxActiveBlocksPerMultiprocessor(&per_cu, mk_kernel<true>, 512, 0);
        if (per_cu < 1) per_cu = 1;
        grid_blocks = cus * 1;
    }
    int lo = 0, hi = N_PHASES;
    void* args[] = {&p, &lo, &hi};
    hipError_t e = hipLaunchCooperativeKernel((void*)mk_kernel<true>, dim3(grid_blocks), dim3(512), args, 0, stream);
    if (e != hipSuccess) fprintf(stderr, "cooperative launch failed: %s (grid %d)\n", hipGetErrorString(e), grid_blocks);
#else
    for (int ph = 0; ph < N_PHASES; ++ph) mk_kernel<false><<<256, 512, 0, stream>>>(p, ph, ph + 1);
#endif
}
```

```cpp
#include <hip/hip_runtime.h>
#include <hip/hip_cooperative_groups.h>
#include <stdint.h>
#include <cstdio>
namespace cg = cooperative_groups;

#ifndef MK_COOP
#define MK_COOP 1
#endif

#define DI __device__ __forceinline__
#define LDSP __attribute__((address_space(3)))
typedef LDSP char* ldsp_t;
typedef unsigned short bf16_t;
typedef short bf16x8 __attribute__((ext_vector_type(8)));
typedef float f32x2 __attribute__((ext_vector_type(2)));
typedef float f32x4 __attribute__((ext_vector_type(4)));
typedef float f32x16 __attribute__((ext_vector_type(16)));
typedef unsigned u32x2 __attribute__((ext_vector_type(2)));
typedef unsigned u32x4 __attribute__((ext_vector_type(4)));
typedef __bf16 bf2_t __attribute__((ext_vector_type(2)));

constexpr int DM = 1024, NB = 4, SEQ = 4096, DEPTH = 4, CTXL = 256;
constexpr int NLAT = NB * SEQ;
constexpr int NCTX = NB * CTXL;
constexpr int NTOK = NLAT + NCTX;
constexpr int IN_DIM = 1792, FF = 4096, NKEY = CTXL + SEQ;
constexpr float EPS = 1e-6f;
constexpr float LOG2E = 1.4426950408889634f;

struct Params {
    const float *x, *c, *ctx, *c_ctx, *w_mod, *b_mod, *norm1_g, *w_in, *q_norm_g, *k_norm_g, *gmlp_norm_g, *w_spatial, *b_spatial, *w_out, *norm2_g, *w_ff1, *w_ff2;
    float* out;
    bf16_t *wt_in, *wt_out, *wt_ff1, *wt_ff2, *ws_bf;
    float *mod, *rope, *xc, *smax, *ss, *shw_in, *shw_ff1;
    bf16_t *H, *Q, *Qc, *K, *Vt, *U, *MIX, *ACT;
};

DI unsigned pk2(float a, float b) { f32x2 v = {a, b}; bf2_t r = __builtin_convertvector(v, bf2_t); return __builtin_bit_cast(unsigned, r); }
DI bf16_t f2bf(float a) { return (bf16_t)(pk2(a, 0.f) & 0xffffu); }
DI float fexp2(float x) { return __builtin_amdgcn_exp2f(x); }
DI float gelu_tanh(float x) {
    const float y = 0.7978845608028654f * (x + 0.044715f * x * x * x);
    return x * __builtin_amdgcn_rcpf(1.f + fexp2(-2.f * LOG2E * y));
}
DI float* xrow_ptr(const Params& p, int row) { return row < NLAT ? p.out + (size_t)row * DM : p.xc + (size_t)(row - NLAT) * DM; }

DI void transpose_tile(const float* __restrict__ src, bf16_t* __restrict__ dst, int K, int N, int tk, int tn, ldsp_t smem) {
    LDSP float* t = (LDSP float*)smem;
    int tid = threadIdx.x;
    asm volatile("" : "+v"(tid));
    const int k0 = tk * 64, n0 = tn * 256;
    f32x4 v[8];
#pragma unroll
    for (int i = 0; i < 8; ++i) v[i] = *(const f32x4*)(src + (size_t)(k0 + (tid >> 6) + 8 * i) * N + n0 + (tid & 63) * 4);
#pragma unroll
    for (int i = 0; i < 8; ++i) {
        const int k = (tid >> 6) + 8 * i, n4 = (tid & 63) * 4;
        t[k * 257 + n4 + 0] = v[i][0]; t[k * 257 + n4 + 1] = v[i][1]; t[k * 257 + n4 + 2] = v[i][2]; t[k * 257 + n4 + 3] = v[i][3];
    }
    __syncthreads();
#pragma unroll
    for (int j = 0; j < 4; ++j) {
        const int n = (tid >> 3) + 64 * j, k8 = (tid & 7) * 8;
        u32x4 w;
        w[0] = pk2(t[(k8 + 0) * 257 + n], t[(k8 + 1) * 257 + n]);
        w[1] = pk2(t[(k8 + 2) * 257 + n], t[(k8 + 3) * 257 + n]);
        w[2] = pk2(t[(k8 + 4) * 257 + n], t[(k8 + 5) * 257 + n]);
        w[3] = pk2(t[(k8 + 6) * 257 + n], t[(k8 + 7) * 257 + n]);
        *(u32x4*)(dst + (size_t)(n0 + n) * K + k0 + k8) = w;
    }
    __syncthreads();
}

DI void mod_unit(const Params& p, int l, int cgi, ldsp_t smem) {
    LDSP float* s = (LDSP float*)smem;
    LDSP float* red = (LDSP float*)(smem + 20480);
    int tid = threadIdx.x;
    asm volatile("" : "+v"(tid));
    for (int i = tid; i < 5 * 1024; i += 512) {
        const int cnd = i >> 10, k = i & 1023;
        const float v = cnd < 4 ? p.c[cnd * 1024 + k] : p.c_ctx[k];
        s[i] = v / (1.f + fexp2(-LOG2E * v));
    }
    __syncthreads();
    const int c4 = tid & 15, ks = tid >> 4;
    f32x4 acc[5];
#pragma unroll
    for (int q = 0; q < 5; ++q) acc[q] = (f32x4){0.f, 0.f, 0.f, 0.f};
    const float* wp = p.w_mod + ((size_t)l * 1024 + ks * 32) * 6144 + cgi * 64 + c4 * 4;
#pragma unroll 8
    for (int kk = 0; kk < 32; ++kk) {
        const f32x4 w = *(const f32x4*)(wp + (size_t)kk * 6144);
        const int k = ks * 32 + kk;
#pragma unroll
        for (int q = 0; q < 5; ++q) acc[q] += w * s[q * 1024 + k];
    }
#pragma unroll
    for (int q = 0; q < 5; ++q)
#pragma unroll
        for (int j = 0; j < 4; ++j) red[(ks * 5 + q) * 64 + c4 * 4 + j] = acc[q][j];
    __syncthreads();
    if (tid < 320) {
        const int q = tid >> 6, col = tid & 63;
        float a = 0.f;
        for (int k2 = 0; k2 < 32; ++k2) a += red[(k2 * 5 + q) * 64 + col];
        const int j = cgi * 64 + col;
        p.mod[((size_t)l * 5 + q) * 6144 + j] = a + p.b_mod[(size_t)l * 6144 + j];
    }
    __syncthreads();
}

DI void phase0(const Params& p, ldsp_t smem) {
    constexpr int T_IN = 16 * 7, T_OUT = 16 * 4, T_FF1 = 16 * 16, T_FF2 = 64 * 4;
    constexpr int T_L = T_IN + T_OUT + T_FF1 + T_FF2;
    constexpr int U_T = DEPTH * T_L;
    constexpr int U_MOD = DEPTH * 96;
    constexpr int U_WS = 64;
    constexpr int U_ALL = U_MOD + U_T + U_WS + 1;
    for (int u = blockIdx.x; u < U_ALL; u += gridDim.x) {
        if (u < U_MOD) { mod_unit(p, u / 96, u % 96, smem); continue; }
        int v = u - U_MOD;
        if (v < U_T) {
            const int l = v / T_L; int r = v % T_L;
            if (r < T_IN) { transpose_tile(p.w_in + (size_t)l * DM * IN_DIM, p.wt_in + (size_t)l * IN_DIM * DM, DM, IN_DIM, r / 7, r % 7, smem); continue; }
            r -= T_IN;
            if (r < T_OUT) { transpose_tile(p.w_out + (size_t)l * DM * DM, p.wt_out + (size_t)l * DM * DM, DM, DM, r / 4, r % 4, smem); continue; }
            r -= T_OUT;
            if (r < T_FF1) { transpose_tile(p.w_ff1 + (size_t)l * DM * FF, p.wt_ff1 + (size_t)l * FF * DM, DM, FF, r / 16, r % 16, smem); continue; }
            r -= T_FF1;
            transpose_tile(p.w_ff2 + (size_t)l * FF * DM, p.wt_ff2 + (size_t)l * DM * FF, FF, DM, r / 4, r % 4, smem); continue;
        }
        v -= U_T;
        if (v < U_WS) {
            int tw = threadIdx.x;
            asm volatile("" : "+v"(tw));
            const size_t i = ((size_t)v * 512 + tw) * 8;
            const f32x4 a = *(const f32x4*)(p.w_spatial + i), b = *(const f32x4*)(p.w_spatial + i + 4);
            u32x4 w; w[0] = pk2(a[0], a[1]); w[1] = pk2(a[2], a[3]); w[2] = pk2(b[0], b[1]); w[3] = pk2(b[2], b[3]);
            *(u32x4*)(p.ws_bf + i) = w;
            continue;
        }
        int ti = threadIdx.x;
        asm volatile("" : "+v"(ti));
        if (ti < DEPTH) {
            float mq = 0.f, mk = 0.f;
            for (int i = 0; i < 64; ++i) { mq = fmaxf(mq, fabsf(p.q_norm_g[ti * 64 + i])); mk = fmaxf(mk, fabsf(p.k_norm_g[ti * 64 + i])); }
            p.smax[ti] = 8.f * mq * mk;
        }
        for (int i = ti; i < 1024; i += 512) {
            const int pos = i >> 4, f = i & 15;
            const float inv = fexp2(-(float)f * (13.287712379549449f / 16.f));
            const float rev = (float)pos * inv * 0.15915494309189535f;
            p.rope[i] = __builtin_amdgcn_cosf(rev);
            p.rope[1024 + i] = __builtin_amdgcn_sinf(rev);
        }
    }
}

DI void phase1(const Params& p) {
    int tid = threadIdx.x;
    asm volatile("" : "+v"(tid));
    const int lane = tid & 63, wid = tid >> 6;
    const int gw = blockIdx.x * 8 + wid, nw = gridDim.x * 8;
    for (int row = gw; row < NTOK; row += nw) {
        const float* src = row < NLAT ? p.x + (size_t)row * DM : p.ctx + (size_t)(row - NLAT) * DM;
        const int cond = row < NLAT ? (row >> 12) : 4;
        const float* mp = p.mod + ((size_t)cond) * 6144;
        f32x4 v[4];
        float ss = 0.f;
#pragma unroll
        for (int i = 0; i < 4; ++i) { v[i] = *(const f32x4*)(src + i * 256 + lane * 4); ss += v[i][0] * v[i][0] + v[i][1] * v[i][1] + v[i][2] * v[i][2] + v[i][3] * v[i][3]; }
#pragma unroll
        for (int o = 1; o < 64; o <<= 1) ss += __shfl_xor(ss, o);
        if (lane < 16) p.ss[(size_t)row * 16 + lane] = lane == 0 ? ss : 0.f;
        bf16_t* hp = p.H + (size_t)row * DM;
        float* xw = xrow_ptr(p, row);
#pragma unroll
        for (int i = 0; i < 4; ++i) {
            const int idx = i * 256 + lane * 4;
            const f32x4 gg = *(const f32x4*)(p.norm1_g + idx), sc = *(const f32x4*)(mp + DM + idx);
            f32x4 y;
#pragma unroll
            for (int j = 0; j < 4; ++j) y[j] = v[i][j] * gg[j] * (1.f + sc[j]);
            u32x2 w; w[0] = pk2(y[0], y[1]); w[1] = pk2(y[2], y[3]);
            *(u32x2*)(hp + idx) = w;
            *(f32x4*)(xw + idx) = v[i];
        }
    }
    {
        const int fr = lane & 15, fq = lane >> 4;
        constexpr int G_IN = IN_DIM / 16, G_FF = FF / 16, G_L = G_IN + G_FF;
        for (int gi = gw; gi < DEPTH * G_L; gi += nw) {
            const int l = gi / G_L, r = gi % G_L;
            const bool which = r >= G_IN;
            const int n0 = (which ? r - G_IN : r) * 16;
            const int N = which ? FF : IN_DIM;
            const bf16_t* W = (which ? p.wt_ff1 + (size_t)l * FF * DM : p.wt_in + (size_t)l * IN_DIM * DM) + (size_t)(n0 + fr) * DM + fq * 8;
            float* dst = which ? p.shw_ff1 + (size_t)l * 5 * FF : p.shw_in + (size_t)l * 5 * IN_DIM;
            const int c = fr < 5 ? fr : fr - 5;
            const float* sh = p.mod + ((size_t)l * 5 + (c < 5 ? c : 0)) * 6144 + (which ? 3 : 0) * DM + fq * 8;
            f32x4 acc = {0.f, 0.f, 0.f, 0.f};
#pragma unroll 8
            for (int ks = 0; ks < 32; ++ks) {
                const bf16x8 wv = *(const bf16x8*)(W + ks * 32);
                const f32x4 s0 = *(const f32x4*)(sh + ks * 32), s1 = *(const f32x4*)(sh + ks * 32 + 4);
                float sv[8] = {s0[0], s0[1], s0[2], s0[3], s1[0], s1[1], s1[2], s1[3]};
                u32x4 aw;
#pragma unroll
                for (int j = 0; j < 4; ++j) {
                    float a0 = sv[2 * j], a1 = sv[2 * j + 1];
                    const unsigned hi = pk2(a0, a1);
                    if (fr >= 5) { a0 -= __uint_as_float(hi << 16); a1 -= __uint_as_float(hi & 0xffff0000u); }
                    aw[j] = fr < 5 ? hi : (fr < 10 ? pk2(a0, a1) : 0u);
                }
                acc = __builtin_amdgcn_mfma_f32_16x16x32_bf16(__builtin_bit_cast(bf16x8, aw), wv, acc, 0, 0, 0);
            }
            const float r4 = __shfl(acc[0], fr + 16);
            const float r5 = __shfl(acc[1], fr + 16), r6 = __shfl(acc[2], fr + 16), r7 = __shfl(acc[3], fr + 16);
            const float r8 = __shfl(acc[0], fr + 32), r9 = __shfl(acc[1], fr + 32);
            if (fq == 0) {
                dst[(size_t)0 * N + n0 + fr] = acc[0] + r5;
                dst[(size_t)1 * N + n0 + fr] = acc[1] + r6;
                dst[(size_t)2 * N + n0 + fr] = acc[2] + r7;
                dst[(size_t)3 * N + n0 + fr] = acc[3] + r8;
                dst[(size_t)4 * N + n0 + fr] = r4 + r9;
            }
        }
    }
}

constexpr int G_TILE_B = 256 * 64 * 2, G_STAGE_B = 2 * G_TILE_B;
DI int lds_byte2(int r, int c) {
    const int st = (r >> 4) * 2 + (c >> 5), ob = (r & 15) * 64 + (c & 31) * 2;
    return st * 1024 + (ob ^ (((ob >> 9) & 1) << 5));
}
DI void stage_rc2(int b, int& R, int& C) {
    const int st = b >> 10, sb = b & 1023, swz = sb ^ (((sb >> 9) & 1) << 5);
    R = (st >> 1) * 16 + swz / 64;
    C = (st & 1) * 32 + (swz % 64) / 2;
}
template <int KS> DI int lds_byte_ks(int r, int c) {
    const int st = (r >> 4) * KS + (c >> 5), ob = (r & 15) * 64 + (c & 31) * 2;
    return st * 1024 + (ob ^ (((ob >> 9) & 1) << 5));
}
template <int KS> DI void stage_rc_ks(int b, int& R, int& C) {
    const int st = b >> 10, sb = b & 1023, swz = sb ^ (((sb >> 9) & 1) << 5);
    R = (st / KS) * 16 + swz / 64;
    C = (st % KS) * 32 + (swz % 64) / 2;
}
#define WAIT_V0() asm volatile("s_waitcnt vmcnt(0)" ::: "memory")

struct TileCtx { int brow, bcol, pn, wr, wc, fr, fq, wid, lane, l; };

DI void tile_coords(int L, int nM, int nN, int& pm, int& pn) {
    const int nwg = nM * nN;
    int wgid = L;
    { const int q = nwg / 8, r = nwg % 8, xcd = wgid % 8, off = wgid / 8; wgid = (xcd < r ? xcd * (q + 1) : r * (q + 1) + (xcd - r) * q) + off; }
    const int nig = 8 * nN, gid = wgid / nig, fm = gid * 8, gsz = (nM - fm) < 8 ? (nM - fm) : 8;
    pm = fm + ((wgid % nig) % gsz); pn = (wgid % nig) / gsz;
}

DI void wave_put(ldsp_t wb, int rowl, int n, int fq, u32x2 w) {
    const int chunk = n * 2 + (fq >> 1);
    *(LDSP u32x2*)(wb + rowl * 128 + ((chunk ^ (rowl & 7)) << 4) + (fq & 1) * 8) = w;
}
DI void wave_rows_store(ldsp_t wb, int lane, bf16_t* dst0, size_t ld) {
#pragma unroll
    for (int i = 0; i < 8; ++i) {
        const int row = i * 8 + (lane >> 3), ch = lane & 7;
        const u32x4 v = *(const LDSP u32x4*)(wb + row * 128 + ((ch ^ (row & 7)) << 4));
        *(u32x4*)(dst0 + (size_t)row * ld + ch * 8) = v;
    }
}

template <int EK> struct EpiResid {
    static DI void run(const f32x4 (&acc)[8][4], const TileCtx& tc, const Params& p, ldsp_t wb) {
        constexpr int GI = EK == 1 ? 2 : 5;
        const int cond = tc.brow < NLAT ? (tc.brow >> 12) : 4;
        const float* gate = p.mod + ((size_t)tc.l * 5 + cond) * 6144 + GI * DM;
        const int col0 = tc.bcol + tc.wc * 64 + tc.fq * 4;
        const bool has_next = EK == 1 || tc.l + 1 < DEPTH;
        const int ln = EK == 1 ? tc.l : (has_next ? tc.l + 1 : tc.l);
        const float* gnx = (EK == 1 ? p.norm2_g : p.norm1_g) + (size_t)ln * DM + col0;
        const float* scn = p.mod + ((size_t)ln * 5 + cond) * 6144 + (EK == 1 ? 4 : 1) * DM + col0;
        float* ssp = p.ss + (size_t)(ln * 2 + (EK == 1 ? 1 : 0)) * NTOK * 16 + (tc.bcol >> 8) * 4 + tc.wc;
        f32x4 gv[4], av[4];
#pragma unroll
        for (int n = 0; n < 4; ++n) {
            gv[n] = *(const f32x4*)(gate + col0 + n * 16);
            const f32x4 g1 = *(const f32x4*)(gnx + n * 16), s1 = *(const f32x4*)(scn + n * 16);
            av[n] = g1 * (1.f + s1);
        }
#pragma unroll
        for (int h = 0; h < 2; ++h) {
#pragma unroll
            for (int mm = 0; mm < 4; ++mm) { __builtin_amdgcn_sched_barrier(0);
                const int m = h * 4 + mm;
                const int row = tc.brow + tc.wr * 128 + m * 16 + tc.fr;
                float* xr = xrow_ptr(p, row) + col0;
                float part = 0.f;
#pragma unroll
                for (int n = 0; n < 4; ++n) {
                    f32x4 xv = *(const f32x4*)(xr + n * 16);
                    xv += gv[n] * acc[m][n];
                    *(f32x4*)(xr + n * 16) = xv;
                    if (has_next) {
                        part += xv[0] * xv[0] + xv[1] * xv[1] + xv[2] * xv[2] + xv[3] * xv[3];
                        const f32x4 hv = xv * av[n];
                        u32x2 w; w[0] = pk2(hv[0], hv[1]); w[1] = pk2(hv[2], hv[3]);
                        wave_put(wb, mm * 16 + tc.fr, n, tc.fq, w);
                    }
                }
                if (has_next) {
                    part += __shfl_xor(part, 16);
                    part += __shfl_xor(part, 32);
                    if (tc.fq == 0) ssp[(size_t)row * 16] = part;
                }
            }
            if (has_next) wave_rows_store(wb, tc.lane, p.H + (size_t)(tc.brow + tc.wr * 128 + h * 64) * DM + tc.bcol + tc.wc * 64, DM);
        }
    }
};
struct EpiFF1 {
    static DI void run(const f32x4 (&acc)[8][4], const TileCtx& tc, const Params& p, ldsp_t wb) {
#pragma unroll
        for (int h = 0; h < 2; ++h) {
#pragma unroll
            for (int mm = 0; mm < 4; ++mm) {
                const int m = h * 4 + mm;
#pragma unroll
                for (int n = 0; n < 4; ++n) {
                    f32x4 a = acc[m][n];
#pragma unroll
                    for (int j = 0; j < 4; ++j) { const float r = fmaxf(a[j], 0.f); a[j] = r * r; }
                    u32x2 w; w[0] = pk2(a[0], a[1]); w[1] = pk2(a[2], a[3]);
                    wave_put(wb, mm * 16 + tc.fr, n, tc.fq, w);
                }
            }
            wave_rows_store(wb, tc.lane, p.ACT + (size_t)(tc.brow + tc.wr * 128 + h * 64) * FF + tc.bcol + tc.wc * 64, FF);
        }
    }
};
template <int BRK> struct EpiIn {
    static DI void run(const f32x4 (&acc)[8][4], const TileCtx& tc, const Params& p, ldsp_t wb) {
        const int l = tc.l, pn = tc.pn, wc = tc.wc, fr = tc.fr, fq = tc.fq;
        if (BRK == 0 || (BRK == 1 && wc < 2)) {
            constexpr bool isq = BRK == 0;
            const int head = isq ? pn * 4 + wc : wc;
            const float* gn = (isq ? p.q_norm_g : p.k_norm_g) + l * 64;
            f32x4 gv[4];
#pragma unroll
            for (int n = 0; n < 4; ++n) gv[n] = *(const f32x4*)(gn + n * 16 + fq * 4);
            const float osc = isq ? 0.125f : 1.f;
            const bool lat = tc.brow < NLAT;
#pragma unroll
            for (int h = 0; h < 2; ++h) {
#pragma unroll
                for (int mm = 0; mm < 4; ++mm) { __builtin_amdgcn_sched_barrier(0);
                    const int m = h * 4 + mm;
                    const int row = tc.brow + tc.wr * 128 + m * 16 + fr;
                    float ss = 0.f;
#pragma unroll
                    for (int n = 0; n < 4; ++n)
#pragma unroll
                        for (int j = 0; j < 4; ++j) ss += acc[m][n][j] * acc[m][n][j];
                    ss += __shfl_xor(ss, 16);
                    ss += __shfl_xor(ss, 32);
                    const float rstd = rsqrtf(ss * (1.f / 64.f) + EPS) * osc;
                    const int t = row & 4095;
#pragma unroll
                    for (int ax = 0; ax < 2; ++ax) {
                        f32x4 x1 = acc[m][2 * ax] * rstd * gv[2 * ax], x2 = acc[m][2 * ax + 1] * rstd * gv[2 * ax + 1];
                        if (lat) {
                            const int pos = ax == 0 ? (t >> 6) : (t & 63);
                            const f32x4 cs = *(const f32x4*)(p.rope + pos * 16 + fq * 4), sn = *(const f32x4*)(p.rope + 1024 + pos * 16 + fq * 4);
                            const f32x4 o1 = x1 * cs - x2 * sn, o2 = x2 * cs + x1 * sn;
                            x1 = o1; x2 = o2;
                        }
                        u32x2 w; w[0] = pk2(x1[0], x1[1]); w[1] = pk2(x1[2], x1[3]);
                        wave_put(wb, mm * 16 + fr, 2 * ax, fq, w);
                        w[0] = pk2(x2[0], x2[1]); w[1] = pk2(x2[2], x2[3]);
                        wave_put(wb, mm * 16 + fr, 2 * ax + 1, fq, w);
                    }
                }
                const int row0 = tc.brow + tc.wr * 128 + h * 64;
                bf16_t* dst0;
                if (lat) {
                    const int b = row0 >> 12, t0 = row0 & 4095;
                    dst0 = isq ? p.Q + ((size_t)(b * 8 + head) * SEQ + t0) * 64 : p.K + ((size_t)(b * 2 + head) * NKEY + CTXL + t0) * 64;
                } else {
                    const int r2 = row0 - NLAT, b = r2 >> 8, t0 = r2 & 255;
                    dst0 = isq ? p.Qc + ((size_t)(b * 8 + head) * CTXL + t0) * 64 : p.K + ((size_t)(b * 2 + head) * NKEY + t0) * 64;
                }
                wave_rows_store(wb, tc.lane, dst0, 64);
            }
        } else if (BRK == 1) {
            const int kvh = wc - 2;
#pragma unroll
            for (int h = 0; h < 2; ++h) {
#pragma unroll
                for (int mm = 0; mm < 4; ++mm) {
                    const int m = h * 4 + mm;
                    const int key = mm * 16 + fr, k16 = key & 15;
                    const int kp = (key & ~15) | ((((k16 >> 2) & 1) << 3) + (k16 & 3) + ((k16 >> 3) << 2));
#pragma unroll
                    for (int n = 0; n < 4; ++n)
#pragma unroll
                        for (int j = 0; j < 4; ++j) {
                            const int d = n * 16 + fq * 4 + j;
                            *(LDSP bf16_t*)(wb + d * 128 + (((kp >> 3) ^ (d & 7)) << 4) + (kp & 7) * 2) = f2bf(acc[m][n][j]);
                        }
                }
                const int row0 = tc.brow + tc.wr * 128 + h * 64;
                int b, pos0;
                if (row0 < NLAT) { b = row0 >> 12; pos0 = CTXL + (row0 & 4095); } else { const int r2 = row0 - NLAT; b = r2 >> 8; pos0 = r2 & 255; }
                wave_rows_store(wb, tc.lane, p.Vt + (size_t)(b * 2 + kvh) * 64 * NKEY + pos0, NKEY);
            }
        } else if (BRK == 2) {
#pragma unroll
            for (int h = 0; h < 2; ++h) {
#pragma unroll
                for (int mm = 0; mm < 4; ++mm) {
                    const int m = h * 4 + mm;
#pragma unroll
                    for (int n = 0; n < 4; ++n) {
                        u32x2 w; w[0] = pk2(gelu_tanh(acc[m][n][0]), gelu_tanh(acc[m][n][1])); w[1] = pk2(gelu_tanh(acc[m][n][2]), gelu_tanh(acc[m][n][3]));
                        wave_put(wb, mm * 16 + fr, n, fq, w);
                    }
                }
                wave_rows_store(wb, tc.lane, p.U + (size_t)(tc.brow + tc.wr * 128 + h * 64) * 1024 + (pn - 3) * 256 + wc * 64, 1024);
            }
        }
    }
};

template <int EK>
DI void gemm_stream(const Params& p, int l, const bf16_t* __restrict__ A, const bf16_t* __restrict__ Bt, int M, int N, int K, ldsp_t shm) {
    const int nM = M / 256, nN = N / 256, nwg = nM * nN;
    int L = blockIdx.x;
    if (L >= nwg) return;
#define G_SA(b) (shm + (b) * G_STAGE_B)
#define G_SB(b) (shm + (b) * G_STAGE_B + G_TILE_B)
#define G_LANE_SETUP() \
    int tid_ = threadIdx.x; \
    asm volatile("" : "+v"(tid_));    \
    const int wid = tid_ >> 6, lane = tid_ & 63, wr = wid >> 2, wc = wid & 3, fr = lane & 15, fq = lane >> 4; \
    unsigned soff[4];        \
    _Pragma("unroll") for (int i = 0; i < 4; ++i) { int sR, sC; stage_rc2(wid * 1024 + i * 8192 + lane * 16, sR, sC); soff[i] = (unsigned)(sR * K + sC) * 2u; }
#define G_STAGE(Ap, Bp, buf, kt) do { const char* ab_ = (const char*)(Ap) + (size_t)(kt) * 128; const char* bb_ = (const char*)(Bp) + (size_t)(kt) * 128; \
      _Pragma("unroll") for (int i = 0; i < 4; ++i) { \
        __builtin_amdgcn_global_load_lds((const unsigned*)(ab_ + soff[i]), (LDSP unsigned*)(G_SA(buf) + wid * 1024 + i * 8192), 16, 0, 0); \
        __builtin_amdgcn_global_load_lds((const unsigned*)(bb_ + soff[i]), (LDSP unsigned*)(G_SB(buf) + wid * 1024 + i * 8192), 16, 0, 0); } } while (0)
    const int nt = K / 64;
    int pm, pn;
    tile_coords(L, nM, nN, pm, pn);
    const bf16_t* Ab = A + (size_t)pm * 256 * K;
    const bf16_t* Bb = Bt + (size_t)pn * 256 * K;
    { G_LANE_SETUP(); (void)wr; (void)wc; (void)fr; (void)fq; G_STAGE(Ab, Bb, 0, 0); WAIT_V0(); __syncthreads(); }
    while (true) {
        G_LANE_SETUP();
        const int aoff = lds_byte2(wr * 128 + fr, fq * 8), boff = lds_byte2(wc * 64 + fr, fq * 8);
        f32x4 acc[8][4];
#pragma unroll
        for (int m = 0; m < 8; ++m)
#pragma unroll
            for (int n = 0; n < 4; ++n) acc[m][n] = (f32x4){0.f, 0.f, 0.f, 0.f};
        const int Ln = L + gridDim.x;
        const bool has_next = Ln < nwg;
        int pm2 = pm, pn2 = pn;
        if (has_next) tile_coords(Ln, nM, nN, pm2, pn2);
        const bf16_t* Ab2 = A + (size_t)pm2 * 256 * K;
        const bf16_t* Bb2 = Bt + (size_t)pn2 * 256 * K;
        bf16x8 Aa[4], Ab_[4], Bk0[4], Bk1[4];
#define G_RDA(AF, buf, ks, mh) do { _Pragma("unroll") for (int m = 0; m < 4; ++m) AF[m] = *(const LDSP bf16x8*)(G_SA(buf) + aoff + ((mh) * 4 + m) * 2048 + (ks) * 1024); } while (0)
#define G_RDB(BF, buf, ks) do { _Pragma("unroll") for (int n = 0; n < 4; ++n) BF[n] = *(const LDSP bf16x8*)(G_SB(buf) + boff + n * 2048 + (ks) * 1024); } while (0)
#define G_MMA(AF, BF, mh) do { __builtin_amdgcn_s_setprio(1); \
            _Pragma("unroll") for (int m = 0; m < 4; ++m) _Pragma("unroll") for (int n = 0; n < 4; ++n) \
                acc[(mh) * 4 + m][n] = __builtin_amdgcn_mfma_f32_16x16x32_bf16(BF[n], AF[m], acc[(mh) * 4 + m][n], 0, 0, 0); \
            __builtin_amdgcn_s_setprio(0); } while (0)
#define G_SB0() __builtin_amdgcn_sched_barrier(0)
        for (int t = 0; t < nt; ++t) {
            const int cur = t & 1;
            G_RDA(Aa, cur, 0, 0); G_RDB(Bk0, cur, 0); G_SB0();
            if (t > 0) G_MMA(Ab_, Bk1, 1);
            G_SB0();
            if (t + 1 < nt) G_STAGE(Ab, Bb, cur ^ 1, t + 1);
            else if (has_next) G_STAGE(Ab2, Bb2, cur ^ 1, 0);
            G_RDA(Ab_, cur, 0, 1); G_SB0();
            G_MMA(Aa, Bk0, 0); G_SB0();
            G_RDA(Aa, cur, 1, 0); G_RDB(Bk1, cur, 1); G_SB0();
            G_MMA(Ab_, Bk0, 1); G_SB0();
            G_RDA(Ab_, cur, 1, 1); G_SB0();
            G_MMA(Aa, Bk1, 0); G_SB0();
            asm volatile("s_waitcnt lgkmcnt(0)" ::: "memory");
            WAIT_V0(); __syncthreads();
        }
        G_MMA(Ab_, Bk1, 1);
        G_SB0();
        {
            int tid2 = threadIdx.x, pme = pm, pne = pn;
            asm volatile("" : "+v"(tid2), "+s"(pme), "+s"(pne));
            TileCtx tc;
            tc.wid = tid2 >> 6; tc.lane = tid2 & 63; tc.wr = tc.wid >> 2; tc.wc = tc.wid & 3; tc.fr = tc.lane & 15; tc.fq = tc.lane >> 4; tc.l = l;
            tc.brow = pme * 256; tc.bcol = pne * 256; tc.pn = pne;
            ldsp_t ex = shm + G_STAGE_B + tc.wid * 8192;
            if (EK == 0 || EK == 2) {
                const int cond = tc.brow < NLAT ? (tc.brow >> 12) : 4;
                const float* ssp = p.ss + ((size_t)(l * 2 + (EK == 0 ? 0 : 1)) * NTOK + tc.brow + tc.wr * 128 + tc.fr) * 16 + tc.fq * 4;
                const float* shw = (EK == 0 ? p.shw_in + ((size_t)l * 5 + cond) * IN_DIM : p.shw_ff1 + ((size_t)l * 5 + cond) * FF) + tc.bcol + tc.wc * 64 + tc.fq * 4;
                f32x4 shv[4];
#pragma unroll
                for (int n = 0; n < 4; ++n) shv[n] = *(const f32x4*)(shw + n * 16);
#pragma unroll
                for (int m = 0; m < 8; ++m) {
                    const f32x4 pp = *(const f32x4*)(ssp + m * 256);
                    float sq = pp[0] + pp[1] + pp[2] + pp[3];
                    sq += __shfl_xor(sq, 16);
                    sq += __shfl_xor(sq, 32);
                    const float rstd = rsqrtf(sq * (1.f / DM) + EPS);
#pragma unroll
                    for (int n = 0; n < 4; ++n) acc[m][n] = acc[m][n] * rstd + shv[n];
                }
            }
            if (EK == 0) {
                if (pne < 2) EpiIn<0>::run(acc, tc, p, ex);
                else if (pne == 2) EpiIn<1>::run(acc, tc, p, ex);
                else EpiIn<2>::run(acc, tc, p, ex);
            } else if (EK == 1) EpiResid<1>::run(acc, tc, p, ex);
            else if (EK == 2) EpiFF1::run(acc, tc, p, ex);
            else EpiResid<3>::run(acc, tc, p, ex);
        }
        __syncthreads();
        if (!has_next) break;
        L = Ln; pm = pm2; pn = pn2; Ab = Ab2; Bb = Bb2;
    }
}

template <int EK>
DI void ctx_item(const Params& p, int l, int grow, int gcol, int slot, f32x4 s0, f32x4 s1, bool lead) {
    if (EK == 2) {
        const float* pp = p.ss + ((size_t)(l * 2 + 1) * NTOK + NLAT + grow) * 16;
        const f32x4 q0 = *(const f32x4*)pp, q1 = *(const f32x4*)(pp + 4), q2 = *(const f32x4*)(pp + 8), q3 = *(const f32x4*)(pp + 12);
        const f32x4 qs = q0 + q1 + q2 + q3;
        const float rstd = rsqrtf((qs[0] + qs[1] + qs[2] + qs[3]) * (1.f / DM) + EPS);
        const float* shw = p.shw_ff1 + ((size_t)l * 5 + 4) * FF + gcol;
        const f32x4 h0 = *(const f32x4*)shw, h1 = *(const f32x4*)(shw + 4);
        s0 = s0 * rstd + h0; s1 = s1 * rstd + h1;
#pragma unroll
        for (int j = 0; j < 4; ++j) { float r0 = fmaxf(s0[j], 0.f), r1 = fmaxf(s1[j], 0.f); s0[j] = r0 * r0; s1[j] = r1 * r1; }
        u32x4 w; w[0] = pk2(s0[0], s0[1]); w[1] = pk2(s0[2], s0[3]); w[2] = pk2(s1[0], s1[1]); w[3] = pk2(s1[2], s1[3]);
        *(u32x4*)(p.ACT + (size_t)(NLAT + grow) * FF + gcol) = w;
    } else {
        const float* gate = p.mod + ((size_t)l * 5 + 4) * 6144 + (EK == 1 ? 2 : 5) * DM + gcol;
        float* xr = p.xc + (size_t)grow * DM + gcol;
        const f32x4 g0 = *(const f32x4*)gate, g1 = *(const f32x4*)(gate + 4);
        f32x4 x0 = *(const f32x4*)xr, x1 = *(const f32x4*)(xr + 4);
        x0 += g0 * s0; x1 += g1 * s1;
        *(f32x4*)xr = x0; *(f32x4*)(xr + 4) = x1;
        const int ln = EK == 1 ? l : l + 1;
        const float* gnx = (EK == 1 ? p.norm2_g : p.norm1_g) + (size_t)ln * DM + gcol;
        const float* scn = p.mod + ((size_t)ln * 5 + 4) * 6144 + (EK == 1 ? 4 : 1) * DM + gcol;
        const f32x4 a0 = *(const f32x4*)gnx * (1.f + *(const f32x4*)scn), a1 = *(const f32x4*)(gnx + 4) * (1.f + *(const f32x4*)(scn + 4));
        const f32x4 y0 = x0 * a0, y1 = x1 * a1;
        u32x4 w; w[0] = pk2(y0[0], y0[1]); w[1] = pk2(y0[2], y0[3]); w[2] = pk2(y1[0], y1[1]); w[3] = pk2(y1[2], y1[3]);
        *(u32x4*)(p.H + (size_t)(NLAT + grow) * DM + gcol) = w;
        float part = x0[0] * x0[0] + x0[1] * x0[1] + x0[2] * x0[2] + x0[3] * x0[3] + x1[0] * x1[0] + x1[1] * x1[1] + x1[2] * x1[2] + x1[3] * x1[3];
        part += __shfl_xor(part, 1); part += __shfl_xor(part, 2); part += __shfl_xor(part, 4);
        if (lead) p.ss[((size_t)(ln * 2 + (EK == 1 ? 1 : 0)) * NTOK + NLAT + grow) * 16 + slot] = part;
    }
}

template <int EK, int TS, int KS>
DI void ctx_tiles(const Params& p, int l, const bf16_t* __restrict__ A, const bf16_t* __restrict__ Bt, int N, int K, ldsp_t shm) {
    constexpr int WM = TS / 2, WN = TS / 4, MT = WM / 16, NT = WN / 16, BKC = 32 * KS;
    constexpr int TILE_A = TS * BKC * 2, PP = TILE_A / 8192;
    const int ntn = N / TS, ntiles = (NCTX / TS) * ntn, nt = K / BKC;
    for (int u = blockIdx.x; u < ntiles; u += gridDim.x) {
        const int tm = u / ntn, tn = u % ntn;
        int tid = threadIdx.x;
        asm volatile("" : "+v"(tid));
        const int wid = tid >> 6, lane = tid & 63, wr = wid >> 2, wc = wid & 3, fr = lane & 15, fq = lane >> 4;
        unsigned soff[PP];
#pragma unroll
        for (int i = 0; i < PP; ++i) { int sR, sC; stage_rc_ks<KS>((wid * PP + i) * 1024 + lane * 16, sR, sC); soff[i] = (unsigned)(sR * K + sC) * 2u; }
        const bf16_t* Ab = A + (size_t)tm * TS * K;
        const bf16_t* Bb = Bt + (size_t)tn * TS * K;
#define C_STAGE(buf, kt) do { const char* ab_ = (const char*)Ab + (size_t)(kt) * (BKC * 2); const char* bb_ = (const char*)Bb + (size_t)(kt) * (BKC * 2); \
      _Pragma("unroll") for (int i = 0; i < PP; ++i) { \
        __builtin_amdgcn_global_load_lds((const unsigned*)(ab_ + soff[i]), (LDSP unsigned*)(shm + (buf) * 2 * TILE_A + (wid * PP + i) * 1024), 16, 0, 0); \
        __builtin_amdgcn_global_load_lds((const unsigned*)(bb_ + soff[i]), (LDSP unsigned*)(shm + (buf) * 2 * TILE_A + TILE_A + (wid * PP + i) * 1024), 16, 0, 0); } } while (0)
        f32x4 acc[MT][NT];
#pragma unroll
        for (int m = 0; m < MT; ++m)
#pragma unroll
            for (int n = 0; n < NT; ++n) acc[m][n] = (f32x4){0.f, 0.f, 0.f, 0.f};
        const int aoff = lds_byte_ks<KS>(wr * WM + fr, fq * 8), boff = lds_byte_ks<KS>(wc * WN + fr, fq * 8);
        C_STAGE(0, 0); WAIT_V0(); __syncthreads();
        for (int t = 0; t < nt; ++t) {
            const int cur = t & 1;
            if (t + 1 < nt) C_STAGE(cur ^ 1, t + 1);
            ldsp_t sa = shm + cur * 2 * TILE_A, sb = sa + TILE_A;
#pragma unroll
            for (int ks = 0; ks < KS; ++ks) {
                bf16x8 At[MT], Bf[NT];
#pragma unroll
                for (int m = 0; m < MT; ++m) At[m] = *(const LDSP bf16x8*)(sa + aoff + m * (KS * 1024) + ks * 1024);
#pragma unroll
                for (int n = 0; n < NT; ++n) Bf[n] = *(const LDSP bf16x8*)(sb + boff + n * (KS * 1024) + ks * 1024);
#pragma unroll
                for (int m = 0; m < MT; ++m)
#pragma unroll
                    for (int n = 0; n < NT; ++n) acc[m][n] = __builtin_amdgcn_mfma_f32_16x16x32_bf16(Bf[n], At[m], acc[m][n], 0, 0, 0);
            }
            WAIT_V0(); __syncthreads();
        }
#pragma unroll
        for (int m = 0; m < MT; ++m)
#pragma unroll
            for (int n = 0; n < NT; ++n) {
                const int row = wr * WM + m * 16 + fr, ch = (wc * WN + n * 16 + fq * 4) >> 2;
                *(LDSP f32x4*)(shm + row * (TS * 4) + ((ch ^ (row & 15)) << 4)) = acc[m][n];
            }
        __syncthreads();
#pragma unroll
        for (int it = 0; it < (TS * TS / 8) / 512; ++it) {
            const int item = it * 512 + tid, row = item / (TS / 8), c8 = item % (TS / 8);
            const f32x4 s0 = *(const LDSP f32x4*)(shm + row * (TS * 4) + (((2 * c8) ^ (row & 15)) << 4));
            const f32x4 s1 = *(const LDSP f32x4*)(shm + row * (TS * 4) + (((2 * c8 + 1) ^ (row & 15)) << 4));
            ctx_item<EK>(p, l, tm * TS + row, tn * TS + c8 * 8, tn, s0, s1, c8 == 0);
        }
        __syncthreads();
    }
}

DI void attn_unit(const Params& p, int l, int b, int kvh, int qb, bool isctx, ldsp_t smem) {
    int tid = threadIdx.x;
    asm volatile("" : "+v"(tid));
    const int wid = tid >> 6, lane = tid & 63, r = lane & 31, hh = lane >> 5;
    const int head = kvh * 4 + (wid >> 1);
    const int t0 = qb * 64 + (wid & 1) * 32;
    const int nkeys = isctx ? CTXL : NKEY;
    const bf16_t* Qp = isctx ? p.Qc + ((size_t)(b * 8 + head) * CTXL + t0) * 64 : p.Q + ((size_t)(b * 8 + head) * SEQ + t0) * 64;
    const bf16_t* Kp = p.K + (size_t)(b * 2 + kvh) * NKEY * 64;
    const bf16_t* Vp = p.Vt + (size_t)(b * 2 + kvh) * 64 * NKEY;
    const int orow = isctx ? NLAT + b * CTXL + t0 : b * SEQ + t0;
    bf16_t* Op = p.MIX + (size_t)orow * DM + head * 64;
    const float cexp = p.smax[l] * LOG2E;

    bf16x8 qf[4];
#pragma unroll
    for (int ks = 0; ks < 4; ++ks) qf[ks] = *(const bf16x8*)(Qp + (size_t)r * 64 + ks * 16 + 8 * hh);
    f32x16 o[2];
#pragma unroll
    for (int i = 0; i < 16; ++i) { o[0][i] = 0.f; o[1][i] = 0.f; }
    float rs0 = 0.f, rs1 = 0.f;

    const int srow = tid >> 3, sch = tid & 7;
    const int kdst = srow * 128 + ((sch ^ ((srow >> 1) & 7)) << 4);
    const bf16_t* kg = Kp + (size_t)srow * 64 + sch * 8;
    const bf16_t* vg = Vp + (size_t)srow * NKEY + sch * 8;
    const int rsw = (r >> 1) & 7;
    const int ntile = nkeys / 64;

#define ATT_QK(SD, kb) do { _Pragma("unroll") for (int kt = 0; kt < 2; ++kt) { \
        _Pragma("unroll") for (int i = 0; i < 16; ++i) SD[kt][i] = 0.f; \
        _Pragma("unroll") for (int ks = 0; ks < 4; ++ks) { \
            const bf16x8 a_ = *(const LDSP bf16x8*)((kb) + (kt * 32 + r) * 128 + (((ks * 2 + hh) ^ rsw) << 4)); \
            SD[kt] = __builtin_amdgcn_mfma_f32_32x32x16_bf16(a_, qf[ks], SD[kt], 0, 0, 0); } } } while (0)

    u32x4 kst, vst;
    f32x16 sA[2], sB[2];
    {
        kst = *(const u32x4*)kg;
        *(LDSP u32x4*)(smem + kdst) = kst;
        kst = *(const u32x4*)(kg + (size_t)64 * 64);
        vst = *(const u32x4*)vg;
        __syncthreads();
        ATT_QK(sA, smem);
        *(LDSP u32x4*)(smem + 8192 + kdst) = kst;
        *(LDSP u32x4*)(smem + 16384 + kdst) = vst;
    }
#define ATT_STEP(t, SC, SN) do { \
        const int par = (t) & 1; \
        __syncthreads(); \
        { const int t2_ = (t) + 2 < ntile ? (t) + 2 : ntile - 1, t1_ = (t) + 1 < ntile ? (t) + 1 : ntile - 1; \
          kst = *(const u32x4*)(kg + (size_t)t2_ * 64 * 64); vst = *(const u32x4*)(vg + t1_ * 64); } \
        bf16x8 kf[8], vf[4], vh[4]; \
        ldsp_t kb_ = smem + (par ^ 1) * 8192; ldsp_t vb_ = smem + 16384 + par * 8192; \
        _Pragma("unroll") for (int kt = 0; kt < 2; ++kt) _Pragma("unroll") for (int ks = 0; ks < 4; ++ks) \
            kf[kt * 4 + ks] = *(const LDSP bf16x8*)(kb_ + (kt * 32 + r) * 128 + (((ks * 2 + hh) ^ rsw) << 4)); \
        _Pragma("unroll") for (int c = 0; c < 2; ++c) _Pragma("unroll") for (int dt = 0; dt < 2; ++dt) \
            vf[c * 2 + dt] = *(const LDSP bf16x8*)(vb_ + (dt * 32 + r) * 128 + (((c * 2 + hh) ^ rsw) << 4)); \
        __builtin_amdgcn_sched_barrier(0); \
        _Pragma("unroll") for (int kt = 0; kt < 2; ++kt) _Pragma("unroll") for (int i = 0; i < 16; ++i) SN[kt][i] = 0.f; \
        _Pragma("unroll") for (int ks = 0; ks < 4; ++ks) _Pragma("unroll") for (int kt = 0; kt < 2; ++kt) \
            SN[kt] = __builtin_amdgcn_mfma_f32_32x32x16_bf16(kf[kt * 4 + ks], qf[ks], SN[kt], 0, 0, 0); \
        _Pragma("unroll") for (int c = 2; c < 4; ++c) _Pragma("unroll") for (int dt = 0; dt < 2; ++dt) \
            vh[(c - 2) * 2 + dt] = *(const LDSP bf16x8*)(vb_ + (dt * 32 + r) * 128 + (((c * 2 + hh) ^ rsw) << 4)); \
        __builtin_amdgcn_sched_barrier(0); \
        _Pragma("unroll") for (int kt = 0; kt < 2; ++kt) { \
            _Pragma("unroll") for (int i = 0; i < 16; ++i) { \
                const float e_ = fexp2(SC[kt][i] * LOG2E - cexp); \
                if (i & 1) rs1 += e_; else rs0 += e_; \
                SC[kt][i] = e_; } } \
        _Pragma("unroll") for (int c = 0; c < 4; ++c) { \
            u32x4 pw; \
            pw[0] = pk2(SC[c >> 1][8 * (c & 1) + 0], SC[c >> 1][8 * (c & 1) + 1]); pw[1] = pk2(SC[c >> 1][8 * (c & 1) + 2], SC[c >> 1][8 * (c & 1) + 3]); \
            pw[2] = pk2(SC[c >> 1][8 * (c & 1) + 4], SC[c >> 1][8 * (c & 1) + 5]); pw[3] = pk2(SC[c >> 1][8 * (c & 1) + 6], SC[c >> 1][8 * (c & 1) + 7]); \
            const bf16x8 pb = __builtin_bit_cast(bf16x8, pw); \
            _Pragma("unroll") for (int dt = 0; dt < 2; ++dt) o[dt] = __builtin_amdgcn_mfma_f32_32x32x16_bf16(c < 2 ? vf[c * 2 + dt] : vh[(c - 2) * 2 + dt], pb, o[dt], 0, 0, 0); } \
        *(LDSP u32x4*)(smem + par * 8192 + kdst) = kst; \
        *(LDSP u32x4*)(smem + 16384 + (par ^ 1) * 8192 + kdst) = vst; \
    } while (0)

    for (int t = 0; t < ntile; t += 2) {
        ATT_STEP(t, sA, sB);
        ATT_STEP(t + 1, sB, sA);
    }
    const float lrun = rs0 + rs1;
    const float ltot = lrun + __shfl_xor(lrun, 32);
    const float inv = 1.f / ltot;
#pragma unroll
    for (int dt = 0; dt < 2; ++dt)
#pragma unroll
        for (int g4 = 0; g4 < 4; ++g4) {
            u32x2 w; w[0] = pk2(o[dt][4 * g4 + 0] * inv, o[dt][4 * g4 + 1] * inv); w[1] = pk2(o[dt][4 * g4 + 2] * inv, o[dt][4 * g4 + 3] * inv);
            *(u32x2*)(Op + (size_t)r * DM + dt * 32 + 8 * g4 + 4 * hh) = w;
        }
    __syncthreads();
}

DI void gmlp_unit(const Params& p, int l, int T, int g, ldsp_t smem) {
    int tid = threadIdx.x;
    asm volatile("" : "+v"(tid));
    const int wid = tid >> 6, lane = tid & 63, fr = lane & 15, fq = lane >> 4;
    {
        const int q = tid >> 2, part = tid & 3;
        const bf16_t* src = p.U + (size_t)(T * 128 + q) * 1024 + 512 + g * 128 + part * 32;
        u32x4 raw[4];
#pragma unroll
        for (int i = 0; i < 4; ++i) raw[i] = *(const u32x4*)(src + i * 8);
        float a = 0.f, b = 0.f;
#pragma unroll
        for (int i = 0; i < 4; ++i)
#pragma unroll
            for (int j = 0; j < 4; ++j) {
                const float lo = __uint_as_float(raw[i][j] << 16), hi = __uint_as_float(raw[i][j] & 0xffff0000u);
                a += lo + hi; b += lo * lo + hi * hi;
            }
        a += __shfl_xor(a, 1); a += __shfl_xor(a, 2);
        b += __shfl_xor(b, 1); b += __shfl_xor(b, 2);
        const float mean = a * (1.f / 128.f);
        const float rstd = rsqrtf(fmaxf(b * (1.f / 128.f) - mean * mean, 0.f) + EPS);
        const float* gn = p.gmlp_norm_g + l * 512 + g * 128 + part * 32;
#pragma unroll
        for (int i = 0; i < 4; ++i)
#pragma unroll
            for (int j = 0; j < 4; ++j) {
                const int c0 = part * 32 + i * 8 + j * 2;
                const float lo = __uint_as_float(raw[i][j] << 16), hi = __uint_as_float(raw[i][j] & 0xffff0000u);
                const unsigned w = pk2((lo - mean) * rstd * gn[i * 8 + j * 2], (hi - mean) * rstd * gn[i * 8 + j * 2 + 1]);
                *(LDSP bf16_t*)(smem + c0 * 256 + (((q >> 3) ^ (c0 & 15)) << 4) + (q & 7) * 2) = (bf16_t)(w & 0xffffu);
                *(LDSP bf16_t*)(smem + (c0 + 1) * 256 + (((q >> 3) ^ ((c0 + 1) & 15)) << 4) + (q & 7) * 2) = (bf16_t)(w >> 16);
            }
    }
    __syncthreads();
    const int prow = wid * 16 + fr;
    const bf16_t* wsp = p.ws_bf + ((size_t)(l * 4 + g) * 128 + prow) * 128 + fq * 8;
    bf16x8 a[4];
#pragma unroll
    for (int ks = 0; ks < 4; ++ks) a[ks] = *(const bf16x8*)(wsp + ks * 32);
    f32x4 acc[8];
#pragma unroll
    for (int n = 0; n < 8; ++n) {
        acc[n] = (f32x4){0.f, 0.f, 0.f, 0.f};
        const int c = n * 16 + fr;
#pragma unroll
        for (int ks = 0; ks < 4; ++ks) {
            const bf16x8 bq = *(const LDSP bf16x8*)(smem + c * 256 + (((ks * 4 + fq) ^ (c & 15)) << 4));
            acc[n] = __builtin_amdgcn_mfma_f32_16x16x32_bf16(bq, a[ks], acc[n], 0, 0, 0);
        }
    }
    const float bs = p.b_spatial[(size_t)(l * 4 + g) * 128 + prow];
    const int row = T * 128 + prow;
    const bf16_t* up = p.U + (size_t)row * 1024 + g * 128 + fq * 4;
    bf16_t* mp = p.MIX + (size_t)row * DM + 512 + g * 128 + fq * 4;
#pragma unroll
    for (int n = 0; n < 8; ++n) {
        const u32x2 uu = *(const u32x2*)(up + n * 16);
        const float u0 = __uint_as_float(uu[0] << 16), u1 = __uint_as_float(uu[0] & 0xffff0000u), u2 = __uint_as_float(uu[1] << 16), u3 = __uint_as_float(uu[1] & 0xffff0000u);
        u32x2 w; w[0] = pk2((acc[n][0] + bs) * u0, (acc[n][1] + bs) * u1); w[1] = pk2((acc[n][2] + bs) * u2, (acc[n][3] + bs) * u3);
        *(u32x2*)(mp + n * 16) = w;
    }
    __syncthreads();
}

DI void mixer_phase(const Params& p, int l, ldsp_t smem) {
    const bool last = l == DEPTH - 1;
    for (int u = blockIdx.x; u < 512; u += gridDim.x) attn_unit(p, l, (u & 7) >> 1, u & 1, u >> 3, false, smem);
    if (!last)
        for (int u = blockIdx.x; u < 32; u += gridDim.x) attn_unit(p, l, (u & 7) >> 1, u & 1, u >> 3, true, smem);
    const int nT = last ? 128 : 136;
    for (int u = blockIdx.x; u < nT * 4; u += gridDim.x) gmlp_unit(p, l, u >> 2, u & 3, smem);
}

constexpr int N_PHASES = 2 + DEPTH * 5;
DI void run_phase(const Params& p, int ph, ldsp_t smem) {
    if (ph == 0) { phase0(p, smem); return; }
    if (ph == 1) { phase1(p); return; }
    const int l = (ph - 2) / 5, k = (ph - 2) % 5;
    const bool last = l == DEPTH - 1;
    switch (k) {
        case 0: gemm_stream<0>(p, l, p.H, p.wt_in + (size_t)l * IN_DIM * DM, NTOK, IN_DIM, DM, smem); break;
        case 1: mixer_phase(p, l, smem); break;
        case 2: gemm_stream<1>(p, l, p.MIX, p.wt_out + (size_t)l * DM * DM, NLAT, DM, DM, smem);
                if (!last) ctx_tiles<1, 64, 8>(p, l, p.MIX + (size_t)NLAT * DM, p.wt_out + (size_t)l * DM * DM, DM, DM, smem);
                break;
        case 3: gemm_stream<2>(p, l, p.H, p.wt_ff1 + (size_t)l * FF * DM, NLAT, FF, DM, smem);
                if (!last) ctx_tiles<2, 128, 4>(p, l, p.H + (size_t)NLAT * DM, p.wt_ff1 + (size_t)l * FF * DM, FF, DM, smem);
                break;
        default: gemm_stream<3>(p, l, p.ACT, p.wt_ff2 + (size_t)l * DM * FF, NLAT, DM, FF, smem);
                if (!last) ctx_tiles<3, 64, 8>(p, l, p.ACT + (size_t)NLAT * FF, p.wt_ff2 + (size_t)l * DM * FF, DM, FF, smem);
                break;
    }
}

template <bool COOP>
__global__ void __launch_bounds__(512) mk_kernel(Params p, int ph_lo, int ph_hi) {
    __shared__ __attribute__((aligned(1024))) char smem_raw[2 * G_STAGE_B + 8192];
    ldsp_t smem = (ldsp_t)smem_raw;
    for (int ph = ph_lo; ph < ph_hi; ++ph) {
        run_phase(p, ph, smem);
#ifdef DUP_K
        if (ph > 1 && (ph - 2) % 5 == DUP_K) { cg::this_grid().sync(); run_phase(p, ph, smem); }
#endif
        if (COOP && ph + 1 < ph_hi) cg::this_grid().sync();
    }
}

extern "C" void kernel_launch(void* const* d_in, const int* in_sizes, int n_in, void* d_out, int out_size, void* d_ws, size_t ws_size, hipStream_t stream) {
    Params p{};
    p.x = (const float*)d_in[0]; p.c = (const float*)d_in[1]; p.ctx = (const float*)d_in[2]; p.c_ctx = (const float*)d_in[3];
    p.w_mod = (const float*)d_in[4]; p.b_mod = (const float*)d_in[5]; p.norm1_g = (const float*)d_in[6]; p.w_in = (const float*)d_in[7];
    p.q_norm_g = (const float*)d_in[8]; p.k_norm_g = (const float*)d_in[9]; p.gmlp_norm_g = (const float*)d_in[10]; p.w_spatial = (const float*)d_in[11];
    p.b_spatial = (const float*)d_in[12]; p.w_out = (const float*)d_in[13]; p.norm2_g = (const float*)d_in[14]; p.w_ff1 = (const float*)d_in[15]; p.w_ff2 = (const float*)d_in[16];
    p.out = (float*)d_out;
    char* w = (char*)d_ws; size_t off = 0;
    auto take = [&](size_t bytes) { char* r = w + off; off += (bytes + 1023) & ~(size_t)1023; return r; };
    p.wt_in = (bf16_t*)take((size_t)DEPTH * IN_DIM * DM * 2);
    p.wt_out = (bf16_t*)take((size_t)DEPTH * DM * DM * 2);
    p.wt_ff1 = (bf16_t*)take((size_t)DEPTH * FF * DM * 2);
    p.wt_ff2 = (bf16_t*)take((size_t)DEPTH * FF * DM * 2);
    p.ws_bf = (bf16_t*)take((size_t)DEPTH * 4 * 128 * 128 * 2);
    p.mod = (float*)take((size_t)DEPTH * 5 * 6144 * 4);
    p.rope = (float*)take(2048 * 4);
    p.xc = (float*)take((size_t)NCTX * DM * 4);
    p.smax = (float*)take(1024);
    p.ss = (float*)take((size_t)DEPTH * 2 * NTOK * 16 * 4);
    p.shw_in = (float*)take((size_t)DEPTH * 5 * IN_DIM * 4);
    p.shw_ff1 = (float*)take((size_t)DEPTH * 5 * FF * 4);
    p.H = (bf16_t*)take((size_t)NTOK * DM * 2);
    p.ACT = (bf16_t*)take((size_t)NTOK * FF * 2);
    {
        char* a = (char*)p.ACT; size_t o2 = 0;
        auto take2 = [&](size_t bytes) { char* r = a + o2; o2 += (bytes + 1023) & ~(size_t)1023; return r; };
        p.Q = (bf16_t*)take2((size_t)NLAT * 512 * 2);
        p.Qc = (bf16_t*)take2((size_t)NCTX * 512 * 2);
        p.K = (bf16_t*)take2((size_t)NB * 2 * NKEY * 64 * 2);
        p.Vt = (bf16_t*)take2((size_t)NB * 2 * NKEY * 64 * 2);
        p.U = (bf16_t*)take2((size_t)NTOK * 1024 * 2);
        p.MIX = (bf16_t*)take2((size_t)NTOK * DM * 2);
    }
    if (off > ws_size) { fprintf(stderr, "workspace too small: need %zu have %zu\n", off, ws_size); return; }
#if MK_COOP
    static int grid_blocks = 0;
    if (!grid_blocks) {
        int dev = 0, cus = 0, per_cu = 0;
        hipGetDevice(&dev);
        hipDeviceGetAttribute(&cus, hipDeviceAttributeMultiprocessorCount, dev);
        hipOccupancyMaxActiveBlocksPerMultiprocessor(&per_cu, mk_kernel<true>, 512, 0);
        if (per_cu < 1) per_cu = 1;
        grid_blocks = cus * 1;
    }
    int lo = 0, hi = N_PHASES;
    void* args[] = {&p, &lo, &hi};
    hipError_t e = hipLaunchCooperativeKernel((void*)mk_kernel<true>, dim3(grid_blocks), dim3(512), args, 0, stream);
    if (e != hipSuccess) fprintf(stderr, "cooperative launch failed: %s (grid %d)\n", hipGetErrorString(e), grid_blocks);
#else
    for (int ph = 0; ph < N_PHASES; ++ph) mk_kernel<false><<<256, 512, 0, stream>>>(p, ph, ph + 1);
#endif
}
```

```cpp
#include <hip/hip_runtime.h>
#include <hip/hip_cooperative_groups.h>
#include <stdint.h>
#include <cstdio>
namespace cg = cooperative_groups;

#ifndef MK_COOP
#define MK_COOP 1
#endif

#define DI __device__ __forceinline__
#define LDSP __attribute__((address_space(3)))
typedef LDSP char* ldsp_t;
typedef unsigned short bf16_t;
typedef short bf16x8 __attribute__((ext_vector_type(8)));
typedef float f32x2 __attribute__((ext_vector_type(2)));
typedef float f32x4 __attribute__((ext_vector_type(4)));
typedef float f32x16 __attribute__((ext_vector_type(16)));
typedef unsigned u32x2 __attribute__((ext_vector_type(2)));
typedef unsigned u32x4 __attribute__((ext_vector_type(4)));
typedef __bf16 bf2_t __attribute__((ext_vector_type(2)));

constexpr int DM = 1024, NB = 4, SEQ = 4096, DEPTH = 4, CTXL = 256;
constexpr int NLAT = NB * SEQ;
constexpr int NCTX = NB * CTXL;
constexpr int NTOK = NLAT + NCTX;
constexpr int IN_DIM = 1792, FF = 4096, NKEY = CTXL + SEQ;
constexpr float EPS = 1e-6f;
constexpr float LOG2E = 1.4426950408889634f;

struct Params {
    const float *x, *c, *ctx, *c_ctx, *w_mod, *b_mod, *norm1_g, *w_in, *q_norm_g, *k_norm_g, *gmlp_norm_g, *w_spatial, *b_spatial, *w_out, *norm2_g, *w_ff1, *w_ff2;
    float* out;
    bf16_t *wt_in, *wt_out, *wt_ff1, *wt_ff2, *ws_bf;
    float *mod, *rope, *xc, *smax, *ss, *shw_in, *shw_ff1;
    unsigned* bar;
    bf16_t *H, *Q, *Qc, *K, *Vt, *U, *MIX, *ACT;
};

DI unsigned pk2(float a, float b) { f32x2 v = {a, b}; bf2_t r = __builtin_convertvector(v, bf2_t); return __builtin_bit_cast(unsigned, r); }
DI bf16_t f2bf(float a) { return (bf16_t)(pk2(a, 0.f) & 0xffffu); }
DI float fexp2(float x) { return __builtin_amdgcn_exp2f(x); }
DI float gelu_tanh(float x) {
    const float y = 0.7978845608028654f * (x + 0.044715f * x * x * x);
    return x * __builtin_amdgcn_rcpf(1.f + fexp2(-2.f * LOG2E * y));
}
DI float* xrow_ptr(const Params& p, int row) { return row < NLAT ? p.out + (size_t)row * DM : p.xc + (size_t)(row - NLAT) * DM; }

DI void transpose_tile(const float* __restrict__ src, bf16_t* __restrict__ dst, int K, int N, int tk, int tn, ldsp_t smem) {
    LDSP float* t = (LDSP float*)smem;
    int tid = threadIdx.x;
    asm volatile("" : "+v"(tid));
    const int k0 = tk * 64, n0 = tn * 256;
    f32x4 v[8];
#pragma unroll
    for (int i = 0; i < 8; ++i) v[i] = *(const f32x4*)(src + (size_t)(k0 + (tid >> 6) + 8 * i) * N + n0 + (tid & 63) * 4);
#pragma unroll
    for (int i = 0; i < 8; ++i) {
        const int k = (tid >> 6) + 8 * i, n4 = (tid & 63) * 4;
        t[k * 257 + n4 + 0] = v[i][0]; t[k * 257 + n4 + 1] = v[i][1]; t[k * 257 + n4 + 2] = v[i][2]; t[k * 257 + n4 + 3] = v[i][3];
    }
    __syncthreads();
#pragma unroll
    for (int j = 0; j < 4; ++j) {
        const int n = (tid >> 3) + 64 * j, k8 = (tid & 7) * 8;
        u32x4 w;
        w[0] = pk2(t[(k8 + 0) * 257 + n], t[(k8 + 1) * 257 + n]);
        w[1] = pk2(t[(k8 + 2) * 257 + n], t[(k8 + 3) * 257 + n]);
        w[2] = pk2(t[(k8 + 4) * 257 + n], t[(k8 + 5) * 257 + n]);
        w[3] = pk2(t[(k8 + 6) * 257 + n], t[(k8 + 7) * 257 + n]);
        *(u32x4*)(dst + (size_t)(n0 + n) * K + k0 + k8) = w;
    }
    __syncthreads();
}

DI void mod_unit(const Params& p, int l, int cgi, ldsp_t smem) {
    LDSP float* s = (LDSP float*)smem;
    LDSP float* red = (LDSP float*)(smem + 20480);
    int tid = threadIdx.x;
    asm volatile("" : "+v"(tid));
    for (int i = tid; i < 5 * 1024; i += 512) {
        const int cnd = i >> 10, k = i & 1023;
        const float v = cnd < 4 ? p.c[cnd * 1024 + k] : p.c_ctx[k];
        s[i] = v / (1.f + fexp2(-LOG2E * v));
    }
    __syncthreads();
    const int c4 = tid & 15, ks = tid >> 4;
    f32x4 acc[5];
#pragma unroll
    for (int q = 0; q < 5; ++q) acc[q] = (f32x4){0.f, 0.f, 0.f, 0.f};
    const float* wp = p.w_mod + ((size_t)l * 1024 + ks * 32) * 6144 + cgi * 64 + c4 * 4;
#pragma unroll 8
    for (int kk = 0; kk < 32; ++kk) {
        const f32x4 w = *(const f32x4*)(wp + (size_t)kk * 6144);
        const int k = ks * 32 + kk;
#pragma unroll
        for (int q = 0; q < 5; ++q) acc[q] += w * s[q * 1024 + k];
    }
#pragma unroll
    for (int q = 0; q < 5; ++q)
#pragma unroll
        for (int j = 0; j < 4; ++j) red[(ks * 5 + q) * 64 + c4 * 4 + j] = acc[q][j];
    __syncthreads();
    if (tid < 320) {
        const int q = tid >> 6, col = tid & 63;
        float a = 0.f;
        for (int k2 = 0; k2 < 32; ++k2) a += red[(k2 * 5 + q) * 64 + col];
        const int j = cgi * 64 + col;
        p.mod[((size_t)l * 5 + q) * 6144 + j] = a + p.b_mod[(size_t)l * 6144 + j];
    }
    __syncthreads();
}

DI void phase0(const Params& p, ldsp_t smem) {
    constexpr int T_IN = 16 * 7, T_OUT = 16 * 4, T_FF1 = 16 * 16, T_FF2 = 64 * 4;
    constexpr int T_L = T_IN + T_OUT + T_FF1 + T_FF2;
    constexpr int U_T = DEPTH * T_L;
    constexpr int U_MOD = DEPTH * 96;
    constexpr int U_WS = 64;
    constexpr int U_ALL = U_MOD + U_T + U_WS + 1;
    for (int u = blockIdx.x; u < U_ALL; u += gridDim.x) {
        if (u < U_MOD) { mod_unit(p, u / 96, u % 96, smem); continue; }
        int v = u - U_MOD;
        if (v < U_T) {
            const int l = v / T_L; int r = v % T_L;
            if (r < T_IN) { transpose_tile(p.w_in + (size_t)l * DM * IN_DIM, p.wt_in + (size_t)l * IN_DIM * DM, DM, IN_DIM, r / 7, r % 7, smem); continue; }
            r -= T_IN;
            if (r < T_OUT) { transpose_tile(p.w_out + (size_t)l * DM * DM, p.wt_out + (size_t)l * DM * DM, DM, DM, r / 4, r % 4, smem); continue; }
            r -= T_OUT;
            if (r < T_FF1) { transpose_tile(p.w_ff1 + (size_t)l * DM * FF, p.wt_ff1 + (size_t)l * FF * DM, DM, FF, r / 16, r % 16, smem); continue; }
            r -= T_FF1;
            transpose_tile(p.w_ff2 + (size_t)l * FF * DM, p.wt_ff2 + (size_t)l * DM * FF, FF, DM, r / 4, r % 4, smem); continue;
        }
        v -= U_T;
        if (v < U_WS) {
            int tw = threadIdx.x;
            asm volatile("" : "+v"(tw));
            const size_t i = ((size_t)v * 512 + tw) * 8;
            const f32x4 a = *(const f32x4*)(p.w_spatial + i), b = *(const f32x4*)(p.w_spatial + i + 4);
            u32x4 w; w[0] = pk2(a[0], a[1]); w[1] = pk2(a[2], a[3]); w[2] = pk2(b[0], b[1]); w[3] = pk2(b[2], b[3]);
            *(u32x4*)(p.ws_bf + i) = w;
            continue;
        }
        int ti = threadIdx.x;
        asm volatile("" : "+v"(ti));
        if (ti == 64) *p.bar = 0u;
        if (ti < DEPTH) {
            float mq = 0.f, mk = 0.f;
            for (int i = 0; i < 64; ++i) { mq = fmaxf(mq, fabsf(p.q_norm_g[ti * 64 + i])); mk = fmaxf(mk, fabsf(p.k_norm_g[ti * 64 + i])); }
            p.smax[ti] = 8.f * mq * mk;
        }
        for (int i = ti; i < 1024; i += 512) {
            const int pos = i >> 4, f = i & 15;
            const float inv = fexp2(-(float)f * (13.287712379549449f / 16.f));
            const float rev = (float)pos * inv * 0.15915494309189535f;
            p.rope[i] = __builtin_amdgcn_cosf(rev);
            p.rope[1024 + i] = __builtin_amdgcn_sinf(rev);
        }
    }
}

DI void phase1(const Params& p) {
    int tid = threadIdx.x;
    asm volatile("" : "+v"(tid));
    const int lane = tid & 63, wid = tid >> 6;
    const int gw = blockIdx.x * 8 + wid, nw = gridDim.x * 8;
    for (int row = gw; row < NTOK; row += nw) {
        const float* src = row < NLAT ? p.x + (size_t)row * DM : p.ctx + (size_t)(row - NLAT) * DM;
        const int cond = row < NLAT ? (row >> 12) : 4;
        const float* mp = p.mod + ((size_t)cond) * 6144;
        f32x4 v[4];
        float ss = 0.f;
#pragma unroll
        for (int i = 0; i < 4; ++i) { v[i] = *(const f32x4*)(src + i * 256 + lane * 4); ss += v[i][0] * v[i][0] + v[i][1] * v[i][1] + v[i][2] * v[i][2] + v[i][3] * v[i][3]; }
#pragma unroll
        for (int o = 1; o < 64; o <<= 1) ss += __shfl_xor(ss, o);
        if (lane < 16) p.ss[(size_t)row * 16 + lane] = lane == 0 ? ss : 0.f;
        bf16_t* hp = p.H + (size_t)row * DM;
        float* xw = xrow_ptr(p, row);
#pragma unroll
        for (int i = 0; i < 4; ++i) {
            const int idx = i * 256 + lane * 4;
            const f32x4 gg = *(const f32x4*)(p.norm1_g + idx), sc = *(const f32x4*)(mp + DM + idx);
            f32x4 y;
#pragma unroll
            for (int j = 0; j < 4; ++j) y[j] = v[i][j] * gg[j] * (1.f + sc[j]);
            u32x2 w; w[0] = pk2(y[0], y[1]); w[1] = pk2(y[2], y[3]);
            *(u32x2*)(hp + idx) = w;
            *(f32x4*)(xw + idx) = v[i];
        }
    }
    {
        const int fr = lane & 15, fq = lane >> 4;
        constexpr int G_IN = IN_DIM / 16, G_FF = FF / 16, G_L = G_IN + G_FF;
        for (int gi = gw; gi < DEPTH * G_L; gi += nw) {
            const int l = gi / G_L, r = gi % G_L;
            const bool which = r >= G_IN;
            const int n0 = (which ? r - G_IN : r) * 16;
            const int N = which ? FF : IN_DIM;
            const bf16_t* W = (which ? p.wt_ff1 + (size_t)l * FF * DM : p.wt_in + (size_t)l * IN_DIM * DM) + (size_t)(n0 + fr) * DM + fq * 8;
            float* dst = which ? p.shw_ff1 + (size_t)l * 5 * FF : p.shw_in + (size_t)l * 5 * IN_DIM;
            const int c = fr < 5 ? fr : fr - 5;
            const float* sh = p.mod + ((size_t)l * 5 + (c < 5 ? c : 0)) * 6144 + (which ? 3 : 0) * DM + fq * 8;
            f32x4 acc = {0.f, 0.f, 0.f, 0.f};
#pragma unroll 8
            for (int ks = 0; ks < 32; ++ks) {
                const bf16x8 wv = *(const bf16x8*)(W + ks * 32);
                const f32x4 s0 = *(const f32x4*)(sh + ks * 32), s1 = *(const f32x4*)(sh + ks * 32 + 4);
                float sv[8] = {s0[0], s0[1], s0[2], s0[3], s1[0], s1[1], s1[2], s1[3]};
                u32x4 aw;
#pragma unroll
                for (int j = 0; j < 4; ++j) {
                    float a0 = sv[2 * j], a1 = sv[2 * j + 1];
                    const unsigned hi = pk2(a0, a1);
                    if (fr >= 5) { a0 -= __uint_as_float(hi << 16); a1 -= __uint_as_float(hi & 0xffff0000u); }
                    aw[j] = fr < 5 ? hi : (fr < 10 ? pk2(a0, a1) : 0u);
                }
                acc = __builtin_amdgcn_mfma_f32_16x16x32_bf16(__builtin_bit_cast(bf16x8, aw), wv, acc, 0, 0, 0);
            }
            const float r4 = __shfl(acc[0], fr + 16);
            const float r5 = __shfl(acc[1], fr + 16), r6 = __shfl(acc[2], fr + 16), r7 = __shfl(acc[3], fr + 16);
            const float r8 = __shfl(acc[0], fr + 32), r9 = __shfl(acc[1], fr + 32);
            if (fq == 0) {
                dst[(size_t)0 * N + n0 + fr] = acc[0] + r5;
                dst[(size_t)1 * N + n0 + fr] = acc[1] + r6;
                dst[(size_t)2 * N + n0 + fr] = acc[2] + r7;
                dst[(size_t)3 * N + n0 + fr] = acc[3] + r8;
                dst[(size_t)4 * N + n0 + fr] = r4 + r9;
            }
        }
    }
}

constexpr int G_TILE_B = 256 * 64 * 2, G_STAGE_B = 2 * G_TILE_B;
DI int lds_byte2(int r, int c) {
    const int st = (r >> 4) * 2 + (c >> 5), ob = (r & 15) * 64 + (c & 31) * 2;
    return st * 1024 + (ob ^ (((ob >> 9) & 1) << 5));
}
DI void stage_rc2(int b, int& R, int& C) {
    const int st = b >> 10, sb = b & 1023, swz = sb ^ (((sb >> 9) & 1) << 5);
    R = (st >> 1) * 16 + swz / 64;
    C = (st & 1) * 32 + (swz % 64) / 2;
}
template <int KS> DI int lds_byte_ks(int r, int c) {
    const int st = (r >> 4) * KS + (c >> 5), ob = (r & 15) * 64 + (c & 31) * 2;
    return st * 1024 + (ob ^ (((ob >> 9) & 1) << 5));
}
template <int KS> DI void stage_rc_ks(int b, int& R, int& C) {
    const int st = b >> 10, sb = b & 1023, swz = sb ^ (((sb >> 9) & 1) << 5);
    R = (st / KS) * 16 + swz / 64;
    C = (st % KS) * 32 + (swz % 64) / 2;
}
#define WAIT_V0() asm volatile("s_waitcnt vmcnt(0)" ::: "memory")

struct TileCtx { int brow, bcol, pn, wr, wc, fr, fq, wid, lane, l; };

DI void tile_coords(int L, int nM, int nN, int& pm, int& pn) {
    const int nwg = nM * nN;
    int wgid = L;
    { const int q = nwg / 8, r = nwg % 8, xcd = wgid % 8, off = wgid / 8; wgid = (xcd < r ? xcd * (q + 1) : r * (q + 1) + (xcd - r) * q) + off; }
    const int nig = 8 * nN, gid = wgid / nig, fm = gid * 8, gsz = (nM - fm) < 8 ? (nM - fm) : 8;
    pm = fm + ((wgid % nig) % gsz); pn = (wgid % nig) / gsz;
}

DI void wave_put(ldsp_t wb, int rowl, int n, int fq, u32x2 w) {
    const int chunk = n * 2 + (fq >> 1);
    *(LDSP u32x2*)(wb + rowl * 128 + ((chunk ^ (rowl & 7)) << 4) + (fq & 1) * 8) = w;
}
DI void wave_rows_store(ldsp_t wb, int lane, bf16_t* dst0, size_t ld) {
#pragma unroll
    for (int i = 0; i < 8; ++i) {
        const int row = i * 8 + (lane >> 3), ch = lane & 7;
        const u32x4 v = *(const LDSP u32x4*)(wb + row * 128 + ((ch ^ (row & 7)) << 4));
        *(u32x4*)(dst0 + (size_t)row * ld + ch * 8) = v;
    }
}

template <int EK> struct EpiResid {
    static DI void run(const f32x4 (&acc)[8][4], const TileCtx& tc, const Params& p, ldsp_t wb) {
        constexpr int GI = EK == 1 ? 2 : 5;
        const int cond = tc.brow < NLAT ? (tc.brow >> 12) : 4;
        const float* gate = p.mod + ((size_t)tc.l * 5 + cond) * 6144 + GI * DM;
        const int col0 = tc.bcol + tc.wc * 64 + tc.fq * 4;
        const bool has_next = EK == 1 || tc.l + 1 < DEPTH;
        const int ln = EK == 1 ? tc.l : (has_next ? tc.l + 1 : tc.l);
        const float* gnx = (EK == 1 ? p.norm2_g : p.norm1_g) + (size_t)ln * DM + col0;
        const float* scn = p.mod + ((size_t)ln * 5 + cond) * 6144 + (EK == 1 ? 4 : 1) * DM + col0;
        float* ssp = p.ss + (size_t)(ln * 2 + (EK == 1 ? 1 : 0)) * NTOK * 16 + (tc.bcol >> 8) * 4 + tc.wc;
        f32x4 gv[4], av[4];
#pragma unroll
        for (int n = 0; n < 4; ++n) {
            gv[n] = *(const f32x4*)(gate + col0 + n * 16);
            const f32x4 g1 = *(const f32x4*)(gnx + n * 16), s1 = *(const f32x4*)(scn + n * 16);
            av[n] = g1 * (1.f + s1);
        }
#pragma unroll
        for (int h = 0; h < 2; ++h) {
#pragma unroll
            for (int mm = 0; mm < 4; ++mm) { __builtin_amdgcn_sched_barrier(0);
                const int m = h * 4 + mm;
                const int row = tc.brow + tc.wr * 128 + m * 16 + tc.fr;
                float* xr = xrow_ptr(p, row) + col0;
                float part = 0.f;
#pragma unroll
                for (int n = 0; n < 4; ++n) {
                    f32x4 xv = *(const f32x4*)(xr + n * 16);
                    xv += gv[n] * acc[m][n];
                    *(f32x4*)(xr + n * 16) = xv;
                    if (has_next) {
                        part += xv[0] * xv[0] + xv[1] * xv[1] + xv[2] * xv[2] + xv[3] * xv[3];
                        const f32x4 hv = xv * av[n];
                        u32x2 w; w[0] = pk2(hv[0], hv[1]); w[1] = pk2(hv[2], hv[3]);
                        wave_put(wb, mm * 16 + tc.fr, n, tc.fq, w);
                    }
                }
                if (has_next) {
                    part += __shfl_xor(part, 16);
                    part += __shfl_xor(part, 32);
                    if (tc.fq == 0) ssp[(size_t)row * 16] = part;
                }
            }
            if (has_next) wave_rows_store(wb, tc.lane, p.H + (size_t)(tc.brow + tc.wr * 128 + h * 64) * DM + tc.bcol + tc.wc * 64, DM);
        }
    }
};
struct EpiFF1 {
    static DI void run(const f32x4 (&acc)[8][4], const TileCtx& tc, const Params& p, ldsp_t wb) {
#pragma unroll
        for (int h = 0; h < 2; ++h) {
#pragma unroll
            for (int mm = 0; mm < 4; ++mm) {
                const int m = h * 4 + mm;
#pragma unroll
                for (int n = 0; n < 4; ++n) {
                    f32x4 a = acc[m][n];
#pragma unroll
                    for (int j = 0; j < 4; ++j) { const float r = fmaxf(a[j], 0.f); a[j] = r * r; }
                    u32x2 w; w[0] = pk2(a[0], a[1]); w[1] = pk2(a[2], a[3]);
                    wave_put(wb, mm * 16 + tc.fr, n, tc.fq, w);
                }
            }
            wave_rows_store(wb, tc.lane, p.ACT + (size_t)(tc.brow + tc.wr * 128 + h * 64) * FF + tc.bcol + tc.wc * 64, FF);
        }
    }
};
template <int BRK> struct EpiIn {
    static DI void run(const f32x4 (&acc)[8][4], const TileCtx& tc, const Params& p, ldsp_t wb) {
        const int l = tc.l, pn = tc.pn, wc = tc.wc, fr = tc.fr, fq = tc.fq;
        if (BRK == 0 || (BRK == 1 && wc < 2)) {
            constexpr bool isq = BRK == 0;
            const int head = isq ? pn * 4 + wc : wc;
            const float* gn = (isq ? p.q_norm_g : p.k_norm_g) + l * 64;
            f32x4 gv[4];
#pragma unroll
            for (int n = 0; n < 4; ++n) gv[n] = *(const f32x4*)(gn + n * 16 + fq * 4);
            const float osc = isq ? 0.125f : 1.f;
            const bool lat = tc.brow < NLAT;
#pragma unroll
            for (int h = 0; h < 2; ++h) {
#pragma unroll
                for (int mm = 0; mm < 4; ++mm) { __builtin_amdgcn_sched_barrier(0);
                    const int m = h * 4 + mm;
                    const int row = tc.brow + tc.wr * 128 + m * 16 + fr;
                    float ss = 0.f;
#pragma unroll
                    for (int n = 0; n < 4; ++n)
#pragma unroll
                        for (int j = 0; j < 4; ++j) ss += acc[m][n][j] * acc[m][n][j];
                    ss += __shfl_xor(ss, 16);
                    ss += __shfl_xor(ss, 32);
                    const float rstd = rsqrtf(ss * (1.f / 64.f) + EPS) * osc;
                    const int t = row & 4095;
#pragma unroll
                    for (int ax = 0; ax < 2; ++ax) {
                        f32x4 x1 = acc[m][2 * ax] * rstd * gv[2 * ax], x2 = acc[m][2 * ax + 1] * rstd * gv[2 * ax + 1];
                        if (lat) {
                            const int pos = ax == 0 ? (t >> 6) : (t & 63);
                            const f32x4 cs = *(const f32x4*)(p.rope + pos * 16 + fq * 4), sn = *(const f32x4*)(p.rope + 1024 + pos * 16 + fq * 4);
                            const f32x4 o1 = x1 * cs - x2 * sn, o2 = x2 * cs + x1 * sn;
                            x1 = o1; x2 = o2;
                        }
                        u32x2 w; w[0] = pk2(x1[0], x1[1]); w[1] = pk2(x1[2], x1[3]);
                        wave_put(wb, mm * 16 + fr, 2 * ax, fq, w);
                        w[0] = pk2(x2[0], x2[1]); w[1] = pk2(x2[2], x2[3]);
                        wave_put(wb, mm * 16 + fr, 2 * ax + 1, fq, w);
                    }
                }
                const int row0 = tc.brow + tc.wr * 128 + h * 64;
                bf16_t* dst0;
                if (lat) {
                    const int b = row0 >> 12, t0 = row0 & 4095;
                    dst0 = isq ? p.Q + ((size_t)(b * 8 + head) * SEQ + t0) * 64 : p.K + ((size_t)(b * 2 + head) * NKEY + CTXL + t0) * 64;
                } else {
                    const int r2 = row0 - NLAT, b = r2 >> 8, t0 = r2 & 255;
                    dst0 = isq ? p.Qc + ((size_t)(b * 8 + head) * CTXL + t0) * 64 : p.K + ((size_t)(b * 2 + head) * NKEY + t0) * 64;
                }
                wave_rows_store(wb, tc.lane, dst0, 64);
            }
        } else if (BRK == 1) {
            const int kvh = wc - 2;
#pragma unroll
            for (int h = 0; h < 2; ++h) {
#pragma unroll
                for (int mm = 0; mm < 4; ++mm) {
                    const int m = h * 4 + mm;
                    const int key = mm * 16 + fr, k16 = key & 15;
                    const int kp = (key & ~15) | ((((k16 >> 2) & 1) << 3) + (k16 & 3) + ((k16 >> 3) << 2));
#pragma unroll
                    for (int n = 0; n < 4; ++n)
#pragma unroll
                        for (int j = 0; j < 4; ++j) {
                            const int d = n * 16 + fq * 4 + j;
                            *(LDSP bf16_t*)(wb + d * 128 + (((kp >> 3) ^ (d & 7)) << 4) + (kp & 7) * 2) = f2bf(acc[m][n][j]);
                        }
                }
                const int row0 = tc.brow + tc.wr * 128 + h * 64;
                int b, pos0;
                if (row0 < NLAT) { b = row0 >> 12; pos0 = CTXL + (row0 & 4095); } else { const int r2 = row0 - NLAT; b = r2 >> 8; pos0 = r2 & 255; }
                wave_rows_store(wb, tc.lane, p.Vt + (size_t)(b * 2 + kvh) * 64 * NKEY + pos0, NKEY);
            }
        } else if (BRK == 2) {
#pragma unroll
            for (int h = 0; h < 2; ++h) {
#pragma unroll
                for (int mm = 0; mm < 4; ++mm) {
                    const int m = h * 4 + mm;
#pragma unroll
                    for (int n = 0; n < 4; ++n) {
                        u32x2 w; w[0] = pk2(gelu_tanh(acc[m][n][0]), gelu_tanh(acc[m][n][1])); w[1] = pk2(gelu_tanh(acc[m][n][2]), gelu_tanh(acc[m][n][3]));
                        wave_put(wb, mm * 16 + fr, n, fq, w);
                    }
                }
                wave_rows_store(wb, tc.lane, p.U + (size_t)(tc.brow + tc.wr * 128 + h * 64) * 1024 + (pn - 3) * 256 + wc * 64, 1024);
            }
        }
    }
};

template <int EK>
DI void gemm_stream(const Params& p, int l, const bf16_t* __restrict__ A, const bf16_t* __restrict__ Bt, int M, int N, int K, ldsp_t shm) {
    const int nM = M / 256, nN = N / 256, nwg = nM * nN;
    int L = blockIdx.x;
    if (L >= nwg) return;
#define G_SA(b) (shm + (b) * G_STAGE_B)
#define G_SB(b) (shm + (b) * G_STAGE_B + G_TILE_B)
#define G_LANE_SETUP() \
    int tid_ = threadIdx.x; \
    asm volatile("" : "+v"(tid_));    \
    const int wid = tid_ >> 6, lane = tid_ & 63, wr = wid >> 2, wc = wid & 3, fr = lane & 15, fq = lane >> 4; \
    unsigned soff[4];        \
    _Pragma("unroll") for (int i = 0; i < 4; ++i) { int sR, sC; stage_rc2(wid * 1024 + i * 8192 + lane * 16, sR, sC); soff[i] = (unsigned)(sR * K + sC) * 2u; }
#define G_STAGE(Ap, Bp, buf, kt) do { const char* ab_ = (const char*)(Ap) + (size_t)(kt) * 128; const char* bb_ = (const char*)(Bp) + (size_t)(kt) * 128; \
      _Pragma("unroll") for (int i = 0; i < 4; ++i) { \
        __builtin_amdgcn_global_load_lds((const unsigned*)(ab_ + soff[i]), (LDSP unsigned*)(G_SA(buf) + wid * 1024 + i * 8192), 16, 0, 0); \
        __builtin_amdgcn_global_load_lds((const unsigned*)(bb_ + soff[i]), (LDSP unsigned*)(G_SB(buf) + wid * 1024 + i * 8192), 16, 0, 0); } } while (0)
    const int nt = K / 64;
    int pm, pn;
    tile_coords(L, nM, nN, pm, pn);
    const bf16_t* Ab = A + (size_t)pm * 256 * K;
    const bf16_t* Bb = Bt + (size_t)pn * 256 * K;
    { G_LANE_SETUP(); (void)wr; (void)wc; (void)fr; (void)fq; G_STAGE(Ab, Bb, 0, 0); WAIT_V0(); __syncthreads(); }
    while (true) {
        G_LANE_SETUP();
        const int aoff = lds_byte2(wr * 128 + fr, fq * 8), boff = lds_byte2(wc * 64 + fr, fq * 8);
        f32x4 acc[8][4];
#pragma unroll
        for (int m = 0; m < 8; ++m)
#pragma unroll
            for (int n = 0; n < 4; ++n) acc[m][n] = (f32x4){0.f, 0.f, 0.f, 0.f};
        const int Ln = L + gridDim.x;
        const bool has_next = Ln < nwg;
        int pm2 = pm, pn2 = pn;
        if (has_next) tile_coords(Ln, nM, nN, pm2, pn2);
        const bf16_t* Ab2 = A + (size_t)pm2 * 256 * K;
        const bf16_t* Bb2 = Bt + (size_t)pn2 * 256 * K;
        bf16x8 Aa[4], Ab_[4], Bk0[4], Bk1[4];
#define G_RDA(AF, buf, ks, mh) do { _Pragma("unroll") for (int m = 0; m < 4; ++m) AF[m] = *(const LDSP bf16x8*)(G_SA(buf) + aoff + ((mh) * 4 + m) * 2048 + (ks) * 1024); } while (0)
#define G_RDB(BF, buf, ks) do { _Pragma("unroll") for (int n = 0; n < 4; ++n) BF[n] = *(const LDSP bf16x8*)(G_SB(buf) + boff + n * 2048 + (ks) * 1024); } while (0)
#define G_MMA(AF, BF, mh) do { __builtin_amdgcn_s_setprio(1); \
            _Pragma("unroll") for (int m = 0; m < 4; ++m) _Pragma("unroll") for (int n = 0; n < 4; ++n) \
                acc[(mh) * 4 + m][n] = __builtin_amdgcn_mfma_f32_16x16x32_bf16(BF[n], AF[m], acc[(mh) * 4 + m][n], 0, 0, 0); \
            __builtin_amdgcn_s_setprio(0); } while (0)
#define G_SB0() __builtin_amdgcn_sched_barrier(0)
        for (int t = 0; t < nt; ++t) {
            const int cur = t & 1;
            G_RDA(Aa, cur, 0, 0); G_RDB(Bk0, cur, 0); G_SB0();
            if (t > 0) G_MMA(Ab_, Bk1, 1);
            G_SB0();
            if (t + 1 < nt) G_STAGE(Ab, Bb, cur ^ 1, t + 1);
            else if (has_next) G_STAGE(Ab2, Bb2, cur ^ 1, 0);
            G_RDA(Ab_, cur, 0, 1); G_SB0();
            G_MMA(Aa, Bk0, 0); G_SB0();
            G_RDA(Aa, cur, 1, 0); G_RDB(Bk1, cur, 1); G_SB0();
            G_MMA(Ab_, Bk0, 1); G_SB0();
            G_RDA(Ab_, cur, 1, 1); G_SB0();
            G_MMA(Aa, Bk1, 0); G_SB0();
            asm volatile("s_waitcnt lgkmcnt(0)" ::: "memory");
            WAIT_V0(); __syncthreads();
        }
        G_MMA(Ab_, Bk1, 1);
        G_SB0();
        {
            int tid2 = threadIdx.x, pme = pm, pne = pn;
            asm volatile("" : "+v"(tid2), "+s"(pme), "+s"(pne));
            TileCtx tc;
            tc.wid = tid2 >> 6; tc.lane = tid2 & 63; tc.wr = tc.wid >> 2; tc.wc = tc.wid & 3; tc.fr = tc.lane & 15; tc.fq = tc.lane >> 4; tc.l = l;
            tc.brow = pme * 256; tc.bcol = pne * 256; tc.pn = pne;
            ldsp_t ex = shm + G_STAGE_B + tc.wid * 8192;
            if (EK == 0 || EK == 2) {
                const int cond = tc.brow < NLAT ? (tc.brow >> 12) : 4;
                const float* ssp = p.ss + ((size_t)(l * 2 + (EK == 0 ? 0 : 1)) * NTOK + tc.brow + tc.wr * 128 + tc.fr) * 16 + tc.fq * 4;
                const float* shw = (EK == 0 ? p.shw_in + ((size_t)l * 5 + cond) * IN_DIM : p.shw_ff1 + ((size_t)l * 5 + cond) * FF) + tc.bcol + tc.wc * 64 + tc.fq * 4;
                f32x4 shv[4];
#pragma unroll
                for (int n = 0; n < 4; ++n) shv[n] = *(const f32x4*)(shw + n * 16);
#pragma unroll
                for (int m = 0; m < 8; ++m) {
                    const f32x4 pp = *(const f32x4*)(ssp + m * 256);
                    float sq = pp[0] + pp[1] + pp[2] + pp[3];
                    sq += __shfl_xor(sq, 16);
                    sq += __shfl_xor(sq, 32);
                    const float rstd = rsqrtf(sq * (1.f / DM) + EPS);
#pragma unroll
                    for (int n = 0; n < 4; ++n) acc[m][n] = acc[m][n] * rstd + shv[n];
                }
            }
            if (EK == 0) {
                if (pne < 2) EpiIn<0>::run(acc, tc, p, ex);
                else if (pne == 2) EpiIn<1>::run(acc, tc, p, ex);
                else EpiIn<2>::run(acc, tc, p, ex);
            } else if (EK == 1) EpiResid<1>::run(acc, tc, p, ex);
            else if (EK == 2) EpiFF1::run(acc, tc, p, ex);
            else EpiResid<3>::run(acc, tc, p, ex);
        }
        __syncthreads();
        if (!has_next) break;
        L = Ln; pm = pm2; pn = pn2; Ab = Ab2; Bb = Bb2;
    }
}

template <int EK>
DI void ctx_item(const Params& p, int l, int grow, int gcol, int slot, f32x4 s0, f32x4 s1, bool lead) {
    if (EK == 2) {
        const float* pp = p.ss + ((size_t)(l * 2 + 1) * NTOK + NLAT + grow) * 16;
        const f32x4 q0 = *(const f32x4*)pp, q1 = *(const f32x4*)(pp + 4), q2 = *(const f32x4*)(pp + 8), q3 = *(const f32x4*)(pp + 12);
        const f32x4 qs = q0 + q1 + q2 + q3;
        const float rstd = rsqrtf((qs[0] + qs[1] + qs[2] + qs[3]) * (1.f / DM) + EPS);
        const float* shw = p.shw_ff1 + ((size_t)l * 5 + 4) * FF + gcol;
        const f32x4 h0 = *(const f32x4*)shw, h1 = *(const f32x4*)(shw + 4);
        s0 = s0 * rstd + h0; s1 = s1 * rstd + h1;
#pragma unroll
        for (int j = 0; j < 4; ++j) { float r0 = fmaxf(s0[j], 0.f), r1 = fmaxf(s1[j], 0.f); s0[j] = r0 * r0; s1[j] = r1 * r1; }
        u32x4 w; w[0] = pk2(s0[0], s0[1]); w[1] = pk2(s0[2], s0[3]); w[2] = pk2(s1[0], s1[1]); w[3] = pk2(s1[2], s1[3]);
        *(u32x4*)(p.ACT + (size_t)(NLAT + grow) * FF + gcol) = w;
    } else {
        const float* gate = p.mod + ((size_t)l * 5 + 4) * 6144 + (EK == 1 ? 2 : 5) * DM + gcol;
        float* xr = p.xc + (size_t)grow * DM + gcol;
        const f32x4 g0 = *(const f32x4*)gate, g1 = *(const f32x4*)(gate + 4);
        f32x4 x0 = *(const f32x4*)xr, x1 = *(const f32x4*)(xr + 4);
        x0 += g0 * s0; x1 += g1 * s1;
        *(f32x4*)xr = x0; *(f32x4*)(xr + 4) = x1;
        const int ln = EK == 1 ? l : l + 1;
        const float* gnx = (EK == 1 ? p.norm2_g : p.norm1_g) + (size_t)ln * DM + gcol;
        const float* scn = p.mod + ((size_t)ln * 5 + 4) * 6144 + (EK == 1 ? 4 : 1) * DM + gcol;
        const f32x4 a0 = *(const f32x4*)gnx * (1.f + *(const f32x4*)scn), a1 = *(const f32x4*)(gnx + 4) * (1.f + *(const f32x4*)(scn + 4));
        const f32x4 y0 = x0 * a0, y1 = x1 * a1;
        u32x4 w; w[0] = pk2(y0[0], y0[1]); w[1] = pk2(y0[2], y0[3]); w[2] = pk2(y1[0], y1[1]); w[3] = pk2(y1[2], y1[3]);
        *(u32x4*)(p.H + (size_t)(NLAT + grow) * DM + gcol) = w;
        float part = x0[0] * x0[0] + x0[1] * x0[1] + x0[2] * x0[2] + x0[3] * x0[3] + x1[0] * x1[0] + x1[1] * x1[1] + x1[2] * x1[2] + x1[3] * x1[3];
        part += __shfl_xor(part, 1); part += __shfl_xor(part, 2); part += __shfl_xor(part, 4);
        if (lead) p.ss[((size_t)(ln * 2 + (EK == 1 ? 1 : 0)) * NTOK + NLAT + grow) * 16 + slot] = part;
    }
}

template <int EK, int TS, int KS>
DI void ctx_tiles(const Params& p, int l, const bf16_t* __restrict__ A, const bf16_t* __restrict__ Bt, int N, int K, ldsp_t shm) {
    constexpr int WM = TS / 2, WN = TS / 4, MT = WM / 16, NT = WN / 16, BKC = 32 * KS;
    constexpr int TILE_A = TS * BKC * 2, PP = TILE_A / 8192;
    const int ntn = N / TS, ntiles = (NCTX / TS) * ntn, nt = K / BKC;
    for (int u = blockIdx.x; u < ntiles; u += gridDim.x) {
        const int tm = u / ntn, tn = u % ntn;
        int tid = threadIdx.x;
        asm volatile("" : "+v"(tid));
        const int wid = tid >> 6, lane = tid & 63, wr = wid >> 2, wc = wid & 3, fr = lane & 15, fq = lane >> 4;
        unsigned soff[PP];
#pragma unroll
        for (int i = 0; i < PP; ++i) { int sR, sC; stage_rc_ks<KS>((wid * PP + i) * 1024 + lane * 16, sR, sC); soff[i] = (unsigned)(sR * K + sC) * 2u; }
        const bf16_t* Ab = A + (size_t)tm * TS * K;
        const bf16_t* Bb = Bt + (size_t)tn * TS * K;
#define C_STAGE(buf, kt) do { const char* ab_ = (const char*)Ab + (size_t)(kt) * (BKC * 2); const char* bb_ = (const char*)Bb + (size_t)(kt) * (BKC * 2); \
      _Pragma("unroll") for (int i = 0; i < PP; ++i) { \
        __builtin_amdgcn_global_load_lds((const unsigned*)(ab_ + soff[i]), (LDSP unsigned*)(shm + (buf) * 2 * TILE_A + (wid * PP + i) * 1024), 16, 0, 0); \
        __builtin_amdgcn_global_load_lds((const unsigned*)(bb_ + soff[i]), (LDSP unsigned*)(shm + (buf) * 2 * TILE_A + TILE_A + (wid * PP + i) * 1024), 16, 0, 0); } } while (0)
        f32x4 acc[MT][NT];
#pragma unroll
        for (int m = 0; m < MT; ++m)
#pragma unroll
            for (int n = 0; n < NT; ++n) acc[m][n] = (f32x4){0.f, 0.f, 0.f, 0.f};
        const int aoff = lds_byte_ks<KS>(wr * WM + fr, fq * 8), boff = lds_byte_ks<KS>(wc * WN + fr, fq * 8);
        C_STAGE(0, 0); WAIT_V0(); __syncthreads();
        for (int t = 0; t < nt; ++t) {
            const int cur = t & 1;
            if (t + 1 < nt) C_STAGE(cur ^ 1, t + 1);
            ldsp_t sa = shm + cur * 2 * TILE_A, sb = sa + TILE_A;
#pragma unroll
            for (int ks = 0; ks < KS; ++ks) {
                bf16x8 At[MT], Bf[NT];
#pragma unroll
                for (int m = 0; m < MT; ++m) At[m] = *(const LDSP bf16x8*)(sa + aoff + m * (KS * 1024) + ks * 1024);
#pragma unroll
                for (int n = 0; n < NT; ++n) Bf[n] = *(const LDSP bf16x8*)(sb + boff + n * (KS * 1024) + ks * 1024);
#pragma unroll
                for (int m = 0; m < MT; ++m)
#pragma unroll
                    for (int n = 0; n < NT; ++n) acc[m][n] = __builtin_amdgcn_mfma_f32_16x16x32_bf16(Bf[n], At[m], acc[m][n], 0, 0, 0);
            }
            WAIT_V0(); __syncthreads();
        }
#pragma unroll
        for (int m = 0; m < MT; ++m)
#pragma unroll
            for (int n = 0; n < NT; ++n) {
                const int row = wr * WM + m * 16 + fr, ch = (wc * WN + n * 16 + fq * 4) >> 2;
                *(LDSP f32x4*)(shm + row * (TS * 4) + ((ch ^ (row & 15)) << 4)) = acc[m][n];
            }
        __syncthreads();
#pragma unroll
        for (int it = 0; it < (TS * TS / 8) / 512; ++it) {
            const int item = it * 512 + tid, row = item / (TS / 8), c8 = item % (TS / 8);
            const f32x4 s0 = *(const LDSP f32x4*)(shm + row * (TS * 4) + (((2 * c8) ^ (row & 15)) << 4));
            const f32x4 s1 = *(const LDSP f32x4*)(shm + row * (TS * 4) + (((2 * c8 + 1) ^ (row & 15)) << 4));
            ctx_item<EK>(p, l, tm * TS + row, tn * TS + c8 * 8, tn, s0, s1, c8 == 0);
        }
        __syncthreads();
    }
}

DI void attn_unit(const Params& p, int l, int b, int kvh, int qb, bool isctx, ldsp_t smem) {
    int tid = threadIdx.x;
    asm volatile("" : "+v"(tid));
    const int wid = tid >> 6, lane = tid & 63, r = lane & 31, hh = lane >> 5;
    const int head = kvh * 4 + (wid >> 1);
    const int t0 = qb * 64 + (wid & 1) * 32;
    const int nkeys = isctx ? CTXL : NKEY;
    const bf16_t* Qp = isctx ? p.Qc + ((size_t)(b * 8 + head) * CTXL + t0) * 64 : p.Q + ((size_t)(b * 8 + head) * SEQ + t0) * 64;
    const bf16_t* Kp = p.K + (size_t)(b * 2 + kvh) * NKEY * 64;
    const bf16_t* Vp = p.Vt + (size_t)(b * 2 + kvh) * 64 * NKEY;
    const int orow = isctx ? NLAT + b * CTXL + t0 : b * SEQ + t0;
    bf16_t* Op = p.MIX + (size_t)orow * DM + head * 64;
    const float cexp = p.smax[l] * LOG2E;

    bf16x8 qf[4];
#pragma unroll
    for (int ks = 0; ks < 4; ++ks) qf[ks] = *(const bf16x8*)(Qp + (size_t)r * 64 + ks * 16 + 8 * hh);
    f32x16 o[2];
#pragma unroll
    for (int i = 0; i < 16; ++i) { o[0][i] = 0.f; o[1][i] = 0.f; }
    float rs0 = 0.f, rs1 = 0.f;

    const int srow = tid >> 3, sch = tid & 7;
    const int kdst = srow * 128 + ((sch ^ ((srow >> 1) & 7)) << 4);
    const bf16_t* kg = Kp + (size_t)srow * 64 + sch * 8;
    const bf16_t* vg = Vp + (size_t)srow * NKEY + sch * 8;
    const int rsw = (r >> 1) & 7;
    const int ntile = nkeys / 64;

#define ATT_QK(SD, kb) do { _Pragma("unroll") for (int kt = 0; kt < 2; ++kt) { \
        _Pragma("unroll") for (int i = 0; i < 16; ++i) SD[kt][i] = 0.f; \
        _Pragma("unroll") for (int ks = 0; ks < 4; ++ks) { \
            const bf16x8 a_ = *(const LDSP bf16x8*)((kb) + (kt * 32 + r) * 128 + (((ks * 2 + hh) ^ rsw) << 4)); \
            SD[kt] = __builtin_amdgcn_mfma_f32_32x32x16_bf16(a_, qf[ks], SD[kt], 0, 0, 0); } } } while (0)

    u32x4 kst, vst;
    f32x16 sA[2], sB[2];
    {
        kst = *(const u32x4*)kg;
        *(LDSP u32x4*)(smem + kdst) = kst;
        kst = *(const u32x4*)(kg + (size_t)64 * 64);
        vst = *(const u32x4*)vg;
        __syncthreads();
        ATT_QK(sA, smem);
        *(LDSP u32x4*)(smem + 8192 + kdst) = kst;
        *(LDSP u32x4*)(smem + 16384 + kdst) = vst;
    }
#define ATT_STEP(t, SC, SN) do { \
        const int par = (t) & 1; \
        __syncthreads(); \
        { const int t2_ = (t) + 2 < ntile ? (t) + 2 : ntile - 1, t1_ = (t) + 1 < ntile ? (t) + 1 : ntile - 1; \
          kst = *(const u32x4*)(kg + (size_t)t2_ * 64 * 64); vst = *(const u32x4*)(vg + t1_ * 64); } \
        bf16x8 kf[8], vf[4], vh[4]; \
        ldsp_t kb_ = smem + (par ^ 1) * 8192; ldsp_t vb_ = smem + 16384 + par * 8192; \
        _Pragma("unroll") for (int kt = 0; kt < 2; ++kt) _Pragma("unroll") for (int ks = 0; ks < 4; ++ks) \
            kf[kt * 4 + ks] = *(const LDSP bf16x8*)(kb_ + (kt * 32 + r) * 128 + (((ks * 2 + hh) ^ rsw) << 4)); \
        _Pragma("unroll") for (int c = 0; c < 2; ++c) _Pragma("unroll") for (int dt = 0; dt < 2; ++dt) \
            vf[c * 2 + dt] = *(const LDSP bf16x8*)(vb_ + (dt * 32 + r) * 128 + (((c * 2 + hh) ^ rsw) << 4)); \
        __builtin_amdgcn_sched_barrier(0); \
        _Pragma("unroll") for (int kt = 0; kt < 2; ++kt) _Pragma("unroll") for (int i = 0; i < 16; ++i) SN[kt][i] = 0.f; \
        _Pragma("unroll") for (int ks = 0; ks < 4; ++ks) _Pragma("unroll") for (int kt = 0; kt < 2; ++kt) \
            SN[kt] = __builtin_amdgcn_mfma_f32_32x32x16_bf16(kf[kt * 4 + ks], qf[ks], SN[kt], 0, 0, 0); \
        _Pragma("unroll") for (int c = 2; c < 4; ++c) _Pragma("unroll") for (int dt = 0; dt < 2; ++dt) \
            vh[(c - 2) * 2 + dt] = *(const LDSP bf16x8*)(vb_ + (dt * 32 + r) * 128 + (((c * 2 + hh) ^ rsw) << 4)); \
        __builtin_amdgcn_sched_barrier(0); \
        _Pragma("unroll") for (int kt = 0; kt < 2; ++kt) { \
            _Pragma("unroll") for (int i = 0; i < 16; ++i) { \
                const float e_ = fexp2(SC[kt][i] * LOG2E - cexp); \
                if (i & 1) rs1 += e_; else rs0 += e_; \
                SC[kt][i] = e_; } } \
        _Pragma("unroll") for (int c = 0; c < 4; ++c) { \
            u32x4 pw; \
            pw[0] = pk2(SC[c >> 1][8 * (c & 1) + 0], SC[c >> 1][8 * (c & 1) + 1]); pw[1] = pk2(SC[c >> 1][8 * (c & 1) + 2], SC[c >> 1][8 * (c & 1) + 3]); \
            pw[2] = pk2(SC[c >> 1][8 * (c & 1) + 4], SC[c >> 1][8 * (c & 1) + 5]); pw[3] = pk2(SC[c >> 1][8 * (c & 1) + 6], SC[c >> 1][8 * (c & 1) + 7]); \
            const bf16x8 pb = __builtin_bit_cast(bf16x8, pw); \
            _Pragma("unroll") for (int dt = 0; dt < 2; ++dt) o[dt] = __builtin_amdgcn_mfma_f32_32x32x16_bf16(c < 2 ? vf[c * 2 + dt] : vh[(c - 2) * 2 + dt], pb, o[dt], 0, 0, 0); } \
        *(LDSP u32x4*)(smem + par * 8192 + kdst) = kst; \
        *(LDSP u32x4*)(smem + 16384 + (par ^ 1) * 8192 + kdst) = vst; \
    } while (0)

    for (int t = 0; t < ntile; t += 2) {
        ATT_STEP(t, sA, sB);
        ATT_STEP(t + 1, sB, sA);
    }
    const float lrun = rs0 + rs1;
    const float ltot = lrun + __shfl_xor(lrun, 32);
    const float inv = 1.f / ltot;
#pragma unroll
    for (int dt = 0; dt < 2; ++dt)
#pragma unroll
        for (int g4 = 0; g4 < 4; ++g4) {
            u32x2 w; w[0] = pk2(o[dt][4 * g4 + 0] * inv, o[dt][4 * g4 + 1] * inv); w[1] = pk2(o[dt][4 * g4 + 2] * inv, o[dt][4 * g4 + 3] * inv);
            *(u32x2*)(Op + (size_t)r * DM + dt * 32 + 8 * g4 + 4 * hh) = w;
        }
    __syncthreads();
}

DI void gmlp_unit(const Params& p, int l, int T, int g, ldsp_t smem) {
    int tid = threadIdx.x;
    asm volatile("" : "+v"(tid));
    const int wid = tid >> 6, lane = tid & 63, fr = lane & 15, fq = lane >> 4;
    {
        const int q = tid >> 2, part = tid & 3;
        const bf16_t* src = p.U + (size_t)(T * 128 + q) * 1024 + 512 + g * 128 + part * 32;
        u32x4 raw[4];
#pragma unroll
        for (int i = 0; i < 4; ++i) raw[i] = *(const u32x4*)(src + i * 8);
        float a = 0.f, b = 0.f;
#pragma unroll
        for (int i = 0; i < 4; ++i)
#pragma unroll
            for (int j = 0; j < 4; ++j) {
                const float lo = __uint_as_float(raw[i][j] << 16), hi = __uint_as_float(raw[i][j] & 0xffff0000u);
                a += lo + hi; b += lo * lo + hi * hi;
            }
        a += __shfl_xor(a, 1); a += __shfl_xor(a, 2);
        b += __shfl_xor(b, 1); b += __shfl_xor(b, 2);
        const float mean = a * (1.f / 128.f);
        const float rstd = rsqrtf(fmaxf(b * (1.f / 128.f) - mean * mean, 0.f) + EPS);
        const float* gn = p.gmlp_norm_g + l * 512 + g * 128 + part * 32;
#pragma unroll
        for (int i = 0; i < 4; ++i)
#pragma unroll
            for (int j = 0; j < 4; ++j) {
                const int c0 = part * 32 + i * 8 + j * 2;
                const float lo = __uint_as_float(raw[i][j] << 16), hi = __uint_as_float(raw[i][j] & 0xffff0000u);
                const unsigned w = pk2((lo - mean) * rstd * gn[i * 8 + j * 2], (hi - mean) * rstd * gn[i * 8 + j * 2 + 1]);
                *(LDSP bf16_t*)(smem + c0 * 256 + (((q >> 3) ^ (c0 & 15)) << 4) + (q & 7) * 2) = (bf16_t)(w & 0xffffu);
                *(LDSP bf16_t*)(smem + (c0 + 1) * 256 + (((q >> 3) ^ ((c0 + 1) & 15)) << 4) + (q & 7) * 2) = (bf16_t)(w >> 16);
            }
    }
    __syncthreads();
    const int prow = wid * 16 + fr;
    const bf16_t* wsp = p.ws_bf + ((size_t)(l * 4 + g) * 128 + prow) * 128 + fq * 8;
    bf16x8 a[4];
#pragma unroll
    for (int ks = 0; ks < 4; ++ks) a[ks] = *(const bf16x8*)(wsp + ks * 32);
    f32x4 acc[8];
#pragma unroll
    for (int n = 0; n < 8; ++n) {
        acc[n] = (f32x4){0.f, 0.f, 0.f, 0.f};
        const int c = n * 16 + fr;
#pragma unroll
        for (int ks = 0; ks < 4; ++ks) {
            const bf16x8 bq = *(const LDSP bf16x8*)(smem + c * 256 + (((ks * 4 + fq) ^ (c & 15)) << 4));
            acc[n] = __builtin_amdgcn_mfma_f32_16x16x32_bf16(bq, a[ks], acc[n], 0, 0, 0);
        }
    }
    const float bs = p.b_spatial[(size_t)(l * 4 + g) * 128 + prow];
    const int row = T * 128 + prow;
    const bf16_t* up = p.U + (size_t)row * 1024 + g * 128 + fq * 4;
    bf16_t* mp = p.MIX + (size_t)row * DM + 512 + g * 128 + fq * 4;
#pragma unroll
    for (int n = 0; n < 8; ++n) {
        const u32x2 uu = *(const u32x2*)(up + n * 16);
        const float u0 = __uint_as_float(uu[0] << 16), u1 = __uint_as_float(uu[0] & 0xffff0000u), u2 = __uint_as_float(uu[1] << 16), u3 = __uint_as_float(uu[1] & 0xffff0000u);
        u32x2 w; w[0] = pk2((acc[n][0] + bs) * u0, (acc[n][1] + bs) * u1); w[1] = pk2((acc[n][2] + bs) * u2, (acc[n][3] + bs) * u3);
        *(u32x2*)(mp + n * 16) = w;
    }
    __syncthreads();
}

DI void mixer_phase(const Params& p, int l, ldsp_t smem) {
    const bool last = l == DEPTH - 1;
    for (int u = blockIdx.x; u < 512; u += gridDim.x) attn_unit(p, l, (u & 7) >> 1, u & 1, u >> 3, false, smem);
    if (!last)
        for (int u = blockIdx.x; u < 32; u += gridDim.x) attn_unit(p, l, (u & 7) >> 1, u & 1, u >> 3, true, smem);
    const int nT = last ? 128 : 136;
    for (int u = blockIdx.x; u < nT * 4; u += gridDim.x) gmlp_unit(p, l, u >> 2, u & 3, smem);
}

DI void grid_barrier(unsigned* ctr, unsigned target) {
    asm volatile("s_waitcnt vmcnt(0)" ::: "memory");
    __syncthreads();
    if (threadIdx.x == 0) {
        __builtin_amdgcn_fence(__ATOMIC_RELEASE, "agent");
        asm volatile("s_waitcnt vmcnt(0)" ::: "memory");
        __hip_atomic_fetch_add(ctr, 1u, __ATOMIC_RELAXED, __HIP_MEMORY_SCOPE_AGENT);
        unsigned sp = 0;
        while (__hip_atomic_load(ctr, __ATOMIC_RELAXED, __HIP_MEMORY_SCOPE_AGENT) < target) { __builtin_amdgcn_s_sleep(1); if (++sp > (1u << 22)) break; }
        __builtin_amdgcn_fence(__ATOMIC_ACQUIRE, "agent");
        asm volatile("s_waitcnt vmcnt(0)" ::: "memory");
    }
    __syncthreads();
}

constexpr int N_PHASES = 2 + DEPTH * 5;
DI void run_phase(const Params& p, int ph, ldsp_t smem) {
    if (ph == 0) { phase0(p, smem); return; }
    if (ph == 1) { phase1(p); return; }
    const int l = (ph - 2) / 5, k = (ph - 2) % 5;
    const bool last = l == DEPTH - 1;
    switch (k) {
        case 0: gemm_stream<0>(p, l, p.H, p.wt_in + (size_t)l * IN_DIM * DM, NTOK, IN_DIM, DM, smem); break;
        case 1: mixer_phase(p, l, smem); break;
        case 2: gemm_stream<1>(p, l, p.MIX, p.wt_out + (size_t)l * DM * DM, NLAT, DM, DM, smem);
                if (!last) ctx_tiles<1, 64, 8>(p, l, p.MIX + (size_t)NLAT * DM, p.wt_out + (size_t)l * DM * DM, DM, DM, smem);
                break;
        case 3: gemm_stream<2>(p, l, p.H, p.wt_ff1 + (size_t)l * FF * DM, NLAT, FF, DM, smem);
                if (!last) ctx_tiles<2, 128, 4>(p, l, p.H + (size_t)NLAT * DM, p.wt_ff1 + (size_t)l * FF * DM, FF, DM, smem);
                break;
        default: gemm_stream<3>(p, l, p.ACT, p.wt_ff2 + (size_t)l * DM * FF, NLAT, DM, FF, smem);
                if (!last) ctx_tiles<3, 64, 8>(p, l, p.ACT + (size_t)NLAT * FF, p.wt_ff2 + (size_t)l * DM * FF, DM, FF, smem);
                break;
    }
}

template <bool COOP>
__global__ void __launch_bounds__(512) mk_kernel(Params p, int ph_lo, int ph_hi) {
    __shared__ __attribute__((aligned(1024))) char smem_raw[2 * G_STAGE_B + 8192];
    ldsp_t smem = (ldsp_t)smem_raw;
    for (int ph = ph_lo; ph < ph_hi; ++ph) {
        run_phase(p, ph, smem);
#ifdef DUP_K
        if (ph > 1 && (ph - 2) % 5 == DUP_K) { cg::this_grid().sync(); run_phase(p, ph, smem); }
#endif
        if (COOP && ph + 1 < ph_hi) {
            if (ph == 0) cg::this_grid().sync();
            else grid_barrier(p.bar, (unsigned)ph * gridDim.x);
        }
    }
}

extern "C" void kernel_launch(void* const* d_in, const int* in_sizes, int n_in, void* d_out, int out_size, void* d_ws, size_t ws_size, hipStream_t stream) {
    Params p{};
    p.x = (const float*)d_in[0]; p.c = (const float*)d_in[1]; p.ctx = (const float*)d_in[2]; p.c_ctx = (const float*)d_in[3];
    p.w_mod = (const float*)d_in[4]; p.b_mod = (const float*)d_in[5]; p.norm1_g = (const float*)d_in[6]; p.w_in = (const float*)d_in[7];
    p.q_norm_g = (const float*)d_in[8]; p.k_norm_g = (const float*)d_in[9]; p.gmlp_norm_g = (const float*)d_in[10]; p.w_spatial = (const float*)d_in[11];
    p.b_spatial = (const float*)d_in[12]; p.w_out = (const float*)d_in[13]; p.norm2_g = (const float*)d_in[14]; p.w_ff1 = (const float*)d_in[15]; p.w_ff2 = (const float*)d_in[16];
    p.out = (float*)d_out;
    char* w = (char*)d_ws; size_t off = 0;
    auto take = [&](size_t bytes) { char* r = w + off; off += (bytes + 1023) & ~(size_t)1023; return r; };
    p.wt_in = (bf16_t*)take((size_t)DEPTH * IN_DIM * DM * 2);
    p.wt_out = (bf16_t*)take((size_t)DEPTH * DM * DM * 2);
    p.wt_ff1 = (bf16_t*)take((size_t)DEPTH * FF * DM * 2);
    p.wt_ff2 = (bf16_t*)take((size_t)DEPTH * FF * DM * 2);
    p.ws_bf = (bf16_t*)take((size_t)DEPTH * 4 * 128 * 128 * 2);
    p.mod = (float*)take((size_t)DEPTH * 5 * 6144 * 4);
    p.rope = (float*)take(2048 * 4);
    p.xc = (float*)take((size_t)NCTX * DM * 4);
    p.smax = (float*)take(1024);
    p.bar = (unsigned*)take(1024);
    p.ss = (float*)take((size_t)DEPTH * 2 * NTOK * 16 * 4);
    p.shw_in = (float*)take((size_t)DEPTH * 5 * IN_DIM * 4);
    p.shw_ff1 = (float*)take((size_t)DEPTH * 5 * FF * 4);
    p.H = (bf16_t*)take((size_t)NTOK * DM * 2);
    p.ACT = (bf16_t*)take((size_t)NTOK * FF * 2);
    {
        char* a = (char*)p.ACT; size_t o2 = 0;
        auto take2 = [&](size_t bytes) { char* r = a + o2; o2 += (bytes + 1023) & ~(size_t)1023; return r; };
        p.Q = (bf16_t*)take2((size_t)NLAT * 512 * 2);
        p.Qc = (bf16_t*)take2((size_t)NCTX * 512 * 2);
        p.K = (bf16_t*)take2((size_t)NB * 2 * NKEY * 64 * 2);
        p.Vt = (bf16_t*)take2((size_t)NB * 2 * NKEY * 64 * 2);
        p.U = (bf16_t*)take2((size_t)NTOK * 1024 * 2);
        p.MIX = (bf16_t*)take2((size_t)NTOK * DM * 2);
    }
    if (off > ws_size) { fprintf(stderr, "workspace too small: need %zu have %zu\n", off, ws_size); return; }
#if MK_COOP
    static int grid_blocks = 0;
    if (!grid_blocks) {
        int dev = 0, cus = 0, per_cu = 0;
        hipGetDevice(&dev);
        hipDeviceGetAttribute(&cus, hipDeviceAttributeMultiprocessorCount, dev);
        hipOccupancyMaxActiveBlocksPerMultiprocessor(&per_cu, mk_kernel<true>, 512, 0);
        if (per_cu < 1) per_cu = 1;
        grid_blocks = cus * 1;
    }
    int lo = 0, hi = N_PHASES;
    void* args[] = {&p, &lo, &hi};
    hipError_t e = hipLaunchCooperativeKernel((void*)mk_kernel<true>, dim3(grid_blocks), dim3(512), args, 0, stream);
    if (e != hipSuccess) fprintf(stderr, "cooperative launch failed: %s (grid %d)\n", hipGetErrorString(e), grid_blocks);
#else
    for (int ph = 0; ph < N_PHASES; ++ph) mk_kernel<false><<<256, 512, 0, stream>>>(p, ph, ph + 1);
#endif
}
```

```cpp
#include <hip/hip_runtime.h>
#include <hip/hip_cooperative_groups.h>
#include <stdint.h>
#include <cstdio>
namespace cg = cooperative_groups;

#ifndef MK_COOP
#define MK_COOP 1
#endif

#define DI __device__ __forceinline__
#define LDSP __attribute__((address_space(3)))
typedef LDSP char* ldsp_t;
typedef unsigned short bf16_t;
typedef short bf16x8 __attribute__((ext_vector_type(8)));
typedef float f32x2 __attribute__((ext_vector_type(2)));
typedef float f32x4 __attribute__((ext_vector_type(4)));
typedef float f32x16 __attribute__((ext_vector_type(16)));
typedef unsigned u32x2 __attribute__((ext_vector_type(2)));
typedef unsigned u32x4 __attribute__((ext_vector_type(4)));
typedef __bf16 bf2_t __attribute__((ext_vector_type(2)));

constexpr int DM = 1024, NB = 4, SEQ = 4096, DEPTH = 4, CTXL = 256;
constexpr int NLAT = NB * SEQ;
constexpr int NCTX = NB * CTXL;
constexpr int NTOK = NLAT + NCTX;
constexpr int IN_DIM = 1792, FF = 4096, NKEY = CTXL + SEQ;
constexpr float EPS = 1e-6f;
constexpr float LOG2E = 1.4426950408889634f;

struct Params {
    const float *x, *c, *ctx, *c_ctx, *w_mod, *b_mod, *norm1_g, *w_in, *q_norm_g, *k_norm_g, *gmlp_norm_g, *w_spatial, *b_spatial, *w_out, *norm2_g, *w_ff1, *w_ff2;
    float* out;
    bf16_t *wt_in, *wt_out, *wt_ff1, *wt_ff2, *ws_bf;
    float *mod, *rope, *xc, *smax, *ss, *shw_in, *shw_ff1;
    unsigned* bar;
    bf16_t *H, *Q, *Qc, *K, *Vt, *U, *MIX, *ACT;
};

DI unsigned pk2(float a, float b) { f32x2 v = {a, b}; bf2_t r = __builtin_convertvector(v, bf2_t); return __builtin_bit_cast(unsigned, r); }
DI bf16_t f2bf(float a) { return (bf16_t)(pk2(a, 0.f) & 0xffffu); }
DI float fexp2(float x) { return __builtin_amdgcn_exp2f(x); }
DI float gelu_tanh(float x) {
    const float y = 0.7978845608028654f * (x + 0.044715f * x * x * x);
    return x * __builtin_amdgcn_rcpf(1.f + fexp2(-2.f * LOG2E * y));
}
DI float* xrow_ptr(const Params& p, int row) { return row < NLAT ? p.out + (size_t)row * DM : p.xc + (size_t)(row - NLAT) * DM; }

DI void transpose_tile(const float* __restrict__ src, bf16_t* __restrict__ dst, int K, int N, int tk, int tn, ldsp_t smem) {
    LDSP float* t = (LDSP float*)smem;
    int tid = threadIdx.x;
    asm volatile("" : "+v"(tid));
    const int k0 = tk * 64, n0 = tn * 256;
    f32x4 v[8];
#pragma unroll
    for (int i = 0; i < 8; ++i) v[i] = *(const f32x4*)(src + (size_t)(k0 + (tid >> 6) + 8 * i) * N + n0 + (tid & 63) * 4);
#pragma unroll
    for (int i = 0; i < 8; ++i) {
        const int k = (tid >> 6) + 8 * i, n4 = (tid & 63) * 4;
        t[k * 257 + n4 + 0] = v[i][0]; t[k * 257 + n4 + 1] = v[i][1]; t[k * 257 + n4 + 2] = v[i][2]; t[k * 257 + n4 + 3] = v[i][3];
    }
    __syncthreads();
#pragma unroll
    for (int j = 0; j < 4; ++j) {
        const int n = (tid >> 3) + 64 * j, k8 = (tid & 7) * 8;
        u32x4 w;
        w[0] = pk2(t[(k8 + 0) * 257 + n], t[(k8 + 1) * 257 + n]);
        w[1] = pk2(t[(k8 + 2) * 257 + n], t[(k8 + 3) * 257 + n]);
        w[2] = pk2(t[(k8 + 4) * 257 + n], t[(k8 + 5) * 257 + n]);
        w[3] = pk2(t[(k8 + 6) * 257 + n], t[(k8 + 7) * 257 + n]);
        *(u32x4*)(dst + (size_t)(n0 + n) * K + k0 + k8) = w;
    }
    __syncthreads();
}

DI void mod_unit(const Params& p, int l, int cgi, ldsp_t smem) {
    LDSP float* s = (LDSP float*)smem;
    LDSP float* red = (LDSP float*)(smem + 20480);
    int tid = threadIdx.x;
    asm volatile("" : "+v"(tid));
    for (int i = tid; i < 5 * 1024; i += 512) {
        const int cnd = i >> 10, k = i & 1023;
        const float v = cnd < 4 ? p.c[cnd * 1024 + k] : p.c_ctx[k];
        s[i] = v / (1.f + fexp2(-LOG2E * v));
    }
    __syncthreads();
    const int c4 = tid & 15, ks = tid >> 4;
    f32x4 acc[5];
#pragma unroll
    for (int q = 0; q < 5; ++q) acc[q] = (f32x4){0.f, 0.f, 0.f, 0.f};
    const float* wp = p.w_mod + ((size_t)l * 1024 + ks * 32) * 6144 + cgi * 64 + c4 * 4;
#pragma unroll 8
    for (int kk = 0; kk < 32; ++kk) {
        const f32x4 w = *(const f32x4*)(wp + (size_t)kk * 6144);
        const int k = ks * 32 + kk;
#pragma unroll
        for (int q = 0; q < 5; ++q) acc[q] += w * s[q * 1024 + k];
    }
#pragma unroll
    for (int q = 0; q < 5; ++q)
#pragma unroll
        for (int j = 0; j < 4; ++j) red[(ks * 5 + q) * 64 + c4 * 4 + j] = acc[q][j];
    __syncthreads();
    if (tid < 320) {
        const int q = tid >> 6, col = tid & 63;
        float a = 0.f;
        for (int k2 = 0; k2 < 32; ++k2) a += red[(k2 * 5 + q) * 64 + col];
        const int j = cgi * 64 + col;
        p.mod[((size_t)l * 5 + q) * 6144 + j] = a + p.b_mod[(size_t)l * 6144 + j];
    }
    __syncthreads();
}

DI void phase0(const Params& p, ldsp_t smem) {
    constexpr int T_IN = 16 * 7, T_OUT = 16 * 4, T_FF1 = 16 * 16, T_FF2 = 64 * 4;
    constexpr int T_L = T_IN + T_OUT + T_FF1 + T_FF2;
    constexpr int U_T = DEPTH * T_L;
    constexpr int U_MOD = DEPTH * 96;
    constexpr int U_WS = 64;
    constexpr int U_ALL = U_MOD + U_T + U_WS + 1;
    for (int u = blockIdx.x; u < U_ALL; u += gridDim.x) {
        if (u < U_MOD) { mod_unit(p, u / 96, u % 96, smem); continue; }
        int v = u - U_MOD;
        if (v < U_T) {
            const int l = v / T_L; int r = v % T_L;
            if (r < T_IN) { transpose_tile(p.w_in + (size_t)l * DM * IN_DIM, p.wt_in + (size_t)l * IN_DIM * DM, DM, IN_DIM, r / 7, r % 7, smem); continue; }
            r -= T_IN;
            if (r < T_OUT) { transpose_tile(p.w_out + (size_t)l * DM * DM, p.wt_out + (size_t)l * DM * DM, DM, DM, r / 4, r % 4, smem); continue; }
            r -= T_OUT;
            if (r < T_FF1) { transpose_tile(p.w_ff1 + (size_t)l * DM * FF, p.wt_ff1 + (size_t)l * FF * DM, DM, FF, r / 16, r % 16, smem); continue; }
            r -= T_FF1;
            transpose_tile(p.w_ff2 + (size_t)l * FF * DM, p.wt_ff2 + (size_t)l * DM * FF, FF, DM, r / 4, r % 4, smem); continue;
        }
        v -= U_T;
        if (v < U_WS) {
            int tw = threadIdx.x;
            asm volatile("" : "+v"(tw));
            const size_t i = ((size_t)v * 512 + tw) * 8;
            const f32x4 a = *(const f32x4*)(p.w_spatial + i), b = *(const f32x4*)(p.w_spatial + i + 4);
            u32x4 w; w[0] = pk2(a[0], a[1]); w[1] = pk2(a[2], a[3]); w[2] = pk2(b[0], b[1]); w[3] = pk2(b[2], b[3]);
            *(u32x4*)(p.ws_bf + i) = w;
            continue;
        }
        int ti = threadIdx.x;
        asm volatile("" : "+v"(ti));
        if (ti == 64) *p.bar = 0u;
        if (ti < DEPTH) {
            float mq = 0.f, mk = 0.f;
            for (int i = 0; i < 64; ++i) { mq = fmaxf(mq, fabsf(p.q_norm_g[ti * 64 + i])); mk = fmaxf(mk, fabsf(p.k_norm_g[ti * 64 + i])); }
            p.smax[ti] = 8.f * mq * mk;
        }
        for (int i = ti; i < 1024; i += 512) {
            const int pos = i >> 4, f = i & 15;
            const float inv = fexp2(-(float)f * (13.287712379549449f / 16.f));
            const float rev = (float)pos * inv * 0.15915494309189535f;
            p.rope[i] = __builtin_amdgcn_cosf(rev);
            p.rope[1024 + i] = __builtin_amdgcn_sinf(rev);
        }
    }
}

DI void phase1(const Params& p) {
    int tid = threadIdx.x;
    asm volatile("" : "+v"(tid));
    const int lane = tid & 63, wid = tid >> 6;
    const int gw = blockIdx.x * 8 + wid, nw = gridDim.x * 8;
    for (int row = gw; row < NTOK; row += nw) {
        const float* src = row < NLAT ? p.x + (size_t)row * DM : p.ctx + (size_t)(row - NLAT) * DM;
        const int cond = row < NLAT ? (row >> 12) : 4;
        const float* mp = p.mod + ((size_t)cond) * 6144;
        f32x4 v[4];
        float ss = 0.f;
#pragma unroll
        for (int i = 0; i < 4; ++i) { v[i] = *(const f32x4*)(src + i * 256 + lane * 4); ss += v[i][0] * v[i][0] + v[i][1] * v[i][1] + v[i][2] * v[i][2] + v[i][3] * v[i][3]; }
#pragma unroll
        for (int o = 1; o < 64; o <<= 1) ss += __shfl_xor(ss, o);
        if (lane < 16) p.ss[(size_t)row * 16 + lane] = lane == 0 ? ss : 0.f;
        bf16_t* hp = p.H + (size_t)row * DM;
        float* xw = xrow_ptr(p, row);
#pragma unroll
        for (int i = 0; i < 4; ++i) {
            const int idx = i * 256 + lane * 4;
            const f32x4 gg = *(const f32x4*)(p.norm1_g + idx), sc = *(const f32x4*)(mp + DM + idx);
            f32x4 y;
#pragma unroll
            for (int j = 0; j < 4; ++j) y[j] = v[i][j] * gg[j] * (1.f + sc[j]);
            u32x2 w; w[0] = pk2(y[0], y[1]); w[1] = pk2(y[2], y[3]);
            *(u32x2*)(hp + idx) = w;
            *(f32x4*)(xw + idx) = v[i];
        }
    }
    {
        const int fr = lane & 15, fq = lane >> 4;
        constexpr int G_IN = IN_DIM / 16, G_FF = FF / 16, G_L = G_IN + G_FF;
        for (int gi = gw; gi < DEPTH * G_L; gi += nw) {
            const int l = gi / G_L, r = gi % G_L;
            const bool which = r >= G_IN;
            const int n0 = (which ? r - G_IN : r) * 16;
            const int N = which ? FF : IN_DIM;
            const bf16_t* W = (which ? p.wt_ff1 + (size_t)l * FF * DM : p.wt_in + (size_t)l * IN_DIM * DM) + (size_t)(n0 + fr) * DM + fq * 8;
            float* dst = which ? p.shw_ff1 + (size_t)l * 5 * FF : p.shw_in + (size_t)l * 5 * IN_DIM;
            const int c = fr < 5 ? fr : fr - 5;
            const float* sh = p.mod + ((size_t)l * 5 + (c < 5 ? c : 0)) * 6144 + (which ? 3 : 0) * DM + fq * 8;
            f32x4 acc = {0.f, 0.f, 0.f, 0.f};
#pragma unroll 8
            for (int ks = 0; ks < 32; ++ks) {
                const bf16x8 wv = *(const bf16x8*)(W + ks * 32);
                const f32x4 s0 = *(const f32x4*)(sh + ks * 32), s1 = *(const f32x4*)(sh + ks * 32 + 4);
                float sv[8] = {s0[0], s0[1], s0[2], s0[3], s1[0], s1[1], s1[2], s1[3]};
                u32x4 aw;
#pragma unroll
                for (int j = 0; j < 4; ++j) {
                    float a0 = sv[2 * j], a1 = sv[2 * j + 1];
                    const unsigned hi = pk2(a0, a1);
                    if (fr >= 5) { a0 -= __uint_as_float(hi << 16); a1 -= __uint_as_float(hi & 0xffff0000u); }
                    aw[j] = fr < 5 ? hi : (fr < 10 ? pk2(a0, a1) : 0u);
                }
                acc = __builtin_amdgcn_mfma_f32_16x16x32_bf16(__builtin_bit_cast(bf16x8, aw), wv, acc, 0, 0, 0);
            }
            const float r4 = __shfl(acc[0], fr + 16);
            const float r5 = __shfl(acc[1], fr + 16), r6 = __shfl(acc[2], fr + 16), r7 = __shfl(acc[3], fr + 16);
            const float r8 = __shfl(acc[0], fr + 32), r9 = __shfl(acc[1], fr + 32);
            if (fq == 0) {
                dst[(size_t)0 * N + n0 + fr] = acc[0] + r5;
                dst[(size_t)1 * N + n0 + fr] = acc[1] + r6;
                dst[(size_t)2 * N + n0 + fr] = acc[2] + r7;
                dst[(size_t)3 * N + n0 + fr] = acc[3] + r8;
                dst[(size_t)4 * N + n0 + fr] = r4 + r9;
            }
        }
    }
}

constexpr int G_TILE_B = 256 * 64 * 2, G_STAGE_B = 2 * G_TILE_B;
DI int lds_byte2(int r, int c) {
    const int st = (r >> 4) * 2 + (c >> 5), ob = (r & 15) * 64 + (c & 31) * 2;
    return st * 1024 + (ob ^ (((ob >> 9) & 1) << 5));
}
DI void stage_rc2(int b, int& R, int& C) {
    const int st = b >> 10, sb = b & 1023, swz = sb ^ (((sb >> 9) & 1) << 5);
    R = (st >> 1) * 16 + swz / 64;
    C = (st & 1) * 32 + (swz % 64) / 2;
}
template <int KS> DI int lds_byte_ks(int r, int c) {
    const int st = (r >> 4) * KS + (c >> 5), ob = (r & 15) * 64 + (c & 31) * 2;
    return st * 1024 + (ob ^ (((ob >> 9) & 1) << 5));
}
template <int KS> DI void stage_rc_ks(int b, int& R, int& C) {
    const int st = b >> 10, sb = b & 1023, swz = sb ^ (((sb >> 9) & 1) << 5);
    R = (st / KS) * 16 + swz / 64;
    C = (st % KS) * 32 + (swz % 64) / 2;
}
#define WAIT_V0() asm volatile("s_waitcnt vmcnt(0)" ::: "memory")

struct TileCtx { int brow, bcol, pn, wr, wc, fr, fq, wid, lane, l; };

DI void tile_coords(int L, int nM, int nN, int& pm, int& pn) {
    const int nwg = nM * nN;
    int wgid = L;
    { const int q = nwg / 8, r = nwg % 8, xcd = wgid % 8, off = wgid / 8; wgid = (xcd < r ? xcd * (q + 1) : r * (q + 1) + (xcd - r) * q) + off; }
    const int nig = 8 * nN, gid = wgid / nig, fm = gid * 8, gsz = (nM - fm) < 8 ? (nM - fm) : 8;
    pm = fm + ((wgid % nig) % gsz); pn = (wgid % nig) / gsz;
}

DI void wave_put(ldsp_t wb, int rowl, int n, int fq, u32x2 w) {
    const int chunk = n * 2 + (fq >> 1);
    *(LDSP u32x2*)(wb + rowl * 128 + ((chunk ^ (rowl & 7)) << 4) + (fq & 1) * 8) = w;
}
DI void wave_rows_store(ldsp_t wb, int lane, bf16_t* dst0, size_t ld) {
#pragma unroll
    for (int i = 0; i < 8; ++i) {
        const int row = i * 8 + (lane >> 3), ch = lane & 7;
        const u32x4 v = *(const LDSP u32x4*)(wb + row * 128 + ((ch ^ (row & 7)) << 4));
        *(u32x4*)(dst0 + (size_t)row * ld + ch * 8) = v;
    }
}

template <int EK> struct EpiResid {
    static DI void run(const f32x4 (&acc)[8][4], const TileCtx& tc, const Params& p, ldsp_t wb) {
        constexpr int GI = EK == 1 ? 2 : 5;
        const int cond = tc.brow < NLAT ? (tc.brow >> 12) : 4;
        const float* gate = p.mod + ((size_t)tc.l * 5 + cond) * 6144 + GI * DM;
        const int col0 = tc.bcol + tc.wc * 64 + tc.fq * 4;
        const bool has_next = EK == 1 || tc.l + 1 < DEPTH;
        const int ln = EK == 1 ? tc.l : (has_next ? tc.l + 1 : tc.l);
        const float* gnx = (EK == 1 ? p.norm2_g : p.norm1_g) + (size_t)ln * DM + col0;
        const float* scn = p.mod + ((size_t)ln * 5 + cond) * 6144 + (EK == 1 ? 4 : 1) * DM + col0;
        float* ssp = p.ss + (size_t)(ln * 2 + (EK == 1 ? 1 : 0)) * NTOK * 16 + (tc.bcol >> 8) * 4 + tc.wc;
        f32x4 gv[4], av[4];
#pragma unroll
        for (int n = 0; n < 4; ++n) {
            gv[n] = *(const f32x4*)(gate + col0 + n * 16);
            const f32x4 g1 = *(const f32x4*)(gnx + n * 16), s1 = *(const f32x4*)(scn + n * 16);
            av[n] = g1 * (1.f + s1);
        }
#pragma unroll
        for (int h = 0; h < 2; ++h) {
#pragma unroll
            for (int mm = 0; mm < 4; ++mm) { __builtin_amdgcn_sched_barrier(0);
                const int m = h * 4 + mm;
                const int row = tc.brow + tc.wr * 128 + m * 16 + tc.fr;
                float* xr = xrow_ptr(p, row) + col0;
                float part = 0.f;
#pragma unroll
                for (int n = 0; n < 4; ++n) {
                    f32x4 xv = *(const f32x4*)(xr + n * 16);
                    xv += gv[n] * acc[m][n];
                    *(f32x4*)(xr + n * 16) = xv;
                    if (has_next) {
                        part += xv[0] * xv[0] + xv[1] * xv[1] + xv[2] * xv[2] + xv[3] * xv[3];
                        const f32x4 hv = xv * av[n];
                        u32x2 w; w[0] = pk2(hv[0], hv[1]); w[1] = pk2(hv[2], hv[3]);
                        wave_put(wb, mm * 16 + tc.fr, n, tc.fq, w);
                    }
                }
                if (has_next) {
                    part += __shfl_xor(part, 16);
                    part += __shfl_xor(part, 32);
                    if (tc.fq == 0) ssp[(size_t)row * 16] = part;
                }
            }
            if (has_next) wave_rows_store(wb, tc.lane, p.H + (size_t)(tc.brow + tc.wr * 128 + h * 64) * DM + tc.bcol + tc.wc * 64, DM);
        }
    }
};
struct EpiFF1 {
    static DI void run(const f32x4 (&acc)[8][4], const TileCtx& tc, const Params& p, ldsp_t wb) {
#pragma unroll
        for (int h = 0; h < 2; ++h) {
#pragma unroll
            for (int mm = 0; mm < 4; ++mm) {
                const int m = h * 4 + mm;
#pragma unroll
                for (int n = 0; n < 4; ++n) {
                    f32x4 a = acc[m][n];
#pragma unroll
                    for (int j = 0; j < 4; ++j) { const float r = fmaxf(a[j], 0.f); a[j] = r * r; }
                    u32x2 w; w[0] = pk2(a[0], a[1]); w[1] = pk2(a[2], a[3]);
                    wave_put(wb, mm * 16 + tc.fr, n, tc.fq, w);
                }
            }
            wave_rows_store(wb, tc.lane, p.ACT + (size_t)(tc.brow + tc.wr * 128 + h * 64) * FF + tc.bcol + tc.wc * 64, FF);
        }
    }
};
template <int BRK> struct EpiIn {
    static DI void run(const f32x4 (&acc)[8][4], const TileCtx& tc, const Params& p, ldsp_t wb) {
        const int l = tc.l, pn = tc.pn, wc = tc.wc, fr = tc.fr, fq = tc.fq;
        if (BRK == 0 || (BRK == 1 && wc < 2)) {
            constexpr bool isq = BRK == 0;
            const int head = isq ? pn * 4 + wc : wc;
            const float* gn = (isq ? p.q_norm_g : p.k_norm_g) + l * 64;
            f32x4 gv[4];
#pragma unroll
            for (int n = 0; n < 4; ++n) gv[n] = *(const f32x4*)(gn + n * 16 + fq * 4);
            const float osc = isq ? 0.125f * LOG2E : 1.f;
            const bool lat = tc.brow < NLAT;
#pragma unroll
            for (int h = 0; h < 2; ++h) {
#pragma unroll
                for (int mm = 0; mm < 4; ++mm) { __builtin_amdgcn_sched_barrier(0);
                    const int m = h * 4 + mm;
                    const int row = tc.brow + tc.wr * 128 + m * 16 + fr;
                    float ss = 0.f;
#pragma unroll
                    for (int n = 0; n < 4; ++n)
#pragma unroll
                        for (int j = 0; j < 4; ++j) ss += acc[m][n][j] * acc[m][n][j];
                    ss += __shfl_xor(ss, 16);
                    ss += __shfl_xor(ss, 32);
                    const float rstd = rsqrtf(ss * (1.f / 64.f) + EPS) * osc;
                    const int t = row & 4095;
#pragma unroll
                    for (int ax = 0; ax < 2; ++ax) {
                        f32x4 x1 = acc[m][2 * ax] * rstd * gv[2 * ax], x2 = acc[m][2 * ax + 1] * rstd * gv[2 * ax + 1];
                        if (lat) {
                            const int pos = ax == 0 ? (t >> 6) : (t & 63);
                            const f32x4 cs = *(const f32x4*)(p.rope + pos * 16 + fq * 4), sn = *(const f32x4*)(p.rope + 1024 + pos * 16 + fq * 4);
                            const f32x4 o1 = x1 * cs - x2 * sn, o2 = x2 * cs + x1 * sn;
                            x1 = o1; x2 = o2;
                        }
                        u32x2 w; w[0] = pk2(x1[0], x1[1]); w[1] = pk2(x1[2], x1[3]);
                        wave_put(wb, mm * 16 + fr, 2 * ax, fq, w);
                        w[0] = pk2(x2[0], x2[1]); w[1] = pk2(x2[2], x2[3]);
                        wave_put(wb, mm * 16 + fr, 2 * ax + 1, fq, w);
                    }
                }
                const int row0 = tc.brow + tc.wr * 128 + h * 64;
                bf16_t* dst0;
                if (lat) {
                    const int b = row0 >> 12, t0 = row0 & 4095;
                    dst0 = isq ? p.Q + ((size_t)(b * 8 + head) * SEQ + t0) * 64 : p.K + ((size_t)(b * 2 + head) * NKEY + CTXL + t0) * 64;
                } else {
                    const int r2 = row0 - NLAT, b = r2 >> 8, t0 = r2 & 255;
                    dst0 = isq ? p.Qc + ((size_t)(b * 8 + head) * CTXL + t0) * 64 : p.K + ((size_t)(b * 2 + head) * NKEY + t0) * 64;
                }
                wave_rows_store(wb, tc.lane, dst0, 64);
            }
        } else if (BRK == 1) {
            const int kvh = wc - 2;
#pragma unroll
            for (int h = 0; h < 2; ++h) {
#pragma unroll
                for (int mm = 0; mm < 4; ++mm) {
                    const int m = h * 4 + mm;
                    const int key = mm * 16 + fr, k16 = key & 15;
                    const int kp = (key & ~15) | ((((k16 >> 2) & 1) << 3) + (k16 & 3) + ((k16 >> 3) << 2));
#pragma unroll
                    for (int n = 0; n < 4; ++n)
#pragma unroll
                        for (int j = 0; j < 4; ++j) {
                            const int d = n * 16 + fq * 4 + j;
                            *(LDSP bf16_t*)(wb + d * 128 + (((kp >> 3) ^ (d & 7)) << 4) + (kp & 7) * 2) = f2bf(acc[m][n][j]);
                        }
                }
                const int row0 = tc.brow + tc.wr * 128 + h * 64;
                int b, pos0;
                if (row0 < NLAT) { b = row0 >> 12; pos0 = CTXL + (row0 & 4095); } else { const int r2 = row0 - NLAT; b = r2 >> 8; pos0 = r2 & 255; }
                wave_rows_store(wb, tc.lane, p.Vt + (size_t)(b * 2 + kvh) * 64 * NKEY + pos0, NKEY);
            }
        } else if (BRK == 2) {
#pragma unroll
            for (int h = 0; h < 2; ++h) {
#pragma unroll
                for (int mm = 0; mm < 4; ++mm) {
                    const int m = h * 4 + mm;
#pragma unroll
                    for (int n = 0; n < 4; ++n) {
                        u32x2 w; w[0] = pk2(gelu_tanh(acc[m][n][0]), gelu_tanh(acc[m][n][1])); w[1] = pk2(gelu_tanh(acc[m][n][2]), gelu_tanh(acc[m][n][3]));
                        wave_put(wb, mm * 16 + fr, n, fq, w);
                    }
                }
                wave_rows_store(wb, tc.lane, p.U + (size_t)(tc.brow + tc.wr * 128 + h * 64) * 1024 + (pn - 3) * 256 + wc * 64, 1024);
            }
        }
    }
};

template <int EK>
DI void gemm_stream(const Params& p, int l, const bf16_t* __restrict__ A, const bf16_t* __restrict__ Bt, int M, int N, int K, ldsp_t shm) {
    const int nM = M / 256, nN = N / 256, nwg = nM * nN;
    int L = blockIdx.x;
    if (L >= nwg) return;
#define G_SA(b) (shm + (b) * G_STAGE_B)
#define G_SB(b) (shm + (b) * G_STAGE_B + G_TILE_B)
#define G_LANE_SETUP() \
    int tid_ = threadIdx.x; \
    asm volatile("" : "+v"(tid_));    \
    const int wid = tid_ >> 6, lane = tid_ & 63, wr = wid >> 2, wc = wid & 3, fr = lane & 15, fq = lane >> 4; \
    unsigned soff[4];        \
    _Pragma("unroll") for (int i = 0; i < 4; ++i) { int sR, sC; stage_rc2(wid * 1024 + i * 8192 + lane * 16, sR, sC); soff[i] = (unsigned)(sR * K + sC) * 2u; }
#define G_STAGE(Ap, Bp, buf, kt) do { const char* ab_ = (const char*)(Ap) + (size_t)(kt) * 128; const char* bb_ = (const char*)(Bp) + (size_t)(kt) * 128; \
      _Pragma("unroll") for (int i = 0; i < 4; ++i) { \
        __builtin_amdgcn_global_load_lds((const unsigned*)(ab_ + soff[i]), (LDSP unsigned*)(G_SA(buf) + wid * 1024 + i * 8192), 16, 0, 0); \
        __builtin_amdgcn_global_load_lds((const unsigned*)(bb_ + soff[i]), (LDSP unsigned*)(G_SB(buf) + wid * 1024 + i * 8192), 16, 0, 0); } } while (0)
    const int nt = K / 64;
    int pm, pn;
    tile_coords(L, nM, nN, pm, pn);
    const bf16_t* Ab = A + (size_t)pm * 256 * K;
    const bf16_t* Bb = Bt + (size_t)pn * 256 * K;
    { G_LANE_SETUP(); (void)wr; (void)wc; (void)fr; (void)fq; G_STAGE(Ab, Bb, 0, 0); WAIT_V0(); __syncthreads(); }
    while (true) {
        G_LANE_SETUP();
        const int aoff = lds_byte2(wr * 128 + fr, fq * 8), boff = lds_byte2(wc * 64 + fr, fq * 8);
        f32x4 acc[8][4];
#pragma unroll
        for (int m = 0; m < 8; ++m)
#pragma unroll
            for (int n = 0; n < 4; ++n) acc[m][n] = (f32x4){0.f, 0.f, 0.f, 0.f};
        const int Ln = L + gridDim.x;
        const bool has_next = Ln < nwg;
        int pm2 = pm, pn2 = pn;
        if (has_next) tile_coords(Ln, nM, nN, pm2, pn2);
        const bf16_t* Ab2 = A + (size_t)pm2 * 256 * K;
        const bf16_t* Bb2 = Bt + (size_t)pn2 * 256 * K;
        bf16x8 Aa[4], Ab_[4], Bk0[4], Bk1[4];
#define G_RDA(AF, buf, ks, mh) do { _Pragma("unroll") for (int m = 0; m < 4; ++m) AF[m] = *(const LDSP bf16x8*)(G_SA(buf) + aoff + ((mh) * 4 + m) * 2048 + (ks) * 1024); } while (0)
#define G_RDB(BF, buf, ks) do { _Pragma("unroll") for (int n = 0; n < 4; ++n) BF[n] = *(const LDSP bf16x8*)(G_SB(buf) + boff + n * 2048 + (ks) * 1024); } while (0)
#define G_MMA(AF, BF, mh) do { __builtin_amdgcn_s_setprio(1); \
            _Pragma("unroll") for (int m = 0; m < 4; ++m) _Pragma("unroll") for (int n = 0; n < 4; ++n) \
                acc[(mh) * 4 + m][n] = __builtin_amdgcn_mfma_f32_16x16x32_bf16(BF[n], AF[m], acc[(mh) * 4 + m][n], 0, 0, 0); \
            __builtin_amdgcn_s_setprio(0); } while (0)
#define G_SB0() __builtin_amdgcn_sched_barrier(0)
        for (int t = 0; t < nt; ++t) {
            const int cur = t & 1;
            G_RDA(Aa, cur, 0, 0); G_RDB(Bk0, cur, 0); G_SB0();
            if (t > 0) G_MMA(Ab_, Bk1, 1);
            G_SB0();
            if (t + 1 < nt) G_STAGE(Ab, Bb, cur ^ 1, t + 1);
            else if (has_next) G_STAGE(Ab2, Bb2, cur ^ 1, 0);
            G_RDA(Ab_, cur, 0, 1); G_SB0();
            G_MMA(Aa, Bk0, 0); G_SB0();
            G_RDA(Aa, cur, 1, 0); G_RDB(Bk1, cur, 1); G_SB0();
            G_MMA(Ab_, Bk0, 1); G_SB0();
            G_RDA(Ab_, cur, 1, 1); G_SB0();
            G_MMA(Aa, Bk1, 0); G_SB0();
            asm volatile("s_waitcnt lgkmcnt(0)" ::: "memory");
            WAIT_V0(); __syncthreads();
        }
        G_MMA(Ab_, Bk1, 1);
        G_SB0();
        {
            int tid2 = threadIdx.x, pme = pm, pne = pn;
            asm volatile("" : "+v"(tid2), "+s"(pme), "+s"(pne));
            TileCtx tc;
            tc.wid = tid2 >> 6; tc.lane = tid2 & 63; tc.wr = tc.wid >> 2; tc.wc = tc.wid & 3; tc.fr = tc.lane & 15; tc.fq = tc.lane >> 4; tc.l = l;
            tc.brow = pme * 256; tc.bcol = pne * 256; tc.pn = pne;
            ldsp_t ex = shm + G_STAGE_B + tc.wid * 8192;
            if (EK == 0 || EK == 2) {
                const int cond = tc.brow < NLAT ? (tc.brow >> 12) : 4;
                const float* ssp = p.ss + ((size_t)(l * 2 + (EK == 0 ? 0 : 1)) * NTOK + tc.brow + tc.wr * 128 + tc.fr) * 16 + tc.fq * 4;
                const float* shw = (EK == 0 ? p.shw_in + ((size_t)l * 5 + cond) * IN_DIM : p.shw_ff1 + ((size_t)l * 5 + cond) * FF) + tc.bcol + tc.wc * 64 + tc.fq * 4;
                f32x4 shv[4];
#pragma unroll
                for (int n = 0; n < 4; ++n) shv[n] = *(const f32x4*)(shw + n * 16);
#pragma unroll
                for (int m = 0; m < 8; ++m) {
                    const f32x4 pp = *(const f32x4*)(ssp + m * 256);
                    float sq = pp[0] + pp[1] + pp[2] + pp[3];
                    sq += __shfl_xor(sq, 16);
                    sq += __shfl_xor(sq, 32);
                    const float rstd = rsqrtf(sq * (1.f / DM) + EPS);
#pragma unroll
                    for (int n = 0; n < 4; ++n) acc[m][n] = acc[m][n] * rstd + shv[n];
                }
            }
            if (EK == 0) {
                if (pne < 2) EpiIn<0>::run(acc, tc, p, ex);
                else if (pne == 2) EpiIn<1>::run(acc, tc, p, ex);
                else EpiIn<2>::run(acc, tc, p, ex);
            } else if (EK == 1) EpiResid<1>::run(acc, tc, p, ex);
            else if (EK == 2) EpiFF1::run(acc, tc, p, ex);
            else EpiResid<3>::run(acc, tc, p, ex);
        }
        __syncthreads();
        if (!has_next) break;
        L = Ln; pm = pm2; pn = pn2; Ab = Ab2; Bb = Bb2;
    }
}

template <int EK>
DI void ctx_item(const Params& p, int l, int grow, int gcol, int slot, f32x4 s0, f32x4 s1, bool lead) {
    if (EK == 2) {
        const float* pp = p.ss + ((size_t)(l * 2 + 1) * NTOK + NLAT + grow) * 16;
        const f32x4 q0 = *(const f32x4*)pp, q1 = *(const f32x4*)(pp + 4), q2 = *(const f32x4*)(pp + 8), q3 = *(const f32x4*)(pp + 12);
        const f32x4 qs = q0 + q1 + q2 + q3;
        const float rstd = rsqrtf((qs[0] + qs[1] + qs[2] + qs[3]) * (1.f / DM) + EPS);
        const float* shw = p.shw_ff1 + ((size_t)l * 5 + 4) * FF + gcol;
        const f32x4 h0 = *(const f32x4*)shw, h1 = *(const f32x4*)(shw + 4);
        s0 = s0 * rstd + h0; s1 = s1 * rstd + h1;
#pragma unroll
        for (int j = 0; j < 4; ++j) { float r0 = fmaxf(s0[j], 0.f), r1 = fmaxf(s1[j], 0.f); s0[j] = r0 * r0; s1[j] = r1 * r1; }
        u32x4 w; w[0] = pk2(s0[0], s0[1]); w[1] = pk2(s0[2], s0[3]); w[2] = pk2(s1[0], s1[1]); w[3] = pk2(s1[2], s1[3]);
        *(u32x4*)(p.ACT + (size_t)(NLAT + grow) * FF + gcol) = w;
    } else {
        const float* gate = p.mod + ((size_t)l * 5 + 4) * 6144 + (EK == 1 ? 2 : 5) * DM + gcol;
        float* xr = p.xc + (size_t)grow * DM + gcol;
        const f32x4 g0 = *(const f32x4*)gate, g1 = *(const f32x4*)(gate + 4);
        f32x4 x0 = *(const f32x4*)xr, x1 = *(const f32x4*)(xr + 4);
        x0 += g0 * s0; x1 += g1 * s1;
        *(f32x4*)xr = x0; *(f32x4*)(xr + 4) = x1;
        const int ln = EK == 1 ? l : l + 1;
        const float* gnx = (EK == 1 ? p.norm2_g : p.norm1_g) + (size_t)ln * DM + gcol;
        const float* scn = p.mod + ((size_t)ln * 5 + 4) * 6144 + (EK == 1 ? 4 : 1) * DM + gcol;
        const f32x4 a0 = *(const f32x4*)gnx * (1.f + *(const f32x4*)scn), a1 = *(const f32x4*)(gnx + 4) * (1.f + *(const f32x4*)(scn + 4));
        const f32x4 y0 = x0 * a0, y1 = x1 * a1;
        u32x4 w; w[0] = pk2(y0[0], y0[1]); w[1] = pk2(y0[2], y0[3]); w[2] = pk2(y1[0], y1[1]); w[3] = pk2(y1[2], y1[3]);
        *(u32x4*)(p.H + (size_t)(NLAT + grow) * DM + gcol) = w;
        float part = x0[0] * x0[0] + x0[1] * x0[1] + x0[2] * x0[2] + x0[3] * x0[3] + x1[0] * x1[0] + x1[1] * x1[1] + x1[2] * x1[2] + x1[3] * x1[3];
        part += __shfl_xor(part, 1); part += __shfl_xor(part, 2); part += __shfl_xor(part, 4);
        if (lead) p.ss[((size_t)(ln * 2 + (EK == 1 ? 1 : 0)) * NTOK + NLAT + grow) * 16 + slot] = part;
    }
}

template <int EK, int TS, int KS>
DI void ctx_tiles(const Params& p, int l, const bf16_t* __restrict__ A, const bf16_t* __restrict__ Bt, int N, int K, ldsp_t shm) {
    constexpr int WM = TS / 2, WN = TS / 4, MT = WM / 16, NT = WN / 16, BKC = 32 * KS;
    constexpr int TILE_A = TS * BKC * 2, PP = TILE_A / 8192;
    const int ntn = N / TS, ntiles = (NCTX / TS) * ntn, nt = K / BKC;
    for (int u = blockIdx.x; u < ntiles; u += gridDim.x) {
        const int tm = u / ntn, tn = u % ntn;
        int tid = threadIdx.x;
        asm volatile("" : "+v"(tid));
        const int wid = tid >> 6, lane = tid & 63, wr = wid >> 2, wc = wid & 3, fr = lane & 15, fq = lane >> 4;
        unsigned soff[PP];
#pragma unroll
        for (int i = 0; i < PP; ++i) { int sR, sC; stage_rc_ks<KS>((wid * PP + i) * 1024 + lane * 16, sR, sC); soff[i] = (unsigned)(sR * K + sC) * 2u; }
        const bf16_t* Ab = A + (size_t)tm * TS * K;
        const bf16_t* Bb = Bt + (size_t)tn * TS * K;
#define C_STAGE(buf, kt) do { const char* ab_ = (const char*)Ab + (size_t)(kt) * (BKC * 2); const char* bb_ = (const char*)Bb + (size_t)(kt) * (BKC * 2); \
      _Pragma("unroll") for (int i = 0; i < PP; ++i) { \
        __builtin_amdgcn_global_load_lds((const unsigned*)(ab_ + soff[i]), (LDSP unsigned*)(shm + (buf) * 2 * TILE_A + (wid * PP + i) * 1024), 16, 0, 0); \
        __builtin_amdgcn_global_load_lds((const unsigned*)(bb_ + soff[i]), (LDSP unsigned*)(shm + (buf) * 2 * TILE_A + TILE_A + (wid * PP + i) * 1024), 16, 0, 0); } } while (0)
        f32x4 acc[MT][NT];
#pragma unroll
        for (int m = 0; m < MT; ++m)
#pragma unroll
            for (int n = 0; n < NT; ++n) acc[m][n] = (f32x4){0.f, 0.f, 0.f, 0.f};
        const int aoff = lds_byte_ks<KS>(wr * WM + fr, fq * 8), boff = lds_byte_ks<KS>(wc * WN + fr, fq * 8);
        C_STAGE(0, 0); WAIT_V0(); __syncthreads();
        for (int t = 0; t < nt; ++t) {
            const int cur = t & 1;
            if (t + 1 < nt) C_STAGE(cur ^ 1, t + 1);
            ldsp_t sa = shm + cur * 2 * TILE_A, sb = sa + TILE_A;
#pragma unroll
            for (int ks = 0; ks < KS; ++ks) {
                bf16x8 At[MT], Bf[NT];
#pragma unroll
                for (int m = 0; m < MT; ++m) At[m] = *(const LDSP bf16x8*)(sa + aoff + m * (KS * 1024) + ks * 1024);
#pragma unroll
                for (int n = 0; n < NT; ++n) Bf[n] = *(const LDSP bf16x8*)(sb + boff + n * (KS * 1024) + ks * 1024);
#pragma unroll
                for (int m = 0; m < MT; ++m)
#pragma unroll
                    for (int n = 0; n < NT; ++n) acc[m][n] = __builtin_amdgcn_mfma_f32_16x16x32_bf16(Bf[n], At[m], acc[m][n], 0, 0, 0);
            }
            WAIT_V0(); __syncthreads();
        }
#pragma unroll
        for (int m = 0; m < MT; ++m)
#pragma unroll
            for (int n = 0; n < NT; ++n) {
                const int row = wr * WM + m * 16 + fr, ch = (wc * WN + n * 16 + fq * 4) >> 2;
                *(LDSP f32x4*)(shm + row * (TS * 4) + ((ch ^ (row & 15)) << 4)) = acc[m][n];
            }
        __syncthreads();
#pragma unroll
        for (int it = 0; it < (TS * TS / 8) / 512; ++it) {
            const int item = it * 512 + tid, row = item / (TS / 8), c8 = item % (TS / 8);
            const f32x4 s0 = *(const LDSP f32x4*)(shm + row * (TS * 4) + (((2 * c8) ^ (row & 15)) << 4));
            const f32x4 s1 = *(const LDSP f32x4*)(shm + row * (TS * 4) + (((2 * c8 + 1) ^ (row & 15)) << 4));
            ctx_item<EK>(p, l, tm * TS + row, tn * TS + c8 * 8, tn, s0, s1, c8 == 0);
        }
        __syncthreads();
    }
}

DI void attn_unit(const Params& p, int l, int b, int kvh, int qb, bool isctx, ldsp_t smem) {
    int tid = threadIdx.x;
    asm volatile("" : "+v"(tid));
    const int wid = tid >> 6, lane = tid & 63, r = lane & 31, hh = lane >> 5;
    const int head = kvh * 4 + (wid >> 1);
    const int t0 = qb * 64 + (wid & 1) * 32;
    const int nkeys = isctx ? CTXL : NKEY;
    const bf16_t* Qp = isctx ? p.Qc + ((size_t)(b * 8 + head) * CTXL + t0) * 64 : p.Q + ((size_t)(b * 8 + head) * SEQ + t0) * 64;
    const bf16_t* Kp = p.K + (size_t)(b * 2 + kvh) * NKEY * 64;
    const bf16_t* Vp = p.Vt + (size_t)(b * 2 + kvh) * 64 * NKEY;
    const int orow = isctx ? NLAT + b * CTXL + t0 : b * SEQ + t0;
    bf16_t* Op = p.MIX + (size_t)orow * DM + head * 64;
    const float cexp = p.smax[l] * LOG2E;

    bf16x8 qf[4];
#pragma unroll
    for (int ks = 0; ks < 4; ++ks) qf[ks] = *(const bf16x8*)(Qp + (size_t)r * 64 + ks * 16 + 8 * hh);
    f32x16 o[2];
#pragma unroll
    for (int i = 0; i < 16; ++i) { o[0][i] = 0.f; o[1][i] = 0.f; }
    float rs0 = 0.f, rs1 = 0.f;

    const int srow = tid >> 3, sch = tid & 7;
    const int kdst = srow * 128 + ((sch ^ ((srow >> 1) & 7)) << 4);
    const bf16_t* kg = Kp + (size_t)srow * 64 + sch * 8;
    const bf16_t* vg = Vp + (size_t)srow * NKEY + sch * 8;
    const int rsw = (r >> 1) & 7;
    const int ntile = nkeys / 64;

#define ATT_QK(SD, kb) do { _Pragma("unroll") for (int kt = 0; kt < 2; ++kt) { \
        _Pragma("unroll") for (int i = 0; i < 16; ++i) SD[kt][i] = -cexp; \
        _Pragma("unroll") for (int ks = 0; ks < 4; ++ks) { \
            const bf16x8 a_ = *(const LDSP bf16x8*)((kb) + (kt * 32 + r) * 128 + (((ks * 2 + hh) ^ rsw) << 4)); \
            SD[kt] = __builtin_amdgcn_mfma_f32_32x32x16_bf16(a_, qf[ks], SD[kt], 0, 0, 0); } } } while (0)

    u32x4 kst, vst;
    f32x16 sA[2], sB[2];
    {
        kst = *(const u32x4*)kg;
        *(LDSP u32x4*)(smem + kdst) = kst;
        kst = *(const u32x4*)(kg + (size_t)64 * 64);
        vst = *(const u32x4*)vg;
        __syncthreads();
        ATT_QK(sA, smem);
        *(LDSP u32x4*)(smem + 8192 + kdst) = kst;
        *(LDSP u32x4*)(smem + 16384 + kdst) = vst;
    }
#define ATT_STEP(t, SC, SN) do { \
        const int par = (t) & 1; \
        __syncthreads(); \
        { const int t2_ = (t) + 2 < ntile ? (t) + 2 : ntile - 1, t1_ = (t) + 1 < ntile ? (t) + 1 : ntile - 1; \
          kst = *(const u32x4*)(kg + (size_t)t2_ * 64 * 64); vst = *(const u32x4*)(vg + t1_ * 64); } \
        bf16x8 kf[8], vf[4], vh[4]; \
        ldsp_t kb_ = smem + (par ^ 1) * 8192; ldsp_t vb_ = smem + 16384 + par * 8192; \
        _Pragma("unroll") for (int kt = 0; kt < 2; ++kt) _Pragma("unroll") for (int ks = 0; ks < 4; ++ks) \
            kf[kt * 4 + ks] = *(const LDSP bf16x8*)(kb_ + (kt * 32 + r) * 128 + (((ks * 2 + hh) ^ rsw) << 4)); \
        _Pragma("unroll") for (int c = 0; c < 2; ++c) _Pragma("unroll") for (int dt = 0; dt < 2; ++dt) \
            vf[c * 2 + dt] = *(const LDSP bf16x8*)(vb_ + (dt * 32 + r) * 128 + (((c * 2 + hh) ^ rsw) << 4)); \
        __builtin_amdgcn_sched_barrier(0); \
        _Pragma("unroll") for (int kt = 0; kt < 2; ++kt) _Pragma("unroll") for (int i = 0; i < 16; ++i) SN[kt][i] = -cexp;     \
        _Pragma("unroll") for (int ks = 0; ks < 4; ++ks) _Pragma("unroll") for (int kt = 0; kt < 2; ++kt) \
            SN[kt] = __builtin_amdgcn_mfma_f32_32x32x16_bf16(kf[kt * 4 + ks], qf[ks], SN[kt], 0, 0, 0); \
        _Pragma("unroll") for (int c = 2; c < 4; ++c) _Pragma("unroll") for (int dt = 0; dt < 2; ++dt) \
            vh[(c - 2) * 2 + dt] = *(const LDSP bf16x8*)(vb_ + (dt * 32 + r) * 128 + (((c * 2 + hh) ^ rsw) << 4)); \
        __builtin_amdgcn_sched_barrier(0); \
        _Pragma("unroll") for (int kt = 0; kt < 2; ++kt) { \
            _Pragma("unroll") for (int i = 0; i < 16; ++i) { \
                const float e_ = fexp2(SC[kt][i]); \
                if (i & 1) rs1 += e_; else rs0 += e_; \
                SC[kt][i] = e_; } } \
        _Pragma("unroll") for (int c = 0; c < 4; ++c) { \
            u32x4 pw; \
            pw[0] = pk2(SC[c >> 1][8 * (c & 1) + 0], SC[c >> 1][8 * (c & 1) + 1]); pw[1] = pk2(SC[c >> 1][8 * (c & 1) + 2], SC[c >> 1][8 * (c & 1) + 3]); \
            pw[2] = pk2(SC[c >> 1][8 * (c & 1) + 4], SC[c >> 1][8 * (c & 1) + 5]); pw[3] = pk2(SC[c >> 1][8 * (c & 1) + 6], SC[c >> 1][8 * (c & 1) + 7]); \
            const bf16x8 pb = __builtin_bit_cast(bf16x8, pw); \
            _Pragma("unroll") for (int dt = 0; dt < 2; ++dt) o[dt] = __builtin_amdgcn_mfma_f32_32x32x16_bf16(c < 2 ? vf[c * 2 + dt] : vh[(c - 2) * 2 + dt], pb, o[dt], 0, 0, 0); } \
        *(LDSP u32x4*)(smem + par * 8192 + kdst) = kst; \
        *(LDSP u32x4*)(smem + 16384 + (par ^ 1) * 8192 + kdst) = vst; \
    } while (0)

    for (int t = 0; t < ntile; t += 2) {
        ATT_STEP(t, sA, sB);
        ATT_STEP(t + 1, sB, sA);
    }
    const float lrun = rs0 + rs1;
    const float ltot = lrun + __shfl_xor(lrun, 32);
    const float inv = 1.f / ltot;
#pragma unroll
    for (int dt = 0; dt < 2; ++dt)
#pragma unroll
        for (int g4 = 0; g4 < 4; ++g4) {
            u32x2 w; w[0] = pk2(o[dt][4 * g4 + 0] * inv, o[dt][4 * g4 + 1] * inv); w[1] = pk2(o[dt][4 * g4 + 2] * inv, o[dt][4 * g4 + 3] * inv);
            *(u32x2*)(Op + (size_t)r * DM + dt * 32 + 8 * g4 + 4 * hh) = w;
        }
    __syncthreads();
}

DI void gmlp_unit(const Params& p, int l, int T, int g, ldsp_t smem) {
    int tid = threadIdx.x;
    asm volatile("" : "+v"(tid));
    const int wid = tid >> 6, lane = tid & 63, fr = lane & 15, fq = lane >> 4;
    {
        const int q = tid >> 2, part = tid & 3;
        const bf16_t* src = p.U + (size_t)(T * 128 + q) * 1024 + 512 + g * 128 + part * 32;
        u32x4 raw[4];
#pragma unroll
        for (int i = 0; i < 4; ++i) raw[i] = *(const u32x4*)(src + i * 8);
        float a = 0.f, b = 0.f;
#pragma unroll
        for (int i = 0; i < 4; ++i)
#pragma unroll
            for (int j = 0; j < 4; ++j) {
                const float lo = __uint_as_float(raw[i][j] << 16), hi = __uint_as_float(raw[i][j] & 0xffff0000u);
                a += lo + hi; b += lo * lo + hi * hi;
            }
        a += __shfl_xor(a, 1); a += __shfl_xor(a, 2);
        b += __shfl_xor(b, 1); b += __shfl_xor(b, 2);
        const float mean = a * (1.f / 128.f);
        const float rstd = rsqrtf(fmaxf(b * (1.f / 128.f) - mean * mean, 0.f) + EPS);
        const float* gn = p.gmlp_norm_g + l * 512 + g * 128 + part * 32;
#pragma unroll
        for (int i = 0; i < 4; ++i)
#pragma unroll
            for (int j = 0; j < 4; ++j) {
                const int c0 = part * 32 + i * 8 + j * 2;
                const float lo = __uint_as_float(raw[i][j] << 16), hi = __uint_as_float(raw[i][j] & 0xffff0000u);
                const unsigned w = pk2((lo - mean) * rstd * gn[i * 8 + j * 2], (hi - mean) * rstd * gn[i * 8 + j * 2 + 1]);
                *(LDSP bf16_t*)(smem + c0 * 256 + (((q >> 3) ^ (c0 & 15)) << 4) + (q & 7) * 2) = (bf16_t)(w & 0xffffu);
                *(LDSP bf16_t*)(smem + (c0 + 1) * 256 + (((q >> 3) ^ ((c0 + 1) & 15)) << 4) + (q & 7) * 2) = (bf16_t)(w >> 16);
            }
    }
    __syncthreads();
    const int prow = wid * 16 + fr;
    const bf16_t* wsp = p.ws_bf + ((size_t)(l * 4 + g) * 128 + prow) * 128 + fq * 8;
    bf16x8 a[4];
#pragma unroll
    for (int ks = 0; ks < 4; ++ks) a[ks] = *(const bf16x8*)(wsp + ks * 32);
    f32x4 acc[8];
#pragma unroll
    for (int n = 0; n < 8; ++n) {
        acc[n] = (f32x4){0.f, 0.f, 0.f, 0.f};
        const int c = n * 16 + fr;
#pragma unroll
        for (int ks = 0; ks < 4; ++ks) {
            const bf16x8 bq = *(const LDSP bf16x8*)(smem + c * 256 + (((ks * 4 + fq) ^ (c & 15)) << 4));
            acc[n] = __builtin_amdgcn_mfma_f32_16x16x32_bf16(bq, a[ks], acc[n], 0, 0, 0);
        }
    }
    const float bs = p.b_spatial[(size_t)(l * 4 + g) * 128 + prow];
    const int row = T * 128 + prow;
    const bf16_t* up = p.U + (size_t)row * 1024 + g * 128 + fq * 4;
    bf16_t* mp = p.MIX + (size_t)row * DM + 512 + g * 128 + fq * 4;
#pragma unroll
    for (int n = 0; n < 8; ++n) {
        const u32x2 uu = *(const u32x2*)(up + n * 16);
        const float u0 = __uint_as_float(uu[0] << 16), u1 = __uint_as_float(uu[0] & 0xffff0000u), u2 = __uint_as_float(uu[1] << 16), u3 = __uint_as_float(uu[1] & 0xffff0000u);
        u32x2 w; w[0] = pk2((acc[n][0] + bs) * u0, (acc[n][1] + bs) * u1); w[1] = pk2((acc[n][2] + bs) * u2, (acc[n][3] + bs) * u3);
        *(u32x2*)(mp + n * 16) = w;
    }
    __syncthreads();
}

DI void mixer_phase(const Params& p, int l, ldsp_t smem) {
    const bool last = l == DEPTH - 1;
    for (int u = blockIdx.x; u < 512; u += gridDim.x) attn_unit(p, l, (u & 7) >> 1, u & 1, u >> 3, false, smem);
    if (!last)
        for (int u = blockIdx.x; u < 32; u += gridDim.x) attn_unit(p, l, (u & 7) >> 1, u & 1, u >> 3, true, smem);
    const int nT = last ? 128 : 136;
    for (int u = blockIdx.x; u < nT * 4; u += gridDim.x) gmlp_unit(p, l, u >> 2, u & 3, smem);
}

DI void grid_barrier(unsigned* ctr, unsigned target) {
    asm volatile("s_waitcnt vmcnt(0)" ::: "memory");
    __syncthreads();
    if (threadIdx.x == 0) {
        __builtin_amdgcn_fence(__ATOMIC_RELEASE, "agent");
        asm volatile("s_waitcnt vmcnt(0)" ::: "memory");
        __hip_atomic_fetch_add(ctr, 1u, __ATOMIC_RELAXED, __HIP_MEMORY_SCOPE_AGENT);
        unsigned sp = 0;
        while (__hip_atomic_load(ctr, __ATOMIC_RELAXED, __HIP_MEMORY_SCOPE_AGENT) < target) { __builtin_amdgcn_s_sleep(1); if (++sp > (1u << 22)) break; }
        __builtin_amdgcn_fence(__ATOMIC_ACQUIRE, "agent");
        asm volatile("s_waitcnt vmcnt(0)" ::: "memory");
    }
    __syncthreads();
}

constexpr int N_PHASES = 2 + DEPTH * 5;
DI void run_phase(const Params& p, int ph, ldsp_t smem) {
    if (ph == 0) { phase0(p, smem); return; }
    if (ph == 1) { phase1(p); return; }
    const int l = (ph - 2) / 5, k = (ph - 2) % 5;
    const bool last = l == DEPTH - 1;
    switch (k) {
        case 0: gemm_stream<0>(p, l, p.H, p.wt_in + (size_t)l * IN_DIM * DM, NTOK, IN_DIM, DM, smem); break;
        case 1: mixer_phase(p, l, smem); break;
        case 2: gemm_stream<1>(p, l, p.MIX, p.wt_out + (size_t)l * DM * DM, NLAT, DM, DM, smem);
                if (!last) ctx_tiles<1, 64, 8>(p, l, p.MIX + (size_t)NLAT * DM, p.wt_out + (size_t)l * DM * DM, DM, DM, smem);
                break;
        case 3: gemm_stream<2>(p, l, p.H, p.wt_ff1 + (size_t)l * FF * DM, NLAT, FF, DM, smem);
                if (!last) ctx_tiles<2, 128, 4>(p, l, p.H + (size_t)NLAT * DM, p.wt_ff1 + (size_t)l * FF * DM, FF, DM, smem);
                break;
        default: gemm_stream<3>(p, l, p.ACT, p.wt_ff2 + (size_t)l * DM * FF, NLAT, DM, FF, smem);
                if (!last) ctx_tiles<3, 64, 8>(p, l, p.ACT + (size_t)NLAT * FF, p.wt_ff2 + (size_t)l * DM * FF, DM, FF, smem);
                break;
    }
}

template <bool COOP>
__global__ void __launch_bounds__(512) mk_kernel(Params p, int ph_lo, int ph_hi) {
    __shared__ __attribute__((aligned(1024))) char smem_raw[2 * G_STAGE_B + 8192];
    ldsp_t smem = (ldsp_t)smem_raw;
    for (int ph = ph_lo; ph < ph_hi; ++ph) {
        run_phase(p, ph, smem);
#ifdef DUP_K
        if (ph > 1 && (ph - 2) % 5 == DUP_K) { cg::this_grid().sync(); run_phase(p, ph, smem); }
#endif
        if (COOP && ph + 1 < ph_hi) {
            if (ph == 0) cg::this_grid().sync();
            else grid_barrier(p.bar, (unsigned)ph * gridDim.x);
        }
    }
}

extern "C" void kernel_launch(void* const* d_in, const int* in_sizes, int n_in, void* d_out, int out_size, void* d_ws, size_t ws_size, hipStream_t stream) {
    Params p{};
    p.x = (const float*)d_in[0]; p.c = (const float*)d_in[1]; p.ctx = (const float*)d_in[2]; p.c_ctx = (const float*)d_in[3];
    p.w_mod = (const float*)d_in[4]; p.b_mod = (const float*)d_in[5]; p.norm1_g = (const float*)d_in[6]; p.w_in = (const float*)d_in[7];
    p.q_norm_g = (const float*)d_in[8]; p.k_norm_g = (const float*)d_in[9]; p.gmlp_norm_g = (const float*)d_in[10]; p.w_spatial = (const float*)d_in[11];
    p.b_spatial = (const float*)d_in[12]; p.w_out = (const float*)d_in[13]; p.norm2_g = (const float*)d_in[14]; p.w_ff1 = (const float*)d_in[15]; p.w_ff2 = (const float*)d_in[16];
    p.out = (float*)d_out;
    char* w = (char*)d_ws; size_t off = 0;
    auto take = [&](size_t bytes) { char* r = w + off; off += (bytes + 1023) & ~(size_t)1023; return r; };
    p.wt_in = (bf16_t*)take((size_t)DEPTH * IN_DIM * DM * 2);
    p.wt_out = (bf16_t*)take((size_t)DEPTH * DM * DM * 2);
    p.wt_ff1 = (bf16_t*)take((size_t)DEPTH * FF * DM * 2);
    p.wt_ff2 = (bf16_t*)take((size_t)DEPTH * FF * DM * 2);
    p.ws_bf = (bf16_t*)take((size_t)DEPTH * 4 * 128 * 128 * 2);
    p.mod = (float*)take((size_t)DEPTH * 5 * 6144 * 4);
    p.rope = (float*)take(2048 * 4);
    p.xc = (float*)take((size_t)NCTX * DM * 4);
    p.smax = (float*)take(1024);
    p.bar = (unsigned*)take(1024);
    p.ss = (float*)take((size_t)DEPTH * 2 * NTOK * 16 * 4);
    p.shw_in = (float*)take((size_t)DEPTH * 5 * IN_DIM * 4);
    p.shw_ff1 = (float*)take((size_t)DEPTH * 5 * FF * 4);
    p.H = (bf16_t*)take((size_t)NTOK * DM * 2);
    p.ACT = (bf16_t*)take((size_t)NTOK * FF * 2);
    {
        char* a = (char*)p.ACT; size_t o2 = 0;
        auto take2 = [&](size_t bytes) { char* r = a + o2; o2 += (bytes + 1023) & ~(size_t)1023; return r; };
        p.Q = (bf16_t*)take2((size_t)NLAT * 512 * 2);
        p.Qc = (bf16_t*)take2((size_t)NCTX * 512 * 2);
        p.K = (bf16_t*)take2((size_t)NB * 2 * NKEY * 64 * 2);
        p.Vt = (bf16_t*)take2((size_t)NB * 2 * NKEY * 64 * 2);
        p.U = (bf16_t*)take2((size_t)NTOK * 1024 * 2);
        p.MIX = (bf16_t*)take2((size_t)NTOK * DM * 2);
    }
    if (off > ws_size) { fprintf(stderr, "workspace too small: need %zu have %zu\n", off, ws_size); return; }
#if MK_COOP
    static int grid_blocks = 0;
    if (!grid_blocks) {
        int dev = 0, cus = 0, per_cu = 0;
        hipGetDevice(&dev);
        hipDeviceGetAttribute(&cus, hipDeviceAttributeMultiprocessorCount, dev);
        hipOccupancyMaxActiveBlocksPerMultiprocessor(&per_cu, mk_kernel<true>, 512, 0);
        if (per_cu < 1) per_cu = 1;
        grid_blocks = cus * 1;
    }
    int lo = 0, hi = N_PHASES;
    void* args[] = {&p, &lo, &hi};
    hipError_t e = hipLaunchCooperativeKernel((void*)mk_kernel<true>, dim3(grid_blocks), dim3(512), args, 0, stream);
    if (e != hipSuccess) fprintf(stderr, "cooperative launch failed: %s (grid %d)\n", hipGetErrorString(e), grid_blocks);
#else
    for (int ph = 0; ph < N_PHASES; ++ph) mk_kernel<false><<<256, 512, 0, stream>>>(p, ph, ph + 1);
#endif
}
```

```cpp
#include <hip/hip_runtime.h>
#include <hip/hip_cooperative_groups.h>
#include <stdint.h>
#include <cstdio>
namespace cg = cooperative_groups;

#ifndef MK_COOP
#define MK_COOP 1
#endif

#define DI __device__ __forceinline__
#define LDSP __attribute__((address_space(3)))
typedef LDSP char* ldsp_t;
typedef unsigned short bf16_t;
typedef short bf16x8 __attribute__((ext_vector_type(8)));
typedef float f32x2 __attribute__((ext_vector_type(2)));
typedef float f32x4 __attribute__((ext_vector_type(4)));
typedef float f32x16 __attribute__((ext_vector_type(16)));
typedef unsigned u32x2 __attribute__((ext_vector_type(2)));
typedef unsigned u32x4 __attribute__((ext_vector_type(4)));
typedef __bf16 bf2_t __attribute__((ext_vector_type(2)));

constexpr int DM = 1024, NB = 4, SEQ = 4096, DEPTH = 4, CTXL = 256;
constexpr int NLAT = NB * SEQ;
constexpr int NCTX = NB * CTXL;
constexpr int NTOK = NLAT + NCTX;
constexpr int IN_DIM = 1792, FF = 4096, NKEY = CTXL + SEQ;
constexpr float EPS = 1e-6f;
constexpr float LOG2E = 1.4426950408889634f;

struct Params {
    const float *x, *c, *ctx, *c_ctx, *w_mod, *b_mod, *norm1_g, *w_in, *q_norm_g, *k_norm_g, *gmlp_norm_g, *w_spatial, *b_spatial, *w_out, *norm2_g, *w_ff1, *w_ff2;
    float* out;
    bf16_t *wt_in, *wt_out, *wt_ff1, *wt_ff2, *ws_bf;
    float *mod, *rope, *xc, *smax, *ss, *shw_in, *shw_ff1;
    unsigned* bar;
    bf16_t *H, *Q, *Qc, *K, *Vt, *U, *MIX, *ACT;
};

DI unsigned pk2(float a, float b) { f32x2 v = {a, b}; bf2_t r = __builtin_convertvector(v, bf2_t); return __builtin_bit_cast(unsigned, r); }
DI bf16_t f2bf(float a) { return (bf16_t)(pk2(a, 0.f) & 0xffffu); }
DI float fexp2(float x) { return __builtin_amdgcn_exp2f(x); }
DI float gelu_tanh(float x) {
    const float y = 0.7978845608028654f * (x + 0.044715f * x * x * x);
    return x * __builtin_amdgcn_rcpf(1.f + fexp2(-2.f * LOG2E * y));
}
DI float* xrow_ptr(const Params& p, int row) { return row < NLAT ? p.out + (size_t)row * DM : p.xc + (size_t)(row - NLAT) * DM; }

DI void transpose_tile(const float* __restrict__ src, bf16_t* __restrict__ dst, int K, int N, int tk, int tn, ldsp_t smem) {
    LDSP float* t = (LDSP float*)smem;
    int tid = threadIdx.x;
    asm volatile("" : "+v"(tid));
    const int k0 = tk * 64, n0 = tn * 256;
    f32x4 v[8];
#pragma unroll
    for (int i = 0; i < 8; ++i) v[i] = *(const f32x4*)(src + (size_t)(k0 + (tid >> 6) + 8 * i) * N + n0 + (tid & 63) * 4);
#pragma unroll
    for (int i = 0; i < 8; ++i) {
        const int k = (tid >> 6) + 8 * i, n4 = (tid & 63) * 4;
        t[k * 257 + n4 + 0] = v[i][0]; t[k * 257 + n4 + 1] = v[i][1]; t[k * 257 + n4 + 2] = v[i][2]; t[k * 257 + n4 + 3] = v[i][3];
    }
    __syncthreads();
#pragma unroll
    for (int j = 0; j < 4; ++j) {
        const int n = (tid >> 3) + 64 * j, k8 = (tid & 7) * 8;
        u32x4 w;
        w[0] = pk2(t[(k8 + 0) * 257 + n], t[(k8 + 1) * 257 + n]);
        w[1] = pk2(t[(k8 + 2) * 257 + n], t[(k8 + 3) * 257 + n]);
        w[2] = pk2(t[(k8 + 4) * 257 + n], t[(k8 + 5) * 257 + n]);
        w[3] = pk2(t[(k8 + 6) * 257 + n], t[(k8 + 7) * 257 + n]);
        *(u32x4*)(dst + (size_t)(n0 + n) * K + k0 + k8) = w;
    }
    __syncthreads();
}

DI void mod_unit(const Params& p, int l, int cgi, ldsp_t smem) {
    LDSP float* s = (LDSP float*)smem;
    LDSP float* red = (LDSP float*)(smem + 20480);
    int tid = threadIdx.x;
    asm volatile("" : "+v"(tid));
    for (int i = tid; i < 5 * 1024; i += 512) {
        const int cnd = i >> 10, k = i & 1023;
        const float v = cnd < 4 ? p.c[cnd * 1024 + k] : p.c_ctx[k];
        s[i] = v / (1.f + fexp2(-LOG2E * v));
    }
    __syncthreads();
    const int c4 = tid & 15, ks = tid >> 4;
    f32x4 acc[5];
#pragma unroll
    for (int q = 0; q < 5; ++q) acc[q] = (f32x4){0.f, 0.f, 0.f, 0.f};
    const float* wp = p.w_mod + ((size_t)l * 1024 + ks * 32) * 6144 + cgi * 64 + c4 * 4;
#pragma unroll 8
    for (int kk = 0; kk < 32; ++kk) {
        const f32x4 w = *(const f32x4*)(wp + (size_t)kk * 6144);
        const int k = ks * 32 + kk;
#pragma unroll
        for (int q = 0; q < 5; ++q) acc[q] += w * s[q * 1024 + k];
    }
#pragma unroll
    for (int q = 0; q < 5; ++q)
#pragma unroll
        for (int j = 0; j < 4; ++j) red[(ks * 5 + q) * 64 + c4 * 4 + j] = acc[q][j];
    __syncthreads();
    if (tid < 320) {
        const int q = tid >> 6, col = tid & 63;
        float a = 0.f;
        for (int k2 = 0; k2 < 32; ++k2) a += red[(k2 * 5 + q) * 64 + col];
        const int j = cgi * 64 + col;
        p.mod[((size_t)l * 5 + q) * 6144 + j] = a + p.b_mod[(size_t)l * 6144 + j];
    }
    __syncthreads();
}

DI void phase0(const Params& p, ldsp_t smem) {
    constexpr int T_IN = 16 * 7, T_OUT = 16 * 4, T_FF1 = 16 * 16, T_FF2 = 64 * 4;
    constexpr int T_L = T_IN + T_OUT + T_FF1 + T_FF2;
    constexpr int U_T = DEPTH * T_L;
    constexpr int U_MOD = DEPTH * 96;
    constexpr int U_WS = 64;
    constexpr int U_ALL = U_MOD + U_T + U_WS + 1;
    for (int u = blockIdx.x; u < U_ALL; u += gridDim.x) {
        if (u < U_MOD) { mod_unit(p, u / 96, u % 96, smem); continue; }
        int v = u - U_MOD;
        if (v < U_T) {
            const int l = v / T_L; int r = v % T_L;
            if (r < T_IN) { transpose_tile(p.w_in + (size_t)l * DM * IN_DIM, p.wt_in + (size_t)l * IN_DIM * DM, DM, IN_DIM, r / 7, r % 7, smem); continue; }
            r -= T_IN;
            if (r < T_OUT) { transpose_tile(p.w_out + (size_t)l * DM * DM, p.wt_out + (size_t)l * DM * DM, DM, DM, r / 4, r % 4, smem); continue; }
            r -= T_OUT;
            if (r < T_FF1) { transpose_tile(p.w_ff1 + (size_t)l * DM * FF, p.wt_ff1 + (size_t)l * FF * DM, DM, FF, r / 16, r % 16, smem); continue; }
            r -= T_FF1;
            transpose_tile(p.w_ff2 + (size_t)l * FF * DM, p.wt_ff2 + (size_t)l * DM * FF, FF, DM, r / 4, r % 4, smem); continue;
        }
        v -= U_T;
        if (v < U_WS) {
            int tw = threadIdx.x;
            asm volatile("" : "+v"(tw));
            const size_t i = ((size_t)v * 512 + tw) * 8;
            const f32x4 a = *(const f32x4*)(p.w_spatial + i), b = *(const f32x4*)(p.w_spatial + i + 4);
            u32x4 w; w[0] = pk2(a[0], a[1]); w[1] = pk2(a[2], a[3]); w[2] = pk2(b[0], b[1]); w[3] = pk2(b[2], b[3]);
            *(u32x4*)(p.ws_bf + i) = w;
            continue;
        }
        int ti = threadIdx.x;
        asm volatile("" : "+v"(ti));
        if (ti == 64) *p.bar = 0u;
        if (ti < DEPTH) {
            float mq = 0.f, mk = 0.f;
            for (int i = 0; i < 64; ++i) { mq = fmaxf(mq, fabsf(p.q_norm_g[ti * 64 + i])); mk = fmaxf(mk, fabsf(p.k_norm_g[ti * 64 + i])); }
            p.smax[ti] = 8.f * mq * mk;
        }
        for (int i = ti; i < 1024; i += 512) {
            const int pos = i >> 4, f = i & 15;
            const float inv = fexp2(-(float)f * (13.287712379549449f / 16.f));
            const float rev = (float)pos * inv * 0.15915494309189535f;
            p.rope[i] = __builtin_amdgcn_cosf(rev);
            p.rope[1024 + i] = __builtin_amdgcn_sinf(rev);
        }
    }
}

DI void phase1(const Params& p) {
    int tid = threadIdx.x;
    asm volatile("" : "+v"(tid));
    const int lane = tid & 63, wid = tid >> 6;
    const int gw = blockIdx.x * 8 + wid, nw = gridDim.x * 8;
    for (int row = gw; row < NTOK; row += nw) {
        const float* src = row < NLAT ? p.x + (size_t)row * DM : p.ctx + (size_t)(row - NLAT) * DM;
        const int cond = row < NLAT ? (row >> 12) : 4;
        const float* mp = p.mod + ((size_t)cond) * 6144;
        f32x4 v[4];
        float ss = 0.f;
#pragma unroll
        for (int i = 0; i < 4; ++i) { v[i] = *(const f32x4*)(src + i * 256 + lane * 4); ss += v[i][0] * v[i][0] + v[i][1] * v[i][1] + v[i][2] * v[i][2] + v[i][3] * v[i][3]; }
#pragma unroll
        for (int o = 1; o < 64; o <<= 1) ss += __shfl_xor(ss, o);
        if (lane < 16) p.ss[(size_t)row * 16 + lane] = lane == 0 ? ss : 0.f;
        bf16_t* hp = p.H + (size_t)row * DM;
        float* xw = xrow_ptr(p, row);
#pragma unroll
        for (int i = 0; i < 4; ++i) {
            const int idx = i * 256 + lane * 4;
            const f32x4 gg = *(const f32x4*)(p.norm1_g + idx), sc = *(const f32x4*)(mp + DM + idx);
            f32x4 y;
#pragma unroll
            for (int j = 0; j < 4; ++j) y[j] = v[i][j] * gg[j] * (1.f + sc[j]);
            u32x2 w; w[0] = pk2(y[0], y[1]); w[1] = pk2(y[2], y[3]);
            *(u32x2*)(hp + idx) = w;
            *(f32x4*)(xw + idx) = v[i];
        }
    }
    {
        const int fr = lane & 15, fq = lane >> 4;
        constexpr int G_IN = IN_DIM / 16, G_FF = FF / 16, G_L = G_IN + G_FF;
        for (int gi = gw; gi < DEPTH * G_L; gi += nw) {
            const int l = gi / G_L, r = gi % G_L;
            const bool which = r >= G_IN;
            const int n0 = (which ? r - G_IN : r) * 16;
            const int N = which ? FF : IN_DIM;
            const bf16_t* W = (which ? p.wt_ff1 + (size_t)l * FF * DM : p.wt_in + (size_t)l * IN_DIM * DM) + (size_t)(n0 + fr) * DM + fq * 8;
            float* dst = which ? p.shw_ff1 + (size_t)l * 5 * FF : p.shw_in + (size_t)l * 5 * IN_DIM;
            const int c = fr < 5 ? fr : fr - 5;
            const float* sh = p.mod + ((size_t)l * 5 + (c < 5 ? c : 0)) * 6144 + (which ? 3 : 0) * DM + fq * 8;
            f32x4 acc = {0.f, 0.f, 0.f, 0.f};
#pragma unroll 8
            for (int ks = 0; ks < 32; ++ks) {
                const bf16x8 wv = *(const bf16x8*)(W + ks * 32);
                const f32x4 s0 = *(const f32x4*)(sh + ks * 32), s1 = *(const f32x4*)(sh + ks * 32 + 4);
                float sv[8] = {s0[0], s0[1], s0[2], s0[3], s1[0], s1[1], s1[2], s1[3]};
                u32x4 aw;
#pragma unroll
                for (int j = 0; j < 4; ++j) {
                    float a0 = sv[2 * j], a1 = sv[2 * j + 1];
                    const unsigned hi = pk2(a0, a1);
                    if (fr >= 5) { a0 -= __uint_as_float(hi << 16); a1 -= __uint_as_float(hi & 0xffff0000u); }
                    aw[j] = fr < 5 ? hi : (fr < 10 ? pk2(a0, a1) : 0u);
                }
                acc = __builtin_amdgcn_mfma_f32_16x16x32_bf16(__builtin_bit_cast(bf16x8, aw), wv, acc, 0, 0, 0);
            }
            const float r4 = __shfl(acc[0], fr + 16);
            const float r5 = __shfl(acc[1], fr + 16), r6 = __shfl(acc[2], fr + 16), r7 = __shfl(acc[3], fr + 16);
            const float r8 = __shfl(acc[0], fr + 32), r9 = __shfl(acc[1], fr + 32);
            if (fq == 0) {
                dst[(size_t)0 * N + n0 + fr] = acc[0] + r5;
                dst[(size_t)1 * N + n0 + fr] = acc[1] + r6;
                dst[(size_t)2 * N + n0 + fr] = acc[2] + r7;
                dst[(size_t)3 * N + n0 + fr] = acc[3] + r8;
                dst[(size_t)4 * N + n0 + fr] = r4 + r9;
            }
        }
    }
}

constexpr int G_TILE_B = 256 * 64 * 2, G_STAGE_B = 2 * G_TILE_B;
DI int lds_byte2(int r, int c) {
    const int st = (r >> 4) * 2 + (c >> 5), ob = (r & 15) * 64 + (c & 31) * 2;
    return st * 1024 + (ob ^ (((ob >> 9) & 1) << 5));
}
DI void stage_rc2(int b, int& R, int& C) {
    const int st = b >> 10, sb = b & 1023, swz = sb ^ (((sb >> 9) & 1) << 5);
    R = (st >> 1) * 16 + swz / 64;
    C = (st & 1) * 32 + (swz % 64) / 2;
}
template <int KS> DI int lds_byte_ks(int r, int c) {
    const int st = (r >> 4) * KS + (c >> 5), ob = (r & 15) * 64 + (c & 31) * 2;
    return st * 1024 + (ob ^ (((ob >> 9) & 1) << 5));
}
template <int KS> DI void stage_rc_ks(int b, int& R, int& C) {
    const int st = b >> 10, sb = b & 1023, swz = sb ^ (((sb >> 9) & 1) << 5);
    R = (st / KS) * 16 + swz / 64;
    C = (st % KS) * 32 + (swz % 64) / 2;
}
#define WAIT_V0() asm volatile("s_waitcnt vmcnt(0)" ::: "memory")

struct TileCtx { int brow, bcol, pn, wr, wc, fr, fq, wid, lane, l; };

DI void tile_coords(int L, int nM, int nN, int& pm, int& pn) {
    const int nwg = nM * nN;
    int wgid = L;
    { const int q = nwg / 8, r = nwg % 8, xcd = wgid % 8, off = wgid / 8; wgid = (xcd < r ? xcd * (q + 1) : r * (q + 1) + (xcd - r) * q) + off; }
    const int nig = 8 * nN, gid = wgid / nig, fm = gid * 8, gsz = (nM - fm) < 8 ? (nM - fm) : 8;
    pm = fm + ((wgid % nig) % gsz); pn = (wgid % nig) / gsz;
}

DI void wave_put(ldsp_t wb, int rowl, int n, int fq, u32x2 w) {
    const int chunk = n * 2 + (fq >> 1);
    *(LDSP u32x2*)(wb + rowl * 128 + ((chunk ^ (rowl & 7)) << 4) + (fq & 1) * 8) = w;
}
DI void wave_rows_store(ldsp_t wb, int lane, bf16_t* dst0, size_t ld) {
#pragma unroll
    for (int i = 0; i < 8; ++i) {
        const int row = i * 8 + (lane >> 3), ch = lane & 7;
        const u32x4 v = *(const LDSP u32x4*)(wb + row * 128 + ((ch ^ (row & 7)) << 4));
        *(u32x4*)(dst0 + (size_t)row * ld + ch * 8) = v;
    }
}

template <int EK> struct EpiResid {
    static DI void run(const f32x4 (&acc)[8][4], const TileCtx& tc, const Params& p, ldsp_t wb) {
        constexpr int GI = EK == 1 ? 2 : 5;
        const int cond = tc.brow < NLAT ? (tc.brow >> 12) : 4;
        const float* gate = p.mod + ((size_t)tc.l * 5 + cond) * 6144 + GI * DM;
        const int col0 = tc.bcol + tc.wc * 64 + tc.fq * 4;
        const bool has_next = EK == 1 || tc.l + 1 < DEPTH;
        const int ln = EK == 1 ? tc.l : (has_next ? tc.l + 1 : tc.l);
        const float* gnx = (EK == 1 ? p.norm2_g : p.norm1_g) + (size_t)ln * DM + col0;
        const float* scn = p.mod + ((size_t)ln * 5 + cond) * 6144 + (EK == 1 ? 4 : 1) * DM + col0;
        float* ssp = p.ss + (size_t)(ln * 2 + (EK == 1 ? 1 : 0)) * NTOK * 16 + (tc.bcol >> 8) * 4 + tc.wc;
        f32x4 gv[4], av[4];
#pragma unroll
        for (int n = 0; n < 4; ++n) {
            gv[n] = *(const f32x4*)(gate + col0 + n * 16);
            const f32x4 g1 = *(const f32x4*)(gnx + n * 16), s1 = *(const f32x4*)(scn + n * 16);
            av[n] = g1 * (1.f + s1);
        }
#pragma unroll
        for (int h = 0; h < 2; ++h) {
#pragma unroll
            for (int mm = 0; mm < 4; ++mm) { __builtin_amdgcn_sched_barrier(0);
                const int m = h * 4 + mm;
                const int row = tc.brow + tc.wr * 128 + m * 16 + tc.fr;
                float* xr = xrow_ptr(p, row) + col0;
                float part = 0.f;
#pragma unroll
                for (int n = 0; n < 4; ++n) {
                    f32x4 xv = *(const f32x4*)(xr + n * 16);
                    xv += gv[n] * acc[m][n];
                    *(f32x4*)(xr + n * 16) = xv;
                    if (has_next) {
                        part += xv[0] * xv[0] + xv[1] * xv[1] + xv[2] * xv[2] + xv[3] * xv[3];
                        const f32x4 hv = xv * av[n];
                        u32x2 w; w[0] = pk2(hv[0], hv[1]); w[1] = pk2(hv[2], hv[3]);
                        wave_put(wb, mm * 16 + tc.fr, n, tc.fq, w);
                    }
                }
                if (has_next) {
                    part += __shfl_xor(part, 16);
                    part += __shfl_xor(part, 32);
                    if (tc.fq == 0) ssp[(size_t)row * 16] = part;
                }
            }
            if (has_next) wave_rows_store(wb, tc.lane, p.H + (size_t)(tc.brow + tc.wr * 128 + h * 64) * DM + tc.bcol + tc.wc * 64, DM);
        }
    }
};
struct EpiFF1 {
    static DI void run(const f32x4 (&acc)[8][4], const TileCtx& tc, const Params& p, ldsp_t wb) {
#pragma unroll
        for (int h = 0; h < 2; ++h) {
#pragma unroll
            for (int mm = 0; mm < 4; ++mm) {
                const int m = h * 4 + mm;
#pragma unroll
                for (int n = 0; n < 4; ++n) {
                    f32x4 a = acc[m][n];
#pragma unroll
                    for (int j = 0; j < 4; ++j) { const float r = fmaxf(a[j], 0.f); a[j] = r * r; }
                    u32x2 w; w[0] = pk2(a[0], a[1]); w[1] = pk2(a[2], a[3]);
                    wave_put(wb, mm * 16 + tc.fr, n, tc.fq, w);
                }
            }
            wave_rows_store(wb, tc.lane, p.ACT + (size_t)(tc.brow + tc.wr * 128 + h * 64) * FF + tc.bcol + tc.wc * 64, FF);
        }
    }
};
template <int BRK> struct EpiIn {
    static DI void run(const f32x4 (&acc)[8][4], const TileCtx& tc, const Params& p, ldsp_t wb) {
        const int l = tc.l, pn = tc.pn, wc = tc.wc, fr = tc.fr, fq = tc.fq;
        if (BRK == 0 || (BRK == 1 && wc < 2)) {
            constexpr bool isq = BRK == 0;
            const int head = isq ? pn * 4 + wc : wc;
            const float* gn = (isq ? p.q_norm_g : p.k_norm_g) + l * 64;
            f32x4 gv[4];
#pragma unroll
            for (int n = 0; n < 4; ++n) gv[n] = *(const f32x4*)(gn + n * 16 + fq * 4);
            const float osc = isq ? 0.125f * LOG2E : 1.f;
            const bool lat = tc.brow < NLAT;
#pragma unroll
            for (int h = 0; h < 2; ++h) {
#pragma unroll
                for (int mm = 0; mm < 4; ++mm) { __builtin_amdgcn_sched_barrier(0);
                    const int m = h * 4 + mm;
                    const int row = tc.brow + tc.wr * 128 + m * 16 + fr;
                    float ss = 0.f;
#pragma unroll
                    for (int n = 0; n < 4; ++n)
#pragma unroll
                        for (int j = 0; j < 4; ++j) ss += acc[m][n][j] * acc[m][n][j];
                    ss += __shfl_xor(ss, 16);
                    ss += __shfl_xor(ss, 32);
                    const float rstd = rsqrtf(ss * (1.f / 64.f) + EPS) * osc;
                    const int t = row & 4095;
#pragma unroll
                    for (int ax = 0; ax < 2; ++ax) {
                        f32x4 x1 = acc[m][2 * ax] * rstd * gv[2 * ax], x2 = acc[m][2 * ax + 1] * rstd * gv[2 * ax + 1];
                        if (lat) {
                            const int pos = ax == 0 ? (t >> 6) : (t & 63);
                            const f32x4 cs = *(const f32x4*)(p.rope + pos * 16 + fq * 4), sn = *(const f32x4*)(p.rope + 1024 + pos * 16 + fq * 4);
                            const f32x4 o1 = x1 * cs - x2 * sn, o2 = x2 * cs + x1 * sn;
                            x1 = o1; x2 = o2;
                        }
                        u32x2 w; w[0] = pk2(x1[0], x1[1]); w[1] = pk2(x1[2], x1[3]);
                        wave_put(wb, mm * 16 + fr, 2 * ax, fq, w);
                        w[0] = pk2(x2[0], x2[1]); w[1] = pk2(x2[2], x2[3]);
                        wave_put(wb, mm * 16 + fr, 2 * ax + 1, fq, w);
                    }
                }
                const int row0 = tc.brow + tc.wr * 128 + h * 64;
                bf16_t* dst0;
                if (lat) {
                    const int b = row0 >> 12, t0 = row0 & 4095;
                    dst0 = isq ? p.Q + ((size_t)(b * 8 + head) * SEQ + t0) * 64 : p.K + ((size_t)(b * 2 + head) * NKEY + CTXL + t0) * 64;
                } else {
                    const int r2 = row0 - NLAT, b = r2 >> 8, t0 = r2 & 255;
                    dst0 = isq ? p.Qc + ((size_t)(b * 8 + head) * CTXL + t0) * 64 : p.K + ((size_t)(b * 2 + head) * NKEY + t0) * 64;
                }
                wave_rows_store(wb, tc.lane, dst0, 64);
            }
        } else if (BRK == 1) {
            const int kvh = wc - 2;
#pragma unroll
            for (int h = 0; h < 2; ++h) {
#pragma unroll
                for (int mm = 0; mm < 4; ++mm) {
                    const int m = h * 4 + mm;
                    const int key = mm * 16 + fr, k16 = key & 15;
                    const int kp = (key & ~15) | ((((k16 >> 2) & 1) << 3) + (k16 & 3) + ((k16 >> 3) << 2));
#pragma unroll
                    for (int n = 0; n < 4; ++n)
#pragma unroll
                        for (int j = 0; j < 4; ++j) {
                            const int d = n * 16 + fq * 4 + j;
                            *(LDSP bf16_t*)(wb + d * 128 + (((kp >> 3) ^ (d & 7)) << 4) + (kp & 7) * 2) = f2bf(acc[m][n][j]);
                        }
                }
                const int row0 = tc.brow + tc.wr * 128 + h * 64;
                int b, pos0;
                if (row0 < NLAT) { b = row0 >> 12; pos0 = CTXL + (row0 & 4095); } else { const int r2 = row0 - NLAT; b = r2 >> 8; pos0 = r2 & 255; }
                wave_rows_store(wb, tc.lane, p.Vt + (size_t)(b * 2 + kvh) * 64 * NKEY + pos0, NKEY);
            }
        } else if (BRK == 2) {
#pragma unroll
            for (int h = 0; h < 2; ++h) {
#pragma unroll
                for (int mm = 0; mm < 4; ++mm) {
                    const int m = h * 4 + mm;
#pragma unroll
                    for (int n = 0; n < 4; ++n) {
                        u32x2 w; w[0] = pk2(gelu_tanh(acc[m][n][0]), gelu_tanh(acc[m][n][1])); w[1] = pk2(gelu_tanh(acc[m][n][2]), gelu_tanh(acc[m][n][3]));
                        wave_put(wb, mm * 16 + fr, n, fq, w);
                    }
                }
                wave_rows_store(wb, tc.lane, p.U + (size_t)(tc.brow + tc.wr * 128 + h * 64) * 1024 + (pn - 3) * 256 + wc * 64, 1024);
            }
        }
    }
};

template <int EK>
DI void gemm_stream(const Params& p, int l, const bf16_t* __restrict__ A, const bf16_t* __restrict__ Bt, int M, int N, int K, ldsp_t shm) {
    const int nM = M / 256, nN = N / 256, nwg = nM * nN;
    int L = blockIdx.x;
    if (L >= nwg) return;
#define G_SA(b) (shm + (b) * G_STAGE_B)
#define G_SB(b) (shm + (b) * G_STAGE_B + G_TILE_B)
#define G_LANE_SETUP() \
    int tid_ = threadIdx.x; \
    asm volatile("" : "+v"(tid_));    \
    const int wid = tid_ >> 6, lane = tid_ & 63, wr = wid >> 2, wc = wid & 3, fr = lane & 15, fq = lane >> 4; \
    unsigned soff[4];        \
    _Pragma("unroll") for (int i = 0; i < 4; ++i) { int sR, sC; stage_rc2(wid * 1024 + i * 8192 + lane * 16, sR, sC); soff[i] = (unsigned)(sR * K + sC) * 2u; }
#define G_STAGE_A(Ap, buf, kt) do { const char* ab_ = (const char*)(Ap) + (size_t)(kt) * 128; \
      _Pragma("unroll") for (int i = 0; i < 4; ++i) \
        __builtin_amdgcn_global_load_lds((const unsigned*)(ab_ + soff[i]), (LDSP unsigned*)(G_SA(buf) + wid * 1024 + i * 8192), 16, 0, 0); } while (0)
#define G_STAGE_B(Bp, buf, kt) do { const char* bb_ = (const char*)(Bp) + (size_t)(kt) * 128; \
      _Pragma("unroll") for (int i = 0; i < 4; ++i) \
        __builtin_amdgcn_global_load_lds((const unsigned*)(bb_ + soff[i]), (LDSP unsigned*)(G_SB(buf) + wid * 1024 + i * 8192), 16, 0, 0); } while (0)
#define G_STAGE(Ap, Bp, buf, kt) do { const char* ab_ = (const char*)(Ap) + (size_t)(kt) * 128; const char* bb_ = (const char*)(Bp) + (size_t)(kt) * 128; \
      _Pragma("unroll") for (int i = 0; i < 4; ++i) { \
        __builtin_amdgcn_global_load_lds((const unsigned*)(ab_ + soff[i]), (LDSP unsigned*)(G_SA(buf) + wid * 1024 + i * 8192), 16, 0, 0); \
        __builtin_amdgcn_global_load_lds((const unsigned*)(bb_ + soff[i]), (LDSP unsigned*)(G_SB(buf) + wid * 1024 + i * 8192), 16, 0, 0); } } while (0)
    const int nt = K / 64;
    int pm, pn;
    tile_coords(L, nM, nN, pm, pn);
    const bf16_t* Ab = A + (size_t)pm * 256 * K;
    const bf16_t* Bb = Bt + (size_t)pn * 256 * K;
    { G_LANE_SETUP(); (void)wr; (void)wc; (void)fr; (void)fq; G_STAGE(Ab, Bb, 0, 0); WAIT_V0(); __syncthreads(); }
    while (true) {
        G_LANE_SETUP();
        const int aoff = lds_byte2(wr * 128 + fr, fq * 8), boff = lds_byte2(wc * 64 + fr, fq * 8);
        f32x4 acc[8][4];
#pragma unroll
        for (int m = 0; m < 8; ++m)
#pragma unroll
            for (int n = 0; n < 4; ++n) acc[m][n] = (f32x4){0.f, 0.f, 0.f, 0.f};
        const int Ln = L + gridDim.x;
        const bool has_next = Ln < nwg;
        int pm2 = pm, pn2 = pn;
        if (has_next) tile_coords(Ln, nM, nN, pm2, pn2);
        const bf16_t* Ab2 = A + (size_t)pm2 * 256 * K;
        const bf16_t* Bb2 = Bt + (size_t)pn2 * 256 * K;
        bf16x8 Aa[4], Ab_[4], Bk0[4], Bk1[4];
#define G_RDA(AF, buf, ks, mh) do { _Pragma("unroll") for (int m = 0; m < 4; ++m) AF[m] = *(const LDSP bf16x8*)(G_SA(buf) + aoff + ((mh) * 4 + m) * 2048 + (ks) * 1024); } while (0)
#define G_RDB(BF, buf, ks) do { _Pragma("unroll") for (int n = 0; n < 4; ++n) BF[n] = *(const LDSP bf16x8*)(G_SB(buf) + boff + n * 2048 + (ks) * 1024); } while (0)
#define G_MMA(AF, BF, mh) do { __builtin_amdgcn_s_setprio(1); \
            _Pragma("unroll") for (int m = 0; m < 4; ++m) _Pragma("unroll") for (int n = 0; n < 4; ++n) \
                acc[(mh) * 4 + m][n] = __builtin_amdgcn_mfma_f32_16x16x32_bf16(BF[n], AF[m], acc[(mh) * 4 + m][n], 0, 0, 0); \
            __builtin_amdgcn_s_setprio(0); } while (0)
#define G_SB0() __builtin_amdgcn_sched_barrier(0)
        for (int t = 0; t < nt; ++t) {
            const int cur = t & 1;
            G_RDA(Aa, cur, 0, 0); G_RDB(Bk0, cur, 0); G_SB0();
            if (t > 0) G_MMA(Ab_, Bk1, 1);
            G_SB0();
            if (t + 1 < nt) G_STAGE_A(Ab, cur ^ 1, t + 1);
            else if (has_next) G_STAGE_A(Ab2, cur ^ 1, 0);
            G_RDA(Ab_, cur, 0, 1); G_SB0();
            G_MMA(Aa, Bk0, 0); G_SB0();
            if (t + 1 < nt) G_STAGE_B(Bb, cur ^ 1, t + 1);
            else if (has_next) G_STAGE_B(Bb2, cur ^ 1, 0);
            G_RDA(Aa, cur, 1, 0); G_RDB(Bk1, cur, 1); G_SB0();
            G_MMA(Ab_, Bk0, 1); G_SB0();
            G_RDA(Ab_, cur, 1, 1); G_SB0();
            G_MMA(Aa, Bk1, 0); G_SB0();
            asm volatile("s_waitcnt lgkmcnt(0)" ::: "memory");
            WAIT_V0(); __syncthreads();
        }
        G_MMA(Ab_, Bk1, 1);
        G_SB0();
        {
            int tid2 = threadIdx.x, pme = pm, pne = pn;
            asm volatile("" : "+v"(tid2), "+s"(pme), "+s"(pne));
            TileCtx tc;
            tc.wid = tid2 >> 6; tc.lane = tid2 & 63; tc.wr = tc.wid >> 2; tc.wc = tc.wid & 3; tc.fr = tc.lane & 15; tc.fq = tc.lane >> 4; tc.l = l;
            tc.brow = pme * 256; tc.bcol = pne * 256; tc.pn = pne;
            ldsp_t ex = shm + G_STAGE_B + tc.wid * 8192;
            if (EK == 0 || EK == 2) {
                const int cond = tc.brow < NLAT ? (tc.brow >> 12) : 4;
                const float* ssp = p.ss + ((size_t)(l * 2 + (EK == 0 ? 0 : 1)) * NTOK + tc.brow + tc.wr * 128 + tc.fr) * 16 + tc.fq * 4;
                const float* shw = (EK == 0 ? p.shw_in + ((size_t)l * 5 + cond) * IN_DIM : p.shw_ff1 + ((size_t)l * 5 + cond) * FF) + tc.bcol + tc.wc * 64 + tc.fq * 4;
                f32x4 shv[4];
#pragma unroll
                for (int n = 0; n < 4; ++n) shv[n] = *(const f32x4*)(shw + n * 16);
#pragma unroll
                for (int m = 0; m < 8; ++m) {
                    const f32x4 pp = *(const f32x4*)(ssp + m * 256);
                    float sq = pp[0] + pp[1] + pp[2] + pp[3];
                    sq += __shfl_xor(sq, 16);
                    sq += __shfl_xor(sq, 32);
                    const float rstd = rsqrtf(sq * (1.f / DM) + EPS);
#pragma unroll
                    for (int n = 0; n < 4; ++n) acc[m][n] = acc[m][n] * rstd + shv[n];
                }
            }
            if (EK == 0) {
                if (pne < 2) EpiIn<0>::run(acc, tc, p, ex);
                else if (pne == 2) EpiIn<1>::run(acc, tc, p, ex);
                else EpiIn<2>::run(acc, tc, p, ex);
            } else if (EK == 1) EpiResid<1>::run(acc, tc, p, ex);
            else if (EK == 2) EpiFF1::run(acc, tc, p, ex);
            else EpiResid<3>::run(acc, tc, p, ex);
        }
        __syncthreads();
        if (!has_next) break;
        L = Ln; pm = pm2; pn = pn2; Ab = Ab2; Bb = Bb2;
    }
}

template <int EK>
DI void ctx_item(const Params& p, int l, int grow, int gcol, int slot, f32x4 s0, f32x4 s1, bool lead) {
    if (EK == 2) {
        const float* pp = p.ss + ((size_t)(l * 2 + 1) * NTOK + NLAT + grow) * 16;
        const f32x4 q0 = *(const f32x4*)pp, q1 = *(const f32x4*)(pp + 4), q2 = *(const f32x4*)(pp + 8), q3 = *(const f32x4*)(pp + 12);
        const f32x4 qs = q0 + q1 + q2 + q3;
        const float rstd = rsqrtf((qs[0] + qs[1] + qs[2] + qs[3]) * (1.f / DM) + EPS);
        const float* shw = p.shw_ff1 + ((size_t)l * 5 + 4) * FF + gcol;
        const f32x4 h0 = *(const f32x4*)shw, h1 = *(const f32x4*)(shw + 4);
        s0 = s0 * rstd + h0; s1 = s1 * rstd + h1;
#pragma unroll
        for (int j = 0; j < 4; ++j) { float r0 = fmaxf(s0[j], 0.f), r1 = fmaxf(s1[j], 0.f); s0[j] = r0 * r0; s1[j] = r1 * r1; }
        u32x4 w; w[0] = pk2(s0[0], s0[1]); w[1] = pk2(s0[2], s0[3]); w[2] = pk2(s1[0], s1[1]); w[3] = pk2(s1[2], s1[3]);
        *(u32x4*)(p.ACT + (size_t)(NLAT + grow) * FF + gcol) = w;
    } else {
        const float* gate = p.mod + ((size_t)l * 5 + 4) * 6144 + (EK == 1 ? 2 : 5) * DM + gcol;
        float* xr = p.xc + (size_t)grow * DM + gcol;
        const f32x4 g0 = *(const f32x4*)gate, g1 = *(const f32x4*)(gate + 4);
        f32x4 x0 = *(const f32x4*)xr, x1 = *(const f32x4*)(xr + 4);
        x0 += g0 * s0; x1 += g1 * s1;
        *(f32x4*)xr = x0; *(f32x4*)(xr + 4) = x1;
        const int ln = EK == 1 ? l : l + 1;
        const float* gnx = (EK == 1 ? p.norm2_g : p.norm1_g) + (size_t)ln * DM + gcol;
        const float* scn = p.mod + ((size_t)ln * 5 + 4) * 6144 + (EK == 1 ? 4 : 1) * DM + gcol;
        const f32x4 a0 = *(const f32x4*)gnx * (1.f + *(const f32x4*)scn), a1 = *(const f32x4*)(gnx + 4) * (1.f + *(const f32x4*)(scn + 4));
        const f32x4 y0 = x0 * a0, y1 = x1 * a1;
        u32x4 w; w[0] = pk2(y0[0], y0[1]); w[1] = pk2(y0[2], y0[3]); w[2] = pk2(y1[0], y1[1]); w[3] = pk2(y1[2], y1[3]);
        *(u32x4*)(p.H + (size_t)(NLAT + grow) * DM + gcol) = w;
        float part = x0[0] * x0[0] + x0[1] * x0[1] + x0[2] * x0[2] + x0[3] * x0[3] + x1[0] * x1[0] + x1[1] * x1[1] + x1[2] * x1[2] + x1[3] * x1[3];
        part += __shfl_xor(part, 1); part += __shfl_xor(part, 2); part += __shfl_xor(part, 4);
        if (lead) p.ss[((size_t)(ln * 2 + (EK == 1 ? 1 : 0)) * NTOK + NLAT + grow) * 16 + slot] = part;
    }
}

template <int EK, int TS, int KS>
DI void ctx_tiles(const Params& p, int l, const bf16_t* __restrict__ A, const bf16_t* __restrict__ Bt, int N, int K, ldsp_t shm) {
    constexpr int WM = TS / 2, WN = TS / 4, MT = WM / 16, NT = WN / 16, BKC = 32 * KS;
    constexpr int TILE_A = TS * BKC * 2, PP = TILE_A / 8192;
    const int ntn = N / TS, ntiles = (NCTX / TS) * ntn, nt = K / BKC;
    for (int u = blockIdx.x; u < ntiles; u += gridDim.x) {
        const int tm = u / ntn, tn = u % ntn;
        int tid = threadIdx.x;
        asm volatile("" : "+v"(tid));
        const int wid = tid >> 6, lane = tid & 63, wr = wid >> 2, wc = wid & 3, fr = lane & 15, fq = lane >> 4;
        unsigned soff[PP];
#pragma unroll
        for (int i = 0; i < PP; ++i) { int sR, sC; stage_rc_ks<KS>((wid * PP + i) * 1024 + lane * 16, sR, sC); soff[i] = (unsigned)(sR * K + sC) * 2u; }
        const bf16_t* Ab = A + (size_t)tm * TS * K;
        const bf16_t* Bb = Bt + (size_t)tn * TS * K;
#define C_STAGE(buf, kt) do { const char* ab_ = (const char*)Ab + (size_t)(kt) * (BKC * 2); const char* bb_ = (const char*)Bb + (size_t)(kt) * (BKC * 2); \
      _Pragma("unroll") for (int i = 0; i < PP; ++i) { \
        __builtin_amdgcn_global_load_lds((const unsigned*)(ab_ + soff[i]), (LDSP unsigned*)(shm + (buf) * 2 * TILE_A + (wid * PP + i) * 1024), 16, 0, 0); \
        __builtin_amdgcn_global_load_lds((const unsigned*)(bb_ + soff[i]), (LDSP unsigned*)(shm + (buf) * 2 * TILE_A + TILE_A + (wid * PP + i) * 1024), 16, 0, 0); } } while (0)
        f32x4 acc[MT][NT];
#pragma unroll
        for (int m = 0; m < MT; ++m)
#pragma unroll
            for (int n = 0; n < NT; ++n) acc[m][n] = (f32x4){0.f, 0.f, 0.f, 0.f};
        const int aoff = lds_byte_ks<KS>(wr * WM + fr, fq * 8), boff = lds_byte_ks<KS>(wc * WN + fr, fq * 8);
        C_STAGE(0, 0); WAIT_V0(); __syncthreads();
        for (int t = 0; t < nt; ++t) {
            const int cur = t & 1;
            if (t + 1 < nt) C_STAGE(cur ^ 1, t + 1);
            ldsp_t sa = shm + cur * 2 * TILE_A, sb = sa + TILE_A;
#pragma unroll
            for (int ks = 0; ks < KS; ++ks) {
                bf16x8 At[MT], Bf[NT];
#pragma unroll
                for (int m = 0; m < MT; ++m) At[m] = *(const LDSP bf16x8*)(sa + aoff + m * (KS * 1024) + ks * 1024);
#pragma unroll
                for (int n = 0; n < NT; ++n) Bf[n] = *(const LDSP bf16x8*)(sb + boff + n * (KS * 1024) + ks * 1024);
#pragma unroll
                for (int m = 0; m < MT; ++m)
#pragma unroll
                    for (int n = 0; n < NT; ++n) acc[m][n] = __builtin_amdgcn_mfma_f32_16x16x32_bf16(Bf[n], At[m], acc[m][n], 0, 0, 0);
            }
            WAIT_V0(); __syncthreads();
        }
#pragma unroll
        for (int m = 0; m < MT; ++m)
#pragma unroll
            for (int n = 0; n < NT; ++n) {
                const int row = wr * WM + m * 16 + fr, ch = (wc * WN + n * 16 + fq * 4) >> 2;
                *(LDSP f32x4*)(shm + row * (TS * 4) + ((ch ^ (row & 15)) << 4)) = acc[m][n];
            }
        __syncthreads();
#pragma unroll
        for (int it = 0; it < (TS * TS / 8) / 512; ++it) {
            const int item = it * 512 + tid, row = item / (TS / 8), c8 = item % (TS / 8);
            const f32x4 s0 = *(const LDSP f32x4*)(shm + row * (TS * 4) + (((2 * c8) ^ (row & 15)) << 4));
            const f32x4 s1 = *(const LDSP f32x4*)(shm + row * (TS * 4) + (((2 * c8 + 1) ^ (row & 15)) << 4));
            ctx_item<EK>(p, l, tm * TS + row, tn * TS + c8 * 8, tn, s0, s1, c8 == 0);
        }
        __syncthreads();
    }
}

DI void attn_unit(const Params& p, int l, int b, int kvh, int qb, bool isctx, ldsp_t smem) {
    int tid = threadIdx.x;
    asm volatile("" : "+v"(tid));
    const int wid = tid >> 6, lane = tid & 63, r = lane & 31, hh = lane >> 5;
    const int head = kvh * 4 + (wid >> 1);
    const int t0 = qb * 64 + (wid & 1) * 32;
    const int nkeys = isctx ? CTXL : NKEY;
    const bf16_t* Qp = isctx ? p.Qc + ((size_t)(b * 8 + head) * CTXL + t0) * 64 : p.Q + ((size_t)(b * 8 + head) * SEQ + t0) * 64;
    const bf16_t* Kp = p.K + (size_t)(b * 2 + kvh) * NKEY * 64;
    const bf16_t* Vp = p.Vt + (size_t)(b * 2 + kvh) * 64 * NKEY;
    const int orow = isctx ? NLAT + b * CTXL + t0 : b * SEQ + t0;
    bf16_t* Op = p.MIX + (size_t)orow * DM + head * 64;
    const float cexp = p.smax[l] * LOG2E;

    bf16x8 qf[4];
#pragma unroll
    for (int ks = 0; ks < 4; ++ks) qf[ks] = *(const bf16x8*)(Qp + (size_t)r * 64 + ks * 16 + 8 * hh);
    f32x16 o[2];
#pragma unroll
    for (int i = 0; i < 16; ++i) { o[0][i] = 0.f; o[1][i] = 0.f; }
    float rs0 = 0.f, rs1 = 0.f;

    const int srow = tid >> 3, sch = tid & 7;
    const int kdst = srow * 128 + ((sch ^ ((srow >> 1) & 7)) << 4);
    const bf16_t* kg = Kp + (size_t)srow * 64 + sch * 8;
    const bf16_t* vg = Vp + (size_t)srow * NKEY + sch * 8;
    const int rsw = (r >> 1) & 7;
    const int ntile = nkeys / 64;

#define ATT_QK(SD, kb) do { _Pragma("unroll") for (int kt = 0; kt < 2; ++kt) { \
        _Pragma("unroll") for (int i = 0; i < 16; ++i) SD[kt][i] = -cexp; \
        _Pragma("unroll") for (int ks = 0; ks < 4; ++ks) { \
            const bf16x8 a_ = *(const LDSP bf16x8*)((kb) + (kt * 32 + r) * 128 + (((ks * 2 + hh) ^ rsw) << 4)); \
            SD[kt] = __builtin_amdgcn_mfma_f32_32x32x16_bf16(a_, qf[ks], SD[kt], 0, 0, 0); } } } while (0)

    u32x4 kst, vst;
    f32x16 sA[2], sB[2];
    {
        kst = *(const u32x4*)kg;
        *(LDSP u32x4*)(smem + kdst) = kst;
        kst = *(const u32x4*)(kg + (size_t)64 * 64);
        vst = *(const u32x4*)vg;
        __syncthreads();
        ATT_QK(sA, smem);
        *(LDSP u32x4*)(smem + 8192 + kdst) = kst;
        *(LDSP u32x4*)(smem + 16384 + kdst) = vst;
    }
#define ATT_STEP(t, SC, SN) do { \
        const int par = (t) & 1; \
        __syncthreads(); \
        { const int t2_ = (t) + 2 < ntile ? (t) + 2 : ntile - 1, t1_ = (t) + 1 < ntile ? (t) + 1 : ntile - 1; \
          kst = *(const u32x4*)(kg + (size_t)t2_ * 64 * 64); vst = *(const u32x4*)(vg + t1_ * 64); } \
        bf16x8 kf[8], vf[4], vh[4]; \
        ldsp_t kb_ = smem + (par ^ 1) * 8192; ldsp_t vb_ = smem + 16384 + par * 8192; \
        _Pragma("unroll") for (int kt = 0; kt < 2; ++kt) _Pragma("unroll") for (int ks = 0; ks < 4; ++ks) \
            kf[kt * 4 + ks] = *(const LDSP bf16x8*)(kb_ + (kt * 32 + r) * 128 + (((ks * 2 + hh) ^ rsw) << 4)); \
        _Pragma("unroll") for (int c = 0; c < 2; ++c) _Pragma("unroll") for (int dt = 0; dt < 2; ++dt) \
            vf[c * 2 + dt] = *(const LDSP bf16x8*)(vb_ + (dt * 32 + r) * 128 + (((c * 2 + hh) ^ rsw) << 4)); \
        __builtin_amdgcn_sched_barrier(0); \
        _Pragma("unroll") for (int kt = 0; kt < 2; ++kt) _Pragma("unroll") for (int i = 0; i < 16; ++i) SN[kt][i] = -cexp;     \
        _Pragma("unroll") for (int ks = 0; ks < 4; ++ks) _Pragma("unroll") for (int kt = 0; kt < 2; ++kt) \
            SN[kt] = __builtin_amdgcn_mfma_f32_32x32x16_bf16(kf[kt * 4 + ks], qf[ks], SN[kt], 0, 0, 0); \
        _Pragma("unroll") for (int c = 2; c < 4; ++c) _Pragma("unroll") for (int dt = 0; dt < 2; ++dt) \
            vh[(c - 2) * 2 + dt] = *(const LDSP bf16x8*)(vb_ + (dt * 32 + r) * 128 + (((c * 2 + hh) ^ rsw) << 4)); \
        __builtin_amdgcn_sched_barrier(0); \
        _Pragma("unroll") for (int kt = 0; kt < 2; ++kt) { \
            _Pragma("unroll") for (int i = 0; i < 16; ++i) { \
                const float e_ = fexp2(SC[kt][i]); \
                if (i & 1) rs1 += e_; else rs0 += e_; \
                SC[kt][i] = e_; } } \
        _Pragma("unroll") for (int c = 0; c < 4; ++c) { \
            u32x4 pw; \
            pw[0] = pk2(SC[c >> 1][8 * (c & 1) + 0], SC[c >> 1][8 * (c & 1) + 1]); pw[1] = pk2(SC[c >> 1][8 * (c & 1) + 2], SC[c >> 1][8 * (c & 1) + 3]); \
            pw[2] = pk2(SC[c >> 1][8 * (c & 1) + 4], SC[c >> 1][8 * (c & 1) + 5]); pw[3] = pk2(SC[c >> 1][8 * (c & 1) + 6], SC[c >> 1][8 * (c & 1) + 7]); \
            const bf16x8 pb = __builtin_bit_cast(bf16x8, pw); \
            _Pragma("unroll") for (int dt = 0; dt < 2; ++dt) o[dt] = __builtin_amdgcn_mfma_f32_32x32x16_bf16(c < 2 ? vf[c * 2 + dt] : vh[(c - 2) * 2 + dt], pb, o[dt], 0, 0, 0); } \
        *(LDSP u32x4*)(smem + par * 8192 + kdst) = kst; \
        *(LDSP u32x4*)(smem + 16384 + (par ^ 1) * 8192 + kdst) = vst; \
    } while (0)

    for (int t = 0; t < ntile; t += 2) {
        ATT_STEP(t, sA, sB);
        ATT_STEP(t + 1, sB, sA);
    }
    const float lrun = rs0 + rs1;
    const float ltot = lrun + __shfl_xor(lrun, 32);
    const float inv = 1.f / ltot;
#pragma unroll
    for (int dt = 0; dt < 2; ++dt)
#pragma unroll
        for (int g4 = 0; g4 < 4; ++g4) {
            u32x2 w; w[0] = pk2(o[dt][4 * g4 + 0] * inv, o[dt][4 * g4 + 1] * inv); w[1] = pk2(o[dt][4 * g4 + 2] * inv, o[dt][4 * g4 + 3] * inv);
            *(u32x2*)(Op + (size_t)r * DM + dt * 32 + 8 * g4 + 4 * hh) = w;
        }
    __syncthreads();
}

DI void gmlp_unit(const Params& p, int l, int T, int g, ldsp_t smem) {
    int tid = threadIdx.x;
    asm volatile("" : "+v"(tid));
    const int wid = tid >> 6, lane = tid & 63, fr = lane & 15, fq = lane >> 4;
    {
        const int q = tid >> 2, part = tid & 3;
        const bf16_t* src = p.U + (size_t)(T * 128 + q) * 1024 + 512 + g * 128 + part * 32;
        u32x4 raw[4];
#pragma unroll
        for (int i = 0; i < 4; ++i) raw[i] = *(const u32x4*)(src + i * 8);
        float a = 0.f, b = 0.f;
#pragma unroll
        for (int i = 0; i < 4; ++i)
#pragma unroll
            for (int j = 0; j < 4; ++j) {
                const float lo = __uint_as_float(raw[i][j] << 16), hi = __uint_as_float(raw[i][j] & 0xffff0000u);
                a += lo + hi; b += lo * lo + hi * hi;
            }
        a += __shfl_xor(a, 1); a += __shfl_xor(a, 2);
        b += __shfl_xor(b, 1); b += __shfl_xor(b, 2);
        const float mean = a * (1.f / 128.f);
        const float rstd = rsqrtf(fmaxf(b * (1.f / 128.f) - mean * mean, 0.f) + EPS);
        const float* gn = p.gmlp_norm_g + l * 512 + g * 128 + part * 32;
#pragma unroll
        for (int i = 0; i < 4; ++i)
#pragma unroll
            for (int j = 0; j < 4; ++j) {
                const int c0 = part * 32 + i * 8 + j * 2;
                const float lo = __uint_as_float(raw[i][j] << 16), hi = __uint_as_float(raw[i][j] & 0xffff0000u);
                const unsigned w = pk2((lo - mean) * rstd * gn[i * 8 + j * 2], (hi - mean) * rstd * gn[i * 8 + j * 2 + 1]);
                *(LDSP bf16_t*)(smem + c0 * 256 + (((q >> 3) ^ (c0 & 15)) << 4) + (q & 7) * 2) = (bf16_t)(w & 0xffffu);
                *(LDSP bf16_t*)(smem + (c0 + 1) * 256 + (((q >> 3) ^ ((c0 + 1) & 15)) << 4) + (q & 7) * 2) = (bf16_t)(w >> 16);
            }
    }
    __syncthreads();
    const int prow = wid * 16 + fr;
    const bf16_t* wsp = p.ws_bf + ((size_t)(l * 4 + g) * 128 + prow) * 128 + fq * 8;
    bf16x8 a[4];
#pragma unroll
    for (int ks = 0; ks < 4; ++ks) a[ks] = *(const bf16x8*)(wsp + ks * 32);
    f32x4 acc[8];
#pragma unroll
    for (int n = 0; n < 8; ++n) {
        acc[n] = (f32x4){0.f, 0.f, 0.f, 0.f};
        const int c = n * 16 + fr;
#pragma unroll
        for (int ks = 0; ks < 4; ++ks) {
            const bf16x8 bq = *(const LDSP bf16x8*)(smem + c * 256 + (((ks * 4 + fq) ^ (c & 15)) << 4));
            acc[n] = __builtin_amdgcn_mfma_f32_16x16x32_bf16(bq, a[ks], acc[n], 0, 0, 0);
        }
    }
    const float bs = p.b_spatial[(size_t)(l * 4 + g) * 128 + prow];
    const int row = T * 128 + prow;
    const bf16_t* up = p.U + (size_t)row * 1024 + g * 128 + fq * 4;
    bf16_t* mp = p.MIX + (size_t)row * DM + 512 + g * 128 + fq * 4;
#pragma unroll
    for (int n = 0; n < 8; ++n) {
        const u32x2 uu = *(const u32x2*)(up + n * 16);
        const float u0 = __uint_as_float(uu[0] << 16), u1 = __uint_as_float(uu[0] & 0xffff0000u), u2 = __uint_as_float(uu[1] << 16), u3 = __uint_as_float(uu[1] & 0xffff0000u);
        u32x2 w; w[0] = pk2((acc[n][0] + bs) * u0, (acc[n][1] + bs) * u1); w[1] = pk2((acc[n][2] + bs) * u2, (acc[n][3] + bs) * u3);
        *(u32x2*)(mp + n * 16) = w;
    }
    __syncthreads();
}

DI void mixer_phase(const Params& p, int l, ldsp_t smem) {
    const bool last = l == DEPTH - 1;
    for (int u = blockIdx.x; u < 512; u += gridDim.x) attn_unit(p, l, (u & 7) >> 1, u & 1, u >> 3, false, smem);
    if (!last)
        for (int u = blockIdx.x; u < 32; u += gridDim.x) attn_unit(p, l, (u & 7) >> 1, u & 1, u >> 3, true, smem);
    const int nT = last ? 128 : 136;
    for (int u = blockIdx.x; u < nT * 4; u += gridDim.x) gmlp_unit(p, l, u >> 2, u & 3, smem);
}

DI void grid_barrier(unsigned* ctr, unsigned target) {
    asm volatile("s_waitcnt vmcnt(0)" ::: "memory");
    __syncthreads();
    if (threadIdx.x == 0) {
        __builtin_amdgcn_fence(__ATOMIC_RELEASE, "agent");
        asm volatile("s_waitcnt vmcnt(0)" ::: "memory");
        __hip_atomic_fetch_add(ctr, 1u, __ATOMIC_RELAXED, __HIP_MEMORY_SCOPE_AGENT);
        unsigned sp = 0;
        while (__hip_atomic_load(ctr, __ATOMIC_RELAXED, __HIP_MEMORY_SCOPE_AGENT) < target) { __builtin_amdgcn_s_sleep(1); if (++sp > (1u << 22)) break; }
        __builtin_amdgcn_fence(__ATOMIC_ACQUIRE, "agent");
        asm volatile("s_waitcnt vmcnt(0)" ::: "memory");
    }
    __syncthreads();
}

constexpr int N_PHASES = 2 + DEPTH * 5;
DI void run_phase(const Params& p, int ph, ldsp_t smem) {
    if (ph == 0) { phase0(p, smem); return; }
    if (ph == 1) { phase1(p); return; }
    const int l = (ph - 2) / 5, k = (ph - 2) % 5;
    const bool last = l == DEPTH - 1;
    switch (k) {
        case 0: gemm_stream<0>(p, l, p.H, p.wt_in + (size_t)l * IN_DIM * DM, NTOK, IN_DIM, DM, smem); break;
        case 1: mixer_phase(p, l, smem); break;
        case 2: gemm_stream<1>(p, l, p.MIX, p.wt_out + (size_t)l * DM * DM, NLAT, DM, DM, smem);
                if (!last) ctx_tiles<1, 64, 8>(p, l, p.MIX + (size_t)NLAT * DM, p.wt_out + (size_t)l * DM * DM, DM, DM, smem);
                break;
        case 3: gemm_stream<2>(p, l, p.H, p.wt_ff1 + (size_t)l * FF * DM, NLAT, FF, DM, smem);
                if (!last) ctx_tiles<2, 128, 4>(p, l, p.H + (size_t)NLAT * DM, p.wt_ff1 + (size_t)l * FF * DM, FF, DM, smem);
                break;
        default: gemm_stream<3>(p, l, p.ACT, p.wt_ff2 + (size_t)l * DM * FF, NLAT, DM, FF, smem);
                if (!last) ctx_tiles<3, 64, 8>(p, l, p.ACT + (size_t)NLAT * FF, p.wt_ff2 + (size_t)l * DM * FF, DM, FF, smem);
                break;
    }
}

template <bool COOP>
__global__ void __launch_bounds__(512) mk_kernel(Params p, int ph_lo, int ph_hi) {
    __shared__ __attribute__((aligned(1024))) char smem_raw[2 * G_STAGE_B + 8192];
    ldsp_t smem = (ldsp_t)smem_raw;
    for (int ph = ph_lo; ph < ph_hi; ++ph) {
        run_phase(p, ph, smem);
#ifdef DUP_K
        if (ph > 1 && (ph - 2) % 5 == DUP_K) { cg::this_grid().sync(); run_phase(p, ph, smem); }
#endif
        if (COOP && ph + 1 < ph_hi) {
            if (ph == 0) cg::this_grid().sync();
            else grid_barrier(p.bar, (unsigned)ph * gridDim.x);
        }
    }
}

extern "C" void kernel_launch(void* const* d_in, const int* in_sizes, int n_in, void* d_out, int out_size, void* d_ws, size_t ws_size, hipStream_t stream) {
    Params p{};
    p.x = (const float*)d_in[0]; p.c = (const float*)d_in[1]; p.ctx = (const float*)d_in[2]; p.c_ctx = (const float*)d_in[3];
    p.w_mod = (const float*)d_in[4]; p.b_mod = (const float*)d_in[5]; p.norm1_g = (const float*)d_in[6]; p.w_in = (const float*)d_in[7];
    p.q_norm_g = (const float*)d_in[8]; p.k_norm_g = (const float*)d_in[9]; p.gmlp_norm_g = (const float*)d_in[10]; p.w_spatial = (const float*)d_in[11];
    p.b_spatial = (const float*)d_in[12]; p.w_out = (const float*)d_in[13]; p.norm2_g = (const float*)d_in[14]; p.w_ff1 = (const float*)d_in[15]; p.w_ff2 = (const float*)d_in[16];
    p.out = (float*)d_out;
    char* w = (char*)d_ws; size_t off = 0;
    auto take = [&](size_t bytes) { char* r = w + off; off += (bytes + 1023) & ~(size_t)1023; return r; };
    p.wt_in = (bf16_t*)take((size_t)DEPTH * IN_DIM * DM * 2);
    p.wt_out = (bf16_t*)take((size_t)DEPTH * DM * DM * 2);
    p.wt_ff1 = (bf16_t*)take((size_t)DEPTH * FF * DM * 2);
    p.wt_ff2 = (bf16_t*)take((size_t)DEPTH * FF * DM * 2);
    p.ws_bf = (bf16_t*)take((size_t)DEPTH * 4 * 128 * 128 * 2);
    p.mod = (float*)take((size_t)DEPTH * 5 * 6144 * 4);
    p.rope = (float*)take(2048 * 4);
    p.xc = (float*)take((size_t)NCTX * DM * 4);
    p.smax = (float*)take(1024);
    p.bar = (unsigned*)take(1024);
    p.ss = (float*)take((size_t)DEPTH * 2 * NTOK * 16 * 4);
    p.shw_in = (float*)take((size_t)DEPTH * 5 * IN_DIM * 4);
    p.shw_ff1 = (float*)take((size_t)DEPTH * 5 * FF * 4);
    p.H = (bf16_t*)take((size_t)NTOK * DM * 2);
    p.ACT = (bf16_t*)take((size_t)NTOK * FF * 2);
    {
        char* a = (char*)p.ACT; size_t o2 = 0;
        auto take2 = [&](size_t bytes) { char* r = a + o2; o2 += (bytes + 1023) & ~(size_t)1023; return r; };
        p.Q = (bf16_t*)take2((size_t)NLAT * 512 * 2);
        p.Qc = (bf16_t*)take2((size_t)NCTX * 512 * 2);
        p.K = (bf16_t*)take2((size_t)NB * 2 * NKEY * 64 * 2);
        p.Vt = (bf16_t*)take2((size_t)NB * 2 * NKEY * 64 * 2);
        p.U = (bf16_t*)take2((size_t)NTOK * 1024 * 2);
        p.MIX = (bf16_t*)take2((size_t)NTOK * DM * 2);
    }
    if (off > ws_size) { fprintf(stderr, "workspace too small: need %zu have %zu\n", off, ws_size); return; }
#if MK_COOP
    static int grid_blocks = 0;
    if (!grid_blocks) {
        int dev = 0, cus = 0, per_cu = 0;
        hipGetDevice(&dev);
        hipDeviceGetAttribute(&cus, hipDeviceAttributeMultiprocessorCount, dev);
        hipOccupancyMaxActiveBlocksPerMultiprocessor(&per_cu, mk_kernel<true>, 512, 0);
        if (per_cu < 1) per_cu = 1;
        grid_blocks = cus * 1;
    }
    int lo = 0, hi = N_PHASES;
    void* args[] = {&p, &lo, &hi};
    hipError_t e = hipLaunchCooperativeKernel((void*)mk_kernel<true>, dim3(grid_blocks), dim3(512), args, 0, stream);
    if (e != hipSuccess) fprintf(stderr, "cooperative launch failed: %s (grid %d)\n", hipGetErrorString(e), grid_blocks);
#else
    for (int ph = 0; ph < N_PHASES; ++ph) mk_kernel<false><<<256, 512, 0, stream>>>(p, ph, ph + 1);
#endif
}
```

```cpp
#include <hip/hip_runtime.h>
#include <hip/hip_cooperative_groups.h>
#include <stdint.h>
#include <cstdio>
namespace cg = cooperative_groups;

#ifndef MK_COOP
#define MK_COOP 1
#endif

#define DI __device__ __forceinline__
#define LDSP __attribute__((address_space(3)))
typedef LDSP char* ldsp_t;
typedef unsigned short bf16_t;
typedef short bf16x8 __attribute__((ext_vector_type(8)));
typedef float f32x2 __attribute__((ext_vector_type(2)));
typedef float f32x4 __attribute__((ext_vector_type(4)));
typedef float f32x16 __attribute__((ext_vector_type(16)));
typedef unsigned u32x2 __attribute__((ext_vector_type(2)));
typedef unsigned u32x4 __attribute__((ext_vector_type(4)));
typedef __bf16 bf2_t __attribute__((ext_vector_type(2)));

constexpr int DM = 1024, NB = 4, SEQ = 4096, DEPTH = 4, CTXL = 256;
constexpr int NLAT = NB * SEQ;
constexpr int NCTX = NB * CTXL;
constexpr int NTOK = NLAT + NCTX;
constexpr int IN_DIM = 1792, FF = 4096, NKEY = CTXL + SEQ;
constexpr float EPS = 1e-6f;
constexpr float LOG2E = 1.4426950408889634f;

struct Params {
    const float *x, *c, *ctx, *c_ctx, *w_mod, *b_mod, *norm1_g, *w_in, *q_norm_g, *k_norm_g, *gmlp_norm_g, *w_spatial, *b_spatial, *w_out, *norm2_g, *w_ff1, *w_ff2;
    float* out;
    bf16_t *wt_in, *wt_out, *wt_ff1, *wt_ff2, *ws_bf;
    float *mod, *rope, *xc, *smax, *ss, *shw_in, *shw_ff1;
    unsigned* bar;
    bf16_t *H, *Q, *Qc, *K, *Vt, *U, *MIX, *ACT;
};

DI unsigned pk2(float a, float b) { f32x2 v = {a, b}; bf2_t r = __builtin_convertvector(v, bf2_t); return __builtin_bit_cast(unsigned, r); }
DI bf16_t f2bf(float a) { return (bf16_t)(pk2(a, 0.f) & 0xffffu); }
DI float fexp2(float x) { return __builtin_amdgcn_exp2f(x); }
DI float gelu_tanh(float x) {
    const float y = 0.7978845608028654f * (x + 0.044715f * x * x * x);
    return x * __builtin_amdgcn_rcpf(1.f + fexp2(-2.f * LOG2E * y));
}
DI float* xrow_ptr(const Params& p, int row) { return row < NLAT ? p.out + (size_t)row * DM : p.xc + (size_t)(row - NLAT) * DM; }

DI void transpose_tile(const float* __restrict__ src, bf16_t* __restrict__ dst, int K, int N, int tk, int tn, ldsp_t smem) {
    LDSP float* t = (LDSP float*)smem;
    int tid = threadIdx.x;
    asm volatile("" : "+v"(tid));
    const int k0 = tk * 64, n0 = tn * 256;
    f32x4 v[8];
#pragma unroll
    for (int i = 0; i < 8; ++i) v[i] = *(const f32x4*)(src + (size_t)(k0 + (tid >> 6) + 8 * i) * N + n0 + (tid & 63) * 4);
#pragma unroll
    for (int i = 0; i < 8; ++i) {
        const int k = (tid >> 6) + 8 * i, n4 = (tid & 63) * 4;
        t[k * 257 + n4 + 0] = v[i][0]; t[k * 257 + n4 + 1] = v[i][1]; t[k * 257 + n4 + 2] = v[i][2]; t[k * 257 + n4 + 3] = v[i][3];
    }
    __syncthreads();
#pragma unroll
    for (int j = 0; j < 4; ++j) {
        const int n = (tid >> 3) + 64 * j, k8 = (tid & 7) * 8;
        u32x4 w;
        w[0] = pk2(t[(k8 + 0) * 257 + n], t[(k8 + 1) * 257 + n]);
        w[1] = pk2(t[(k8 + 2) * 257 + n], t[(k8 + 3) * 257 + n]);
        w[2] = pk2(t[(k8 + 4) * 257 + n], t[(k8 + 5) * 257 + n]);
        w[3] = pk2(t[(k8 + 6) * 257 + n], t[(k8 + 7) * 257 + n]);
        *(u32x4*)(dst + (size_t)(n0 + n) * K + k0 + k8) = w;
    }
    __syncthreads();
}

DI void mod_unit(const Params& p, int l, int cgi, ldsp_t smem) {
    LDSP float* s = (LDSP float*)smem;
    LDSP float* red = (LDSP float*)(smem + 20480);
    int tid = threadIdx.x;
    asm volatile("" : "+v"(tid));
    for (int i = tid; i < 5 * 1024; i += 512) {
        const int cnd = i >> 10, k = i & 1023;
        const float v = cnd < 4 ? p.c[cnd * 1024 + k] : p.c_ctx[k];
        s[i] = v / (1.f + fexp2(-LOG2E * v));
    }
    __syncthreads();
    const int c4 = tid & 15, ks = tid >> 4;
    f32x4 acc[5];
#pragma unroll
    for (int q = 0; q < 5; ++q) acc[q] = (f32x4){0.f, 0.f, 0.f, 0.f};
    const float* wp = p.w_mod + ((size_t)l * 1024 + ks * 32) * 6144 + cgi * 64 + c4 * 4;
#pragma unroll 8
    for (int kk = 0; kk < 32; ++kk) {
        const f32x4 w = *(const f32x4*)(wp + (size_t)kk * 6144);
        const int k = ks * 32 + kk;
#pragma unroll
        for (int q = 0; q < 5; ++q) acc[q] += w * s[q * 1024 + k];
    }
#pragma unroll
    for (int q = 0; q < 5; ++q)
#pragma unroll
        for (int j = 0; j < 4; ++j) red[(ks * 5 + q) * 64 + c4 * 4 + j] = acc[q][j];
    __syncthreads();
    if (tid < 320) {
        const int q = tid >> 6, col = tid & 63;
        float a = 0.f;
        for (int k2 = 0; k2 < 32; ++k2) a += red[(k2 * 5 + q) * 64 + col];
        const int j = cgi * 64 + col;
        p.mod[((size_t)l * 5 + q) * 6144 + j] = a + p.b_mod[(size_t)l * 6144 + j];
    }
    __syncthreads();
}

DI void phase0(const Params& p, ldsp_t smem) {
    constexpr int T_IN = 16 * 7, T_OUT = 16 * 4, T_FF1 = 16 * 16, T_FF2 = 64 * 4;
    constexpr int T_L = T_IN + T_OUT + T_FF1 + T_FF2;
    constexpr int U_T = DEPTH * T_L;
    constexpr int U_MOD = DEPTH * 96;
    constexpr int U_WS = 64;
    constexpr int U_ALL = U_MOD + U_T + U_WS + 1;
    for (int u = blockIdx.x; u < U_ALL; u += gridDim.x) {
        if (u < U_MOD) { mod_unit(p, u / 96, u % 96, smem); continue; }
        int v = u - U_MOD;
        if (v < U_T) {
            const int l = v / T_L; int r = v % T_L;
            if (r < T_IN) { transpose_tile(p.w_in + (size_t)l * DM * IN_DIM, p.wt_in + (size_t)l * IN_DIM * DM, DM, IN_DIM, r / 7, r % 7, smem); continue; }
            r -= T_IN;
            if (r < T_OUT) { transpose_tile(p.w_out + (size_t)l * DM * DM, p.wt_out + (size_t)l * DM * DM, DM, DM, r / 4, r % 4, smem); continue; }
            r -= T_OUT;
            if (r < T_FF1) { transpose_tile(p.w_ff1 + (size_t)l * DM * FF, p.wt_ff1 + (size_t)l * FF * DM, DM, FF, r / 16, r % 16, smem); continue; }
            r -= T_FF1;
            transpose_tile(p.w_ff2 + (size_t)l * FF * DM, p.wt_ff2 + (size_t)l * DM * FF, FF, DM, r / 4, r % 4, smem); continue;
        }
        v -= U_T;
        if (v < U_WS) {
            int tw = threadIdx.x;
            asm volatile("" : "+v"(tw));
            const size_t i = ((size_t)v * 512 + tw) * 8;
            const f32x4 a = *(const f32x4*)(p.w_spatial + i), b = *(const f32x4*)(p.w_spatial + i + 4);
            u32x4 w; w[0] = pk2(a[0], a[1]); w[1] = pk2(a[2], a[3]); w[2] = pk2(b[0], b[1]); w[3] = pk2(b[2], b[3]);
            *(u32x4*)(p.ws_bf + i) = w;
            continue;
        }
        int ti = threadIdx.x;
        asm volatile("" : "+v"(ti));
        if (ti >= 64 && ti < 64 + 9) p.bar[(ti - 64) * 64] = 0u;
        if (ti < DEPTH) {
            float mq = 0.f, mk = 0.f;
            for (int i = 0; i < 64; ++i) { mq = fmaxf(mq, fabsf(p.q_norm_g[ti * 64 + i])); mk = fmaxf(mk, fabsf(p.k_norm_g[ti * 64 + i])); }
            p.smax[ti] = 8.f * mq * mk;
        }
        for (int i = ti; i < 1024; i += 512) {
            const int pos = i >> 4, f = i & 15;
            const float inv = fexp2(-(float)f * (13.287712379549449f / 16.f));
            const float rev = (float)pos * inv * 0.15915494309189535f;
            p.rope[i] = __builtin_amdgcn_cosf(rev);
            p.rope[1024 + i] = __builtin_amdgcn_sinf(rev);
        }
    }
}

DI void phase1(const Params& p) {
    int tid = threadIdx.x;
    asm volatile("" : "+v"(tid));
    const int lane = tid & 63, wid = tid >> 6;
    const int gw = blockIdx.x * 8 + wid, nw = gridDim.x * 8;
    for (int row = gw; row < NTOK; row += nw) {
        const float* src = row < NLAT ? p.x + (size_t)row * DM : p.ctx + (size_t)(row - NLAT) * DM;
        const int cond = row < NLAT ? (row >> 12) : 4;
        const float* mp = p.mod + ((size_t)cond) * 6144;
        f32x4 v[4];
        float ss = 0.f;
#pragma unroll
        for (int i = 0; i < 4; ++i) { v[i] = *(const f32x4*)(src + i * 256 + lane * 4); ss += v[i][0] * v[i][0] + v[i][1] * v[i][1] + v[i][2] * v[i][2] + v[i][3] * v[i][3]; }
#pragma unroll
        for (int o = 1; o < 64; o <<= 1) ss += __shfl_xor(ss, o);
        if (lane < 16) p.ss[(size_t)row * 16 + lane] = lane == 0 ? ss : 0.f;
        bf16_t* hp = p.H + (size_t)row * DM;
        float* xw = xrow_ptr(p, row);
#pragma unroll
        for (int i = 0; i < 4; ++i) {
            const int idx = i * 256 + lane * 4;
            const f32x4 gg = *(const f32x4*)(p.norm1_g + idx), sc = *(const f32x4*)(mp + DM + idx);
            f32x4 y;
#pragma unroll
            for (int j = 0; j < 4; ++j) y[j] = v[i][j] * gg[j] * (1.f + sc[j]);
            u32x2 w; w[0] = pk2(y[0], y[1]); w[1] = pk2(y[2], y[3]);
            *(u32x2*)(hp + idx) = w;
            *(f32x4*)(xw + idx) = v[i];
        }
    }
    {
        const int fr = lane & 15, fq = lane >> 4;
        constexpr int G_IN = IN_DIM / 16, G_FF = FF / 16, G_L = G_IN + G_FF;
        for (int gi = gw; gi < DEPTH * G_L; gi += nw) {
            const int l = gi / G_L, r = gi % G_L;
            const bool which = r >= G_IN;
            const int n0 = (which ? r - G_IN : r) * 16;
            const int N = which ? FF : IN_DIM;
            const bf16_t* W = (which ? p.wt_ff1 + (size_t)l * FF * DM : p.wt_in + (size_t)l * IN_DIM * DM) + (size_t)(n0 + fr) * DM + fq * 8;
            float* dst = which ? p.shw_ff1 + (size_t)l * 5 * FF : p.shw_in + (size_t)l * 5 * IN_DIM;
            const int c = fr < 5 ? fr : fr - 5;
            const float* sh = p.mod + ((size_t)l * 5 + (c < 5 ? c : 0)) * 6144 + (which ? 3 : 0) * DM + fq * 8;
            f32x4 acc = {0.f, 0.f, 0.f, 0.f};
#pragma unroll 8
            for (int ks = 0; ks < 32; ++ks) {
                const bf16x8 wv = *(const bf16x8*)(W + ks * 32);
                const f32x4 s0 = *(const f32x4*)(sh + ks * 32), s1 = *(const f32x4*)(sh + ks * 32 + 4);
                float sv[8] = {s0[0], s0[1], s0[2], s0[3], s1[0], s1[1], s1[2], s1[3]};
                u32x4 aw;
#pragma unroll
                for (int j = 0; j < 4; ++j) {
                    float a0 = sv[2 * j], a1 = sv[2 * j + 1];
                    const unsigned hi = pk2(a0, a1);
                    if (fr >= 5) { a0 -= __uint_as_float(hi << 16); a1 -= __uint_as_float(hi & 0xffff0000u); }
                    aw[j] = fr < 5 ? hi : (fr < 10 ? pk2(a0, a1) : 0u);
                }
                acc = __builtin_amdgcn_mfma_f32_16x16x32_bf16(__builtin_bit_cast(bf16x8, aw), wv, acc, 0, 0, 0);
            }
            const float r4 = __shfl(acc[0], fr + 16);
            const float r5 = __shfl(acc[1], fr + 16), r6 = __shfl(acc[2], fr + 16), r7 = __shfl(acc[3], fr + 16);
            const float r8 = __shfl(acc[0], fr + 32), r9 = __shfl(acc[1], fr + 32);
            if (fq == 0) {
                dst[(size_t)0 * N + n0 + fr] = acc[0] + r5;
                dst[(size_t)1 * N + n0 + fr] = acc[1] + r6;
                dst[(size_t)2 * N + n0 + fr] = acc[2] + r7;
                dst[(size_t)3 * N + n0 + fr] = acc[3] + r8;
                dst[(size_t)4 * N + n0 + fr] = r4 + r9;
            }
        }
    }
}

constexpr int G_TILE_B = 256 * 64 * 2, G_STAGE_B = 2 * G_TILE_B;
DI int lds_byte2(int r, int c) {
    const int st = (r >> 4) * 2 + (c >> 5), ob = (r & 15) * 64 + (c & 31) * 2;
    return st * 1024 + (ob ^ (((ob >> 9) & 1) << 5));
}
DI void stage_rc2(int b, int& R, int& C) {
    const int st = b >> 10, sb = b & 1023, swz = sb ^ (((sb >> 9) & 1) << 5);
    R = (st >> 1) * 16 + swz / 64;
    C = (st & 1) * 32 + (swz % 64) / 2;
}
template <int KS> DI int lds_byte_ks(int r, int c) {
    const int st = (r >> 4) * KS + (c >> 5), ob = (r & 15) * 64 + (c & 31) * 2;
    return st * 1024 + (ob ^ (((ob >> 9) & 1) << 5));
}
template <int KS> DI void stage_rc_ks(int b, int& R, int& C) {
    const int st = b >> 10, sb = b & 1023, swz = sb ^ (((sb >> 9) & 1) << 5);
    R = (st / KS) * 16 + swz / 64;
    C = (st % KS) * 32 + (swz % 64) / 2;
}
#define WAIT_V0() asm volatile("s_waitcnt vmcnt(0)" ::: "memory")

struct TileCtx { int brow, bcol, pn, wr, wc, fr, fq, wid, lane, l; };

DI void tile_coords(int L, int nM, int nN, int& pm, int& pn) {
    const int nwg = nM * nN;
    int wgid = L;
    { const int q = nwg / 8, r = nwg % 8, xcd = wgid % 8, off = wgid / 8; wgid = (xcd < r ? xcd * (q + 1) : r * (q + 1) + (xcd - r) * q) + off; }
    const int nig = 8 * nN, gid = wgid / nig, fm = gid * 8, gsz = (nM - fm) < 8 ? (nM - fm) : 8;
    pm = fm + ((wgid % nig) % gsz); pn = (wgid % nig) / gsz;
}

DI void wave_put(ldsp_t wb, int rowl, int n, int fq, u32x2 w) {
    const int chunk = n * 2 + (fq >> 1);
    *(LDSP u32x2*)(wb + rowl * 128 + ((chunk ^ (rowl & 7)) << 4) + (fq & 1) * 8) = w;
}
DI void wave_rows_store(ldsp_t wb, int lane, bf16_t* dst0, size_t ld) {
#pragma unroll
    for (int i = 0; i < 8; ++i) {
        const int row = i * 8 + (lane >> 3), ch = lane & 7;
        const u32x4 v = *(const LDSP u32x4*)(wb + row * 128 + ((ch ^ (row & 7)) << 4));
        *(u32x4*)(dst0 + (size_t)row * ld + ch * 8) = v;
    }
}

template <int EK> struct EpiResid {
    static DI void run(const f32x4 (&acc)[8][4], const TileCtx& tc, const Params& p, ldsp_t wb) {
        constexpr int GI = EK == 1 ? 2 : 5;
        const int cond = tc.brow < NLAT ? (tc.brow >> 12) : 4;
        const float* gate = p.mod + ((size_t)tc.l * 5 + cond) * 6144 + GI * DM;
        const int col0 = tc.bcol + tc.wc * 64 + tc.fq * 4;
        const bool has_next = EK == 1 || tc.l + 1 < DEPTH;
        const int ln = EK == 1 ? tc.l : (has_next ? tc.l + 1 : tc.l);
        const float* gnx = (EK == 1 ? p.norm2_g : p.norm1_g) + (size_t)ln * DM + col0;
        const float* scn = p.mod + ((size_t)ln * 5 + cond) * 6144 + (EK == 1 ? 4 : 1) * DM + col0;
        float* ssp = p.ss + (size_t)(ln * 2 + (EK == 1 ? 1 : 0)) * NTOK * 16 + (tc.bcol >> 8) * 4 + tc.wc;
        f32x4 gv[4], av[4];
#pragma unroll
        for (int n = 0; n < 4; ++n) {
            gv[n] = *(const f32x4*)(gate + col0 + n * 16);
            const f32x4 g1 = *(const f32x4*)(gnx + n * 16), s1 = *(const f32x4*)(scn + n * 16);
            av[n] = g1 * (1.f + s1);
        }
#pragma unroll
        for (int h = 0; h < 2; ++h) {
#pragma unroll
            for (int mm = 0; mm < 4; ++mm) { __builtin_amdgcn_sched_barrier(0);
                const int m = h * 4 + mm;
                const int row = tc.brow + tc.wr * 128 + m * 16 + tc.fr;
                float* xr = xrow_ptr(p, row) + col0;
                float part = 0.f;
#pragma unroll
                for (int n = 0; n < 4; ++n) {
                    f32x4 xv = *(const f32x4*)(xr + n * 16);
                    xv += gv[n] * acc[m][n];
                    *(f32x4*)(xr + n * 16) = xv;
                    if (has_next) {
                        part += xv[0] * xv[0] + xv[1] * xv[1] + xv[2] * xv[2] + xv[3] * xv[3];
                        const f32x4 hv = xv * av[n];
                        u32x2 w; w[0] = pk2(hv[0], hv[1]); w[1] = pk2(hv[2], hv[3]);
                        wave_put(wb, mm * 16 + tc.fr, n, tc.fq, w);
                    }
                }
                if (has_next) {
                    part += __shfl_xor(part, 16);
                    part += __shfl_xor(part, 32);
                    if (tc.fq == 0) ssp[(size_t)row * 16] = part;
                }
            }
            if (has_next) wave_rows_store(wb, tc.lane, p.H + (size_t)(tc.brow + tc.wr * 128 + h * 64) * DM + tc.bcol + tc.wc * 64, DM);
        }
    }
};
struct EpiFF1 {
    static DI void run(const f32x4 (&acc)[8][4], const TileCtx& tc, const Params& p, ldsp_t wb) {
#pragma unroll
        for (int h = 0; h < 2; ++h) {
#pragma unroll
            for (int mm = 0; mm < 4; ++mm) {
                const int m = h * 4 + mm;
#pragma unroll
                for (int n = 0; n < 4; ++n) {
                    f32x4 a = acc[m][n];
#pragma unroll
                    for (int j = 0; j < 4; ++j) { const float r = fmaxf(a[j], 0.f); a[j] = r * r; }
                    u32x2 w; w[0] = pk2(a[0], a[1]); w[1] = pk2(a[2], a[3]);
                    wave_put(wb, mm * 16 + tc.fr, n, tc.fq, w);
                }
            }
            wave_rows_store(wb, tc.lane, p.ACT + (size_t)(tc.brow + tc.wr * 128 + h * 64) * FF + tc.bcol + tc.wc * 64, FF);
        }
    }
};
template <int BRK> struct EpiIn {
    static DI void run(const f32x4 (&acc)[8][4], const TileCtx& tc, const Params& p, ldsp_t wb) {
        const int l = tc.l, pn = tc.pn, wc = tc.wc, fr = tc.fr, fq = tc.fq;
        if (BRK == 0 || (BRK == 1 && wc < 2)) {
            constexpr bool isq = BRK == 0;
            const int head = isq ? pn * 4 + wc : wc;
            const float* gn = (isq ? p.q_norm_g : p.k_norm_g) + l * 64;
            f32x4 gv[4];
#pragma unroll
            for (int n = 0; n < 4; ++n) gv[n] = *(const f32x4*)(gn + n * 16 + fq * 4);
            const float osc = isq ? 0.125f * LOG2E : 1.f;
            const bool lat = tc.brow < NLAT;
#pragma unroll
            for (int h = 0; h < 2; ++h) {
#pragma unroll
                for (int mm = 0; mm < 4; ++mm) { __builtin_amdgcn_sched_barrier(0);
                    const int m = h * 4 + mm;
                    const int row = tc.brow + tc.wr * 128 + m * 16 + fr;
                    float ss = 0.f;
#pragma unroll
                    for (int n = 0; n < 4; ++n)
#pragma unroll
                        for (int j = 0; j < 4; ++j) ss += acc[m][n][j] * acc[m][n][j];
                    ss += __shfl_xor(ss, 16);
                    ss += __shfl_xor(ss, 32);
                    const float rstd = rsqrtf(ss * (1.f / 64.f) + EPS) * osc;
                    const int t = row & 4095;
#pragma unroll
                    for (int ax = 0; ax < 2; ++ax) {
                        f32x4 x1 = acc[m][2 * ax] * rstd * gv[2 * ax], x2 = acc[m][2 * ax + 1] * rstd * gv[2 * ax + 1];
                        if (lat) {
                            const int pos = ax == 0 ? (t >> 6) : (t & 63);
                            const f32x4 cs = *(const f32x4*)(p.rope + pos * 16 + fq * 4), sn = *(const f32x4*)(p.rope + 1024 + pos * 16 + fq * 4);
                            const f32x4 o1 = x1 * cs - x2 * sn, o2 = x2 * cs + x1 * sn;
                            x1 = o1; x2 = o2;
                        }
                        u32x2 w; w[0] = pk2(x1[0], x1[1]); w[1] = pk2(x1[2], x1[3]);
                        wave_put(wb, mm * 16 + fr, 2 * ax, fq, w);
                        w[0] = pk2(x2[0], x2[1]); w[1] = pk2(x2[2], x2[3]);
                        wave_put(wb, mm * 16 + fr, 2 * ax + 1, fq, w);
                    }
                }
                const int row0 = tc.brow + tc.wr * 128 + h * 64;
                bf16_t* dst0;
                if (lat) {
                    const int b = row0 >> 12, t0 = row0 & 4095;
                    dst0 = isq ? p.Q + ((size_t)(b * 8 + head) * SEQ + t0) * 64 : p.K + ((size_t)(b * 2 + head) * NKEY + CTXL + t0) * 64;
                } else {
                    const int r2 = row0 - NLAT, b = r2 >> 8, t0 = r2 & 255;
                    dst0 = isq ? p.Qc + ((size_t)(b * 8 + head) * CTXL + t0) * 64 : p.K + ((size_t)(b * 2 + head) * NKEY + t0) * 64;
                }
                wave_rows_store(wb, tc.lane, dst0, 64);
            }
        } else if (BRK == 1) {
            const int kvh = wc - 2;
#pragma unroll
            for (int h = 0; h < 2; ++h) {
#pragma unroll
                for (int mm = 0; mm < 4; ++mm) {
                    const int m = h * 4 + mm;
                    const int key = mm * 16 + fr, k16 = key & 15;
                    const int kp = (key & ~15) | ((((k16 >> 2) & 1) << 3) + (k16 & 3) + ((k16 >> 3) << 2));
#pragma unroll
                    for (int n = 0; n < 4; ++n)
#pragma unroll
                        for (int j = 0; j < 4; ++j) {
                            const int d = n * 16 + fq * 4 + j;
                            *(LDSP bf16_t*)(wb + d * 128 + (((kp >> 3) ^ (d & 7)) << 4) + (kp & 7) * 2) = f2bf(acc[m][n][j]);
                        }
                }
                const int row0 = tc.brow + tc.wr * 128 + h * 64;
                int b, pos0;
                if (row0 < NLAT) { b = row0 >> 12; pos0 = CTXL + (row0 & 4095); } else { const int r2 = row0 - NLAT; b = r2 >> 8; pos0 = r2 & 255; }
                wave_rows_store(wb, tc.lane, p.Vt + (size_t)(b * 2 + kvh) * 64 * NKEY + pos0, NKEY);
            }
        } else if (BRK == 2) {
#pragma unroll
            for (int h = 0; h < 2; ++h) {
#pragma unroll
                for (int mm = 0; mm < 4; ++mm) {
                    const int m = h * 4 + mm;
#pragma unroll
                    for (int n = 0; n < 4; ++n) {
                        u32x2 w; w[0] = pk2(gelu_tanh(acc[m][n][0]), gelu_tanh(acc[m][n][1])); w[1] = pk2(gelu_tanh(acc[m][n][2]), gelu_tanh(acc[m][n][3]));
                        wave_put(wb, mm * 16 + fr, n, fq, w);
                    }
                }
                wave_rows_store(wb, tc.lane, p.U + (size_t)(tc.brow + tc.wr * 128 + h * 64) * 1024 + (pn - 3) * 256 + wc * 64, 1024);
            }
        }
    }
};

template <int EK>
DI void gemm_stream(const Params& p, int l, const bf16_t* __restrict__ A, const bf16_t* __restrict__ Bt, int M, int N, int K, ldsp_t shm) {
    const int nM = M / 256, nN = N / 256, nwg = nM * nN;
    int L = blockIdx.x;
    if (L >= nwg) return;
#define G_SA(b) (shm + (b) * G_STAGE_B)
#define G_SB(b) (shm + (b) * G_STAGE_B + G_TILE_B)
#define G_LANE_SETUP() \
    int tid_ = threadIdx.x; \
    asm volatile("" : "+v"(tid_));    \
    const int wid = tid_ >> 6, lane = tid_ & 63, wr = wid >> 2, wc = wid & 3, fr = lane & 15, fq = lane >> 4; \
    unsigned soff[4];        \
    _Pragma("unroll") for (int i = 0; i < 4; ++i) { int sR, sC; stage_rc2(wid * 1024 + i * 8192 + lane * 16, sR, sC); soff[i] = (unsigned)(sR * K + sC) * 2u; }
#define G_STAGE_A(Ap, buf, kt) do { const char* ab_ = (const char*)(Ap) + (size_t)(kt) * 128; \
      _Pragma("unroll") for (int i = 0; i < 4; ++i) \
        __builtin_amdgcn_global_load_lds((const unsigned*)(ab_ + soff[i]), (LDSP unsigned*)(G_SA(buf) + wid * 1024 + i * 8192), 16, 0, 0); } while (0)
#define G_STAGE_B(Bp, buf, kt) do { const char* bb_ = (const char*)(Bp) + (size_t)(kt) * 128; \
      _Pragma("unroll") for (int i = 0; i < 4; ++i) \
        __builtin_amdgcn_global_load_lds((const unsigned*)(bb_ + soff[i]), (LDSP unsigned*)(G_SB(buf) + wid * 1024 + i * 8192), 16, 0, 0); } while (0)
#define G_STAGE(Ap, Bp, buf, kt) do { const char* ab_ = (const char*)(Ap) + (size_t)(kt) * 128; const char* bb_ = (const char*)(Bp) + (size_t)(kt) * 128; \
      _Pragma("unroll") for (int i = 0; i < 4; ++i) { \
        __builtin_amdgcn_global_load_lds((const unsigned*)(ab_ + soff[i]), (LDSP unsigned*)(G_SA(buf) + wid * 1024 + i * 8192), 16, 0, 0); \
        __builtin_amdgcn_global_load_lds((const unsigned*)(bb_ + soff[i]), (LDSP unsigned*)(G_SB(buf) + wid * 1024 + i * 8192), 16, 0, 0); } } while (0)
    const int nt = K / 64;
    int pm, pn;
    tile_coords(L, nM, nN, pm, pn);
    const bf16_t* Ab = A + (size_t)pm * 256 * K;
    const bf16_t* Bb = Bt + (size_t)pn * 256 * K;
    { G_LANE_SETUP(); (void)wr; (void)wc; (void)fr; (void)fq; G_STAGE(Ab, Bb, 0, 0); WAIT_V0(); __syncthreads(); }
    while (true) {
        G_LANE_SETUP();
        const int aoff = lds_byte2(wr * 128 + fr, fq * 8), boff = lds_byte2(wc * 64 + fr, fq * 8);
        f32x4 acc[8][4];
#pragma unroll
        for (int m = 0; m < 8; ++m)
#pragma unroll
            for (int n = 0; n < 4; ++n) acc[m][n] = (f32x4){0.f, 0.f, 0.f, 0.f};
        const int Ln = L + gridDim.x;
        const bool has_next = Ln < nwg;
        int pm2 = pm, pn2 = pn;
        if (has_next) tile_coords(Ln, nM, nN, pm2, pn2);
        const bf16_t* Ab2 = A + (size_t)pm2 * 256 * K;
        const bf16_t* Bb2 = Bt + (size_t)pn2 * 256 * K;
        bf16x8 Aa[4], Ab_[4], Bk0[4], Bk1[4];
#define G_RDA(AF, buf, ks, mh) do { _Pragma("unroll") for (int m = 0; m < 4; ++m) AF[m] = *(const LDSP bf16x8*)(G_SA(buf) + aoff + ((mh) * 4 + m) * 2048 + (ks) * 1024); } while (0)
#define G_RDB(BF, buf, ks) do { _Pragma("unroll") for (int n = 0; n < 4; ++n) BF[n] = *(const LDSP bf16x8*)(G_SB(buf) + boff + n * 2048 + (ks) * 1024); } while (0)
#define G_MMA(AF, BF, mh) do { __builtin_amdgcn_s_setprio(1); \
            _Pragma("unroll") for (int m = 0; m < 4; ++m) _Pragma("unroll") for (int n = 0; n < 4; ++n) \
                acc[(mh) * 4 + m][n] = __builtin_amdgcn_mfma_f32_16x16x32_bf16(BF[n], AF[m], acc[(mh) * 4 + m][n], 0, 0, 0); \
            __builtin_amdgcn_s_setprio(0); } while (0)
#define G_SB0() __builtin_amdgcn_sched_barrier(0)
        for (int t = 0; t < nt; ++t) {
            const int cur = t & 1;
            G_RDA(Aa, cur, 0, 0); G_RDB(Bk0, cur, 0); G_SB0();
            if (t > 0) G_MMA(Ab_, Bk1, 1);
            G_SB0();
            if (t + 1 < nt) G_STAGE_A(Ab, cur ^ 1, t + 1);
            else if (has_next) G_STAGE_A(Ab2, cur ^ 1, 0);
            G_RDA(Ab_, cur, 0, 1); G_SB0();
            G_MMA(Aa, Bk0, 0); G_SB0();
            if (t + 1 < nt) G_STAGE_B(Bb, cur ^ 1, t + 1);
            else if (has_next) G_STAGE_B(Bb2, cur ^ 1, 0);
            G_RDA(Aa, cur, 1, 0); G_RDB(Bk1, cur, 1); G_SB0();
            G_MMA(Ab_, Bk0, 1); G_SB0();
            G_RDA(Ab_, cur, 1, 1); G_SB0();
            G_MMA(Aa, Bk1, 0); G_SB0();
            asm volatile("s_waitcnt lgkmcnt(0)" ::: "memory");
            WAIT_V0(); __syncthreads();
        }
        G_MMA(Ab_, Bk1, 1);
        G_SB0();
        {
            int tid2 = threadIdx.x, pme = pm, pne = pn;
            asm volatile("" : "+v"(tid2), "+s"(pme), "+s"(pne));
            TileCtx tc;
            tc.wid = tid2 >> 6; tc.lane = tid2 & 63; tc.wr = tc.wid >> 2; tc.wc = tc.wid & 3; tc.fr = tc.lane & 15; tc.fq = tc.lane >> 4; tc.l = l;
            tc.brow = pme * 256; tc.bcol = pne * 256; tc.pn = pne;
            ldsp_t ex = shm + G_STAGE_B + tc.wid * 8192;
            if (EK == 0 || EK == 2) {
                const int cond = tc.brow < NLAT ? (tc.brow >> 12) : 4;
                const float* ssp = p.ss + ((size_t)(l * 2 + (EK == 0 ? 0 : 1)) * NTOK + tc.brow + tc.wr * 128 + tc.fr) * 16 + tc.fq * 4;
                const float* shw = (EK == 0 ? p.shw_in + ((size_t)l * 5 + cond) * IN_DIM : p.shw_ff1 + ((size_t)l * 5 + cond) * FF) + tc.bcol + tc.wc * 64 + tc.fq * 4;
                f32x4 shv[4];
#pragma unroll
                for (int n = 0; n < 4; ++n) shv[n] = *(const f32x4*)(shw + n * 16);
#pragma unroll
                for (int m = 0; m < 8; ++m) {
                    const f32x4 pp = *(const f32x4*)(ssp + m * 256);
                    float sq = pp[0] + pp[1] + pp[2] + pp[3];
                    sq += __shfl_xor(sq, 16);
                    sq += __shfl_xor(sq, 32);
                    const float rstd = rsqrtf(sq * (1.f / DM) + EPS);
#pragma unroll
                    for (int n = 0; n < 4; ++n) acc[m][n] = acc[m][n] * rstd + shv[n];
                }
            }
            if (EK == 0) {
                if (pne < 2) EpiIn<0>::run(acc, tc, p, ex);
                else if (pne == 2) EpiIn<1>::run(acc, tc, p, ex);
                else EpiIn<2>::run(acc, tc, p, ex);
            } else if (EK == 1) EpiResid<1>::run(acc, tc, p, ex);
            else if (EK == 2) EpiFF1::run(acc, tc, p, ex);
            else EpiResid<3>::run(acc, tc, p, ex);
        }
        __syncthreads();
        if (!has_next) break;
        L = Ln; pm = pm2; pn = pn2; Ab = Ab2; Bb = Bb2;
    }
}

template <int EK>
DI void ctx_item(const Params& p, int l, int grow, int gcol, int slot, f32x4 s0, f32x4 s1, bool lead) {
    if (EK == 2) {
        const float* pp = p.ss + ((size_t)(l * 2 + 1) * NTOK + NLAT + grow) * 16;
        const f32x4 q0 = *(const f32x4*)pp, q1 = *(const f32x4*)(pp + 4), q2 = *(const f32x4*)(pp + 8), q3 = *(const f32x4*)(pp + 12);
        const f32x4 qs = q0 + q1 + q2 + q3;
        const float rstd = rsqrtf((qs[0] + qs[1] + qs[2] + qs[3]) * (1.f / DM) + EPS);
        const float* shw = p.shw_ff1 + ((size_t)l * 5 + 4) * FF + gcol;
        const f32x4 h0 = *(const f32x4*)shw, h1 = *(const f32x4*)(shw + 4);
        s0 = s0 * rstd + h0; s1 = s1 * rstd + h1;
#pragma unroll
        for (int j = 0; j < 4; ++j) { float r0 = fmaxf(s0[j], 0.f), r1 = fmaxf(s1[j], 0.f); s0[j] = r0 * r0; s1[j] = r1 * r1; }
        u32x4 w; w[0] = pk2(s0[0], s0[1]); w[1] = pk2(s0[2], s0[3]); w[2] = pk2(s1[0], s1[1]); w[3] = pk2(s1[2], s1[3]);
        *(u32x4*)(p.ACT + (size_t)(NLAT + grow) * FF + gcol) = w;
    } else {
        const float* gate = p.mod + ((size_t)l * 5 + 4) * 6144 + (EK == 1 ? 2 : 5) * DM + gcol;
        float* xr = p.xc + (size_t)grow * DM + gcol;
        const f32x4 g0 = *(const f32x4*)gate, g1 = *(const f32x4*)(gate + 4);
        f32x4 x0 = *(const f32x4*)xr, x1 = *(const f32x4*)(xr + 4);
        x0 += g0 * s0; x1 += g1 * s1;
        *(f32x4*)xr = x0; *(f32x4*)(xr + 4) = x1;
        const int ln = EK == 1 ? l : l + 1;
        const float* gnx = (EK == 1 ? p.norm2_g : p.norm1_g) + (size_t)ln * DM + gcol;
        const float* scn = p.mod + ((size_t)ln * 5 + 4) * 6144 + (EK == 1 ? 4 : 1) * DM + gcol;
        const f32x4 a0 = *(const f32x4*)gnx * (1.f + *(const f32x4*)scn), a1 = *(const f32x4*)(gnx + 4) * (1.f + *(const f32x4*)(scn + 4));
        const f32x4 y0 = x0 * a0, y1 = x1 * a1;
        u32x4 w; w[0] = pk2(y0[0], y0[1]); w[1] = pk2(y0[2], y0[3]); w[2] = pk2(y1[0], y1[1]); w[3] = pk2(y1[2], y1[3]);
        *(u32x4*)(p.H + (size_t)(NLAT + grow) * DM + gcol) = w;
        float part = x0[0] * x0[0] + x0[1] * x0[1] + x0[2] * x0[2] + x0[3] * x0[3] + x1[0] * x1[0] + x1[1] * x1[1] + x1[2] * x1[2] + x1[3] * x1[3];
        part += __shfl_xor(part, 1); part += __shfl_xor(part, 2); part += __shfl_xor(part, 4);
        if (lead) p.ss[((size_t)(ln * 2 + (EK == 1 ? 1 : 0)) * NTOK + NLAT + grow) * 16 + slot] = part;
    }
}

template <int EK, int TS, int KS>
DI void ctx_tiles(const Params& p, int l, const bf16_t* __restrict__ A, const bf16_t* __restrict__ Bt, int N, int K, ldsp_t shm) {
    constexpr int WM = TS / 2, WN = TS / 4, MT = WM / 16, NT = WN / 16, BKC = 32 * KS;
    constexpr int TILE_A = TS * BKC * 2, PP = TILE_A / 8192;
    const int ntn = N / TS, ntiles = (NCTX / TS) * ntn, nt = K / BKC;
    for (int u = blockIdx.x; u < ntiles; u += gridDim.x) {
        const int tm = u / ntn, tn = u % ntn;
        int tid = threadIdx.x;
        asm volatile("" : "+v"(tid));
        const int wid = tid >> 6, lane = tid & 63, wr = wid >> 2, wc = wid & 3, fr = lane & 15, fq = lane >> 4;
        unsigned soff[PP];
#pragma unroll
        for (int i = 0; i < PP; ++i) { int sR, sC; stage_rc_ks<KS>((wid * PP + i) * 1024 + lane * 16, sR, sC); soff[i] = (unsigned)(sR * K + sC) * 2u; }
        const bf16_t* Ab = A + (size_t)tm * TS * K;
        const bf16_t* Bb = Bt + (size_t)tn * TS * K;
#define C_STAGE(buf, kt) do { const char* ab_ = (const char*)Ab + (size_t)(kt) * (BKC * 2); const char* bb_ = (const char*)Bb + (size_t)(kt) * (BKC * 2); \
      _Pragma("unroll") for (int i = 0; i < PP; ++i) { \
        __builtin_amdgcn_global_load_lds((const unsigned*)(ab_ + soff[i]), (LDSP unsigned*)(shm + (buf) * 2 * TILE_A + (wid * PP + i) * 1024), 16, 0, 0); \
        __builtin_amdgcn_global_load_lds((const unsigned*)(bb_ + soff[i]), (LDSP unsigned*)(shm + (buf) * 2 * TILE_A + TILE_A + (wid * PP + i) * 1024), 16, 0, 0); } } while (0)
        f32x4 acc[MT][NT];
#pragma unroll
        for (int m = 0; m < MT; ++m)
#pragma unroll
            for (int n = 0; n < NT; ++n) acc[m][n] = (f32x4){0.f, 0.f, 0.f, 0.f};
        const int aoff = lds_byte_ks<KS>(wr * WM + fr, fq * 8), boff = lds_byte_ks<KS>(wc * WN + fr, fq * 8);
        C_STAGE(0, 0); WAIT_V0(); __syncthreads();
        for (int t = 0; t < nt; ++t) {
            const int cur = t & 1;
            if (t + 1 < nt) C_STAGE(cur ^ 1, t + 1);
            ldsp_t sa = shm + cur * 2 * TILE_A, sb = sa + TILE_A;
#pragma unroll
            for (int ks = 0; ks < KS; ++ks) {
                bf16x8 At[MT], Bf[NT];
#pragma unroll
                for (int m = 0; m < MT; ++m) At[m] = *(const LDSP bf16x8*)(sa + aoff + m * (KS * 1024) + ks * 1024);
#pragma unroll
                for (int n = 0; n < NT; ++n) Bf[n] = *(const LDSP bf16x8*)(sb + boff + n * (KS * 1024) + ks * 1024);
#pragma unroll
                for (int m = 0; m < MT; ++m)
#pragma unroll
                    for (int n = 0; n < NT; ++n) acc[m][n] = __builtin_amdgcn_mfma_f32_16x16x32_bf16(Bf[n], At[m], acc[m][n], 0, 0, 0);
            }
            WAIT_V0(); __syncthreads();
        }
#pragma unroll
        for (int m = 0; m < MT; ++m)
#pragma unroll
            for (int n = 0; n < NT; ++n) {
                const int row = wr * WM + m * 16 + fr, ch = (wc * WN + n * 16 + fq * 4) >> 2;
                *(LDSP f32x4*)(shm + row * (TS * 4) + ((ch ^ (row & 15)) << 4)) = acc[m][n];
            }
        __syncthreads();
#pragma unroll
        for (int it = 0; it < (TS * TS / 8) / 512; ++it) {
            const int item = it * 512 + tid, row = item / (TS / 8), c8 = item % (TS / 8);
            const f32x4 s0 = *(const LDSP f32x4*)(shm + row * (TS * 4) + (((2 * c8) ^ (row & 15)) << 4));
            const f32x4 s1 = *(const LDSP f32x4*)(shm + row * (TS * 4) + (((2 * c8 + 1) ^ (row & 15)) << 4));
            ctx_item<EK>(p, l, tm * TS + row, tn * TS + c8 * 8, tn, s0, s1, c8 == 0);
        }
        __syncthreads();
    }
}

DI void attn_unit(const Params& p, int l, int b, int kvh, int qb, bool isctx, ldsp_t smem) {
    int tid = threadIdx.x;
    asm volatile("" : "+v"(tid));
    const int wid = tid >> 6, lane = tid & 63, r = lane & 31, hh = lane >> 5;
    const int head = kvh * 4 + (wid >> 1);
    const int t0 = qb * 64 + (wid & 1) * 32;
    const int nkeys = isctx ? CTXL : NKEY;
    const bf16_t* Qp = isctx ? p.Qc + ((size_t)(b * 8 + head) * CTXL + t0) * 64 : p.Q + ((size_t)(b * 8 + head) * SEQ + t0) * 64;
    const bf16_t* Kp = p.K + (size_t)(b * 2 + kvh) * NKEY * 64;
    const bf16_t* Vp = p.Vt + (size_t)(b * 2 + kvh) * 64 * NKEY;
    const int orow = isctx ? NLAT + b * CTXL + t0 : b * SEQ + t0;
    bf16_t* Op = p.MIX + (size_t)orow * DM + head * 64;
    const float cexp = p.smax[l] * LOG2E;

    bf16x8 qf[4];
#pragma unroll
    for (int ks = 0; ks < 4; ++ks) qf[ks] = *(const bf16x8*)(Qp + (size_t)r * 64 + ks * 16 + 8 * hh);
    f32x16 o[2];
#pragma unroll
    for (int i = 0; i < 16; ++i) { o[0][i] = 0.f; o[1][i] = 0.f; }
    float rs0 = 0.f, rs1 = 0.f;

    const int srow = tid >> 3, sch = tid & 7;
    const int kdst = srow * 128 + ((sch ^ ((srow >> 1) & 7)) << 4);
    const bf16_t* kg = Kp + (size_t)srow * 64 + sch * 8;
    const bf16_t* vg = Vp + (size_t)srow * NKEY + sch * 8;
    const int rsw = (r >> 1) & 7;
    const int ntile = nkeys / 64;

#define ATT_QK(SD, kb) do { _Pragma("unroll") for (int kt = 0; kt < 2; ++kt) { \
        _Pragma("unroll") for (int i = 0; i < 16; ++i) SD[kt][i] = -cexp; \
        _Pragma("unroll") for (int ks = 0; ks < 4; ++ks) { \
            const bf16x8 a_ = *(const LDSP bf16x8*)((kb) + (kt * 32 + r) * 128 + (((ks * 2 + hh) ^ rsw) << 4)); \
            SD[kt] = __builtin_amdgcn_mfma_f32_32x32x16_bf16(a_, qf[ks], SD[kt], 0, 0, 0); } } } while (0)

    u32x4 kst, vst;
    f32x16 sA[2], sB[2];
    {
        kst = *(const u32x4*)kg;
        *(LDSP u32x4*)(smem + kdst) = kst;
        kst = *(const u32x4*)(kg + (size_t)64 * 64);
        vst = *(const u32x4*)vg;
        __syncthreads();
        ATT_QK(sA, smem);
        *(LDSP u32x4*)(smem + 8192 + kdst) = kst;
        *(LDSP u32x4*)(smem + 16384 + kdst) = vst;
    }
#define ATT_STEP(t, SC, SN) do { \
        const int par = (t) & 1; \
        __syncthreads(); \
        { const int t2_ = (t) + 2 < ntile ? (t) + 2 : ntile - 1, t1_ = (t) + 1 < ntile ? (t) + 1 : ntile - 1; \
          kst = *(const u32x4*)(kg + (size_t)t2_ * 64 * 64); vst = *(const u32x4*)(vg + t1_ * 64); } \
        bf16x8 kf[8], vf[4], vh[4]; \
        ldsp_t kb_ = smem + (par ^ 1) * 8192; ldsp_t vb_ = smem + 16384 + par * 8192; \
        _Pragma("unroll") for (int kt = 0; kt < 2; ++kt) _Pragma("unroll") for (int ks = 0; ks < 4; ++ks) \
            kf[kt * 4 + ks] = *(const LDSP bf16x8*)(kb_ + (kt * 32 + r) * 128 + (((ks * 2 + hh) ^ rsw) << 4)); \
        _Pragma("unroll") for (int c = 0; c < 2; ++c) _Pragma("unroll") for (int dt = 0; dt < 2; ++dt) \
            vf[c * 2 + dt] = *(const LDSP bf16x8*)(vb_ + (dt * 32 + r) * 128 + (((c * 2 + hh) ^ rsw) << 4)); \
        __builtin_amdgcn_sched_barrier(0); \
        _Pragma("unroll") for (int kt = 0; kt < 2; ++kt) _Pragma("unroll") for (int i = 0; i < 16; ++i) SN[kt][i] = -cexp;     \
        _Pragma("unroll") for (int ks = 0; ks < 4; ++ks) _Pragma("unroll") for (int kt = 0; kt < 2; ++kt) \
            SN[kt] = __builtin_amdgcn_mfma_f32_32x32x16_bf16(kf[kt * 4 + ks], qf[ks], SN[kt], 0, 0, 0); \
        _Pragma("unroll") for (int c = 2; c < 4; ++c) _Pragma("unroll") for (int dt = 0; dt < 2; ++dt) \
            vh[(c - 2) * 2 + dt] = *(const LDSP bf16x8*)(vb_ + (dt * 32 + r) * 128 + (((c * 2 + hh) ^ rsw) << 4)); \
        __builtin_amdgcn_sched_barrier(0); \
        _Pragma("unroll") for (int kt = 0; kt < 2; ++kt) { \
            _Pragma("unroll") for (int i = 0; i < 16; ++i) { \
                const float e_ = fexp2(SC[kt][i]); \
                if (i & 1) rs1 += e_; else rs0 += e_; \
                SC[kt][i] = e_; } } \
        _Pragma("unroll") for (int c = 0; c < 4; ++c) { \
            u32x4 pw; \
            pw[0] = pk2(SC[c >> 1][8 * (c & 1) + 0], SC[c >> 1][8 * (c & 1) + 1]); pw[1] = pk2(SC[c >> 1][8 * (c & 1) + 2], SC[c >> 1][8 * (c & 1) + 3]); \
            pw[2] = pk2(SC[c >> 1][8 * (c & 1) + 4], SC[c >> 1][8 * (c & 1) + 5]); pw[3] = pk2(SC[c >> 1][8 * (c & 1) + 6], SC[c >> 1][8 * (c & 1) + 7]); \
            const bf16x8 pb = __builtin_bit_cast(bf16x8, pw); \
            _Pragma("unroll") for (int dt = 0; dt < 2; ++dt) o[dt] = __builtin_amdgcn_mfma_f32_32x32x16_bf16(c < 2 ? vf[c * 2 + dt] : vh[(c - 2) * 2 + dt], pb, o[dt], 0, 0, 0); } \
        *(LDSP u32x4*)(smem + par * 8192 + kdst) = kst; \
        *(LDSP u32x4*)(smem + 16384 + (par ^ 1) * 8192 + kdst) = vst; \
    } while (0)

    for (int t = 0; t < ntile; t += 2) {
        ATT_STEP(t, sA, sB);
        ATT_STEP(t + 1, sB, sA);
    }
    const float lrun = rs0 + rs1;
    const float ltot = lrun + __shfl_xor(lrun, 32);
    const float inv = 1.f / ltot;
#pragma unroll
    for (int dt = 0; dt < 2; ++dt)
#pragma unroll
        for (int g4 = 0; g4 < 4; ++g4) {
            u32x2 w; w[0] = pk2(o[dt][4 * g4 + 0] * inv, o[dt][4 * g4 + 1] * inv); w[1] = pk2(o[dt][4 * g4 + 2] * inv, o[dt][4 * g4 + 3] * inv);
            *(u32x2*)(Op + (size_t)r * DM + dt * 32 + 8 * g4 + 4 * hh) = w;
        }
    __syncthreads();
}

DI void gmlp_unit(const Params& p, int l, int T, int g, ldsp_t smem) {
    int tid = threadIdx.x;
    asm volatile("" : "+v"(tid));
    const int wid = tid >> 6, lane = tid & 63, fr = lane & 15, fq = lane >> 4;
    {
        const int q = tid >> 2, part = tid & 3;
        const bf16_t* src = p.U + (size_t)(T * 128 + q) * 1024 + 512 + g * 128 + part * 32;
        u32x4 raw[4];
#pragma unroll
        for (int i = 0; i < 4; ++i) raw[i] = *(const u32x4*)(src + i * 8);
        float a = 0.f, b = 0.f;
#pragma unroll
        for (int i = 0; i < 4; ++i)
#pragma unroll
            for (int j = 0; j < 4; ++j) {
                const float lo = __uint_as_float(raw[i][j] << 16), hi = __uint_as_float(raw[i][j] & 0xffff0000u);
                a += lo + hi; b += lo * lo + hi * hi;
            }
        a += __shfl_xor(a, 1); a += __shfl_xor(a, 2);
        b += __shfl_xor(b, 1); b += __shfl_xor(b, 2);
        const float mean = a * (1.f / 128.f);
        const float rstd = rsqrtf(fmaxf(b * (1.f / 128.f) - mean * mean, 0.f) + EPS);
        const float* gn = p.gmlp_norm_g + l * 512 + g * 128 + part * 32;
#pragma unroll
        for (int i = 0; i < 4; ++i)
#pragma unroll
            for (int j = 0; j < 4; ++j) {
                const int c0 = part * 32 + i * 8 + j * 2;
                const float lo = __uint_as_float(raw[i][j] << 16), hi = __uint_as_float(raw[i][j] & 0xffff0000u);
                const unsigned w = pk2((lo - mean) * rstd * gn[i * 8 + j * 2], (hi - mean) * rstd * gn[i * 8 + j * 2 + 1]);
                *(LDSP bf16_t*)(smem + c0 * 256 + (((q >> 3) ^ (c0 & 15)) << 4) + (q & 7) * 2) = (bf16_t)(w & 0xffffu);
                *(LDSP bf16_t*)(smem + (c0 + 1) * 256 + (((q >> 3) ^ ((c0 + 1) & 15)) << 4) + (q & 7) * 2) = (bf16_t)(w >> 16);
            }
    }
    __syncthreads();
    const int prow = wid * 16 + fr;
    const bf16_t* wsp = p.ws_bf + ((size_t)(l * 4 + g) * 128 + prow) * 128 + fq * 8;
    bf16x8 a[4];
#pragma unroll
    for (int ks = 0; ks < 4; ++ks) a[ks] = *(const bf16x8*)(wsp + ks * 32);
    f32x4 acc[8];
#pragma unroll
    for (int n = 0; n < 8; ++n) {
        acc[n] = (f32x4){0.f, 0.f, 0.f, 0.f};
        const int c = n * 16 + fr;
#pragma unroll
        for (int ks = 0; ks < 4; ++ks) {
            const bf16x8 bq = *(const LDSP bf16x8*)(smem + c * 256 + (((ks * 4 + fq) ^ (c & 15)) << 4));
            acc[n] = __builtin_amdgcn_mfma_f32_16x16x32_bf16(bq, a[ks], acc[n], 0, 0, 0);
        }
    }
    const float bs = p.b_spatial[(size_t)(l * 4 + g) * 128 + prow];
    const int row = T * 128 + prow;
    const bf16_t* up = p.U + (size_t)row * 1024 + g * 128 + fq * 4;
    bf16_t* mp = p.MIX + (size_t)row * DM + 512 + g * 128 + fq * 4;
#pragma unroll
    for (int n = 0; n < 8; ++n) {
        const u32x2 uu = *(const u32x2*)(up + n * 16);
        const float u0 = __uint_as_float(uu[0] << 16), u1 = __uint_as_float(uu[0] & 0xffff0000u), u2 = __uint_as_float(uu[1] << 16), u3 = __uint_as_float(uu[1] & 0xffff0000u);
        u32x2 w; w[0] = pk2((acc[n][0] + bs) * u0, (acc[n][1] + bs) * u1); w[1] = pk2((acc[n][2] + bs) * u2, (acc[n][3] + bs) * u3);
        *(u32x2*)(mp + n * 16) = w;
    }
    __syncthreads();
}

DI void mixer_phase(const Params& p, int l, ldsp_t smem) {
    const bool last = l == DEPTH - 1;
    for (int u = blockIdx.x; u < 512; u += gridDim.x) attn_unit(p, l, (u & 7) >> 1, u & 1, u >> 3, false, smem);
    if (!last)
        for (int u = blockIdx.x; u < 32; u += gridDim.x) attn_unit(p, l, (u & 7) >> 1, u & 1, u >> 3, true, smem);
    const int nT = last ? 128 : 136;
    for (int u = blockIdx.x; u < nT * 4; u += gridDim.x) gmlp_unit(p, l, u >> 2, u & 3, smem);
}

DI void grid_barrier(unsigned* bar, unsigned k) {
    asm volatile("s_waitcnt vmcnt(0)" ::: "memory");
    __syncthreads();
    if (threadIdx.x == 0) {
        __builtin_amdgcn_fence(__ATOMIC_RELEASE, "agent");
        asm volatile("s_waitcnt vmcnt(0)" ::: "memory");
        const unsigned j = blockIdx.x & 7u, G = gridDim.x;
        const unsigned nsub = (G - j + 7u) >> 3, ngrp = G < 8u ? G : 8u;
        const unsigned old = __hip_atomic_fetch_add(bar + 64 * (1 + j), 1u, __ATOMIC_RELAXED, __HIP_MEMORY_SCOPE_AGENT);
        if (old + 1u == k * nsub) __hip_atomic_fetch_add(bar, 1u, __ATOMIC_RELAXED, __HIP_MEMORY_SCOPE_AGENT);
        unsigned sp = 0;
        while (__hip_atomic_load(bar, __ATOMIC_RELAXED, __HIP_MEMORY_SCOPE_AGENT) < k * ngrp) { __builtin_amdgcn_s_sleep(1); if (++sp > (1u << 22)) break; }
        __builtin_amdgcn_fence(__ATOMIC_ACQUIRE, "agent");
        asm volatile("s_waitcnt vmcnt(0)" ::: "memory");
    }
    __syncthreads();
}

constexpr int N_PHASES = 2 + DEPTH * 5;
DI void run_phase(const Params& p, int ph, ldsp_t smem) {
    if (ph == 0) { phase0(p, smem); return; }
    if (ph == 1) { phase1(p); return; }
    const int l = (ph - 2) / 5, k = (ph - 2) % 5;
    const bool last = l == DEPTH - 1;
    switch (k) {
        case 0: gemm_stream<0>(p, l, p.H, p.wt_in + (size_t)l * IN_DIM * DM, NTOK, IN_DIM, DM, smem); break;
        case 1: mixer_phase(p, l, smem); break;
        case 2: gemm_stream<1>(p, l, p.MIX, p.wt_out + (size_t)l * DM * DM, NLAT, DM, DM, smem);
                if (!last) ctx_tiles<1, 64, 8>(p, l, p.MIX + (size_t)NLAT * DM, p.wt_out + (size_t)l * DM * DM, DM, DM, smem);
                break;
        case 3: gemm_stream<2>(p, l, p.H, p.wt_ff1 + (size_t)l * FF * DM, NLAT, FF, DM, smem);
                if (!last) ctx_tiles<2, 128, 4>(p, l, p.H + (size_t)NLAT * DM, p.wt_ff1 + (size_t)l * FF * DM, FF, DM, smem);
                break;
        default: gemm_stream<3>(p, l, p.ACT, p.wt_ff2 + (size_t)l * DM * FF, NLAT, DM, FF, smem);
                if (!last) ctx_tiles<3, 64, 8>(p, l, p.ACT + (size_t)NLAT * FF, p.wt_ff2 + (size_t)l * DM * FF, DM, FF, smem);
                break;
    }
}

template <bool COOP>
__global__ void __launch_bounds__(512) mk_kernel(Params p, int ph_lo, int ph_hi) {
    __shared__ __attribute__((aligned(1024))) char smem_raw[2 * G_STAGE_B + 8192];
    ldsp_t smem = (ldsp_t)smem_raw;
    for (int ph = ph_lo; ph < ph_hi; ++ph) {
        run_phase(p, ph, smem);
#ifdef DUP_K
        if (ph > 1 && (ph - 2) % 5 == DUP_K) { cg::this_grid().sync(); run_phase(p, ph, smem); }
#endif
        if (COOP && ph + 1 < ph_hi) {
            if (ph == 0) cg::this_grid().sync();
            else grid_barrier(p.bar, (unsigned)ph);
        }
    }
}

extern "C" void kernel_launch(void* const* d_in, const int* in_sizes, int n_in, void* d_out, int out_size, void* d_ws, size_t ws_size, hipStream_t stream) {
    Params p{};
    p.x = (const float*)d_in[0]; p.c = (const float*)d_in[1]; p.ctx = (const float*)d_in[2]; p.c_ctx = (const float*)d_in[3];
    p.w_mod = (const float*)d_in[4]; p.b_mod = (const float*)d_in[5]; p.norm1_g = (const float*)d_in[6]; p.w_in = (const float*)d_in[7];
    p.q_norm_g = (const float*)d_in[8]; p.k_norm_g = (const float*)d_in[9]; p.gmlp_norm_g = (const float*)d_in[10]; p.w_spatial = (const float*)d_in[11];
    p.b_spatial = (const float*)d_in[12]; p.w_out = (const float*)d_in[13]; p.norm2_g = (const float*)d_in[14]; p.w_ff1 = (const float*)d_in[15]; p.w_ff2 = (const float*)d_in[16];
    p.out = (float*)d_out;
    char* w = (char*)d_ws; size_t off = 0;
    auto take = [&](size_t bytes) { char* r = w + off; off += (bytes + 1023) & ~(size_t)1023; return r; };
    p.wt_in = (bf16_t*)take((size_t)DEPTH * IN_DIM * DM * 2);
    p.wt_out = (bf16_t*)take((size_t)DEPTH * DM * DM * 2);
    p.wt_ff1 = (bf16_t*)take((size_t)DEPTH * FF * DM * 2);
    p.wt_ff2 = (bf16_t*)take((size_t)DEPTH * FF * DM * 2);
    p.ws_bf = (bf16_t*)take((size_t)DEPTH * 4 * 128 * 128 * 2);
    p.mod = (float*)take((size_t)DEPTH * 5 * 6144 * 4);
    p.rope = (float*)take(2048 * 4);
    p.xc = (float*)take((size_t)NCTX * DM * 4);
    p.smax = (float*)take(1024);
    p.bar = (unsigned*)take(4096);
    p.ss = (float*)take((size_t)DEPTH * 2 * NTOK * 16 * 4);
    p.shw_in = (float*)take((size_t)DEPTH * 5 * IN_DIM * 4);
    p.shw_ff1 = (float*)take((size_t)DEPTH * 5 * FF * 4);
    p.H = (bf16_t*)take((size_t)NTOK * DM * 2);
    p.ACT = (bf16_t*)take((size_t)NTOK * FF * 2);
    {
        char* a = (char*)p.ACT; size_t o2 = 0;
        auto take2 = [&](size_t bytes) { char* r = a + o2; o2 += (bytes + 1023) & ~(size_t)1023; return r; };
        p.Q = (bf16_t*)take2((size_t)NLAT * 512 * 2);
        p.Qc = (bf16_t*)take2((size_t)NCTX * 512 * 2);
        p.K = (bf16_t*)take2((size_t)NB * 2 * NKEY * 64 * 2);
        p.Vt = (bf16_t*)take2((size_t)NB * 2 * NKEY * 64 * 2);
        p.U = (bf16_t*)take2((size_t)NTOK * 1024 * 2);
        p.MIX = (bf16_t*)take2((size_t)NTOK * DM * 2);
    }
    if (off > ws_size) { fprintf(stderr, "workspace too small: need %zu have %zu\n", off, ws_size); return; }
#if MK_COOP
    static int grid_blocks = 0;
    if (!grid_blocks) {
        int dev = 0, cus = 0, per_cu = 0;
        hipGetDevice(&dev);
        hipDeviceGetAttribute(&cus, hipDeviceAttributeMultiprocessorCount, dev);
        hipOccupancyMaxActiveBlocksPerMultiprocessor(&per_cu, mk_kernel<true>, 512, 0);
        if (per_cu < 1) per_cu = 1;
        grid_blocks = cus * 1;
    }
    int lo = 0, hi = N_PHASES;
    void* args[] = {&p, &lo, &hi};
    hipError_t e = hipLaunchCooperativeKernel((void*)mk_kernel<true>, dim3(grid_blocks), dim3(512), args, 0, stream);
    if (e != hipSuccess) fprintf(stderr, "cooperative launch failed: %s (grid %d)\n", hipGetErrorString(e), grid_blocks);
#else
    for (int ph = 0; ph < N_PHASES; ++ph) mk_kernel<false><<<256, 512, 0, stream>>>(p, ph, ph + 1);
#endif
}
```

```cpp
#include <hip/hip_runtime.h>
#include <hip/hip_cooperative_groups.h>
#include <stdint.h>
#include <cstdio>
namespace cg = cooperative_groups;

#ifndef MK_COOP
#define MK_COOP 1
#endif

#define DI __device__ __forceinline__
#define LDSP __attribute__((address_space(3)))
typedef LDSP char* ldsp_t;
typedef unsigned short bf16_t;
typedef short bf16x8 __attribute__((ext_vector_type(8)));
typedef float f32x2 __attribute__((ext_vector_type(2)));
typedef float f32x4 __attribute__((ext_vector_type(4)));
typedef float f32x16 __attribute__((ext_vector_type(16)));
typedef unsigned u32x2 __attribute__((ext_vector_type(2)));
typedef unsigned u32x4 __attribute__((ext_vector_type(4)));
typedef __bf16 bf2_t __attribute__((ext_vector_type(2)));

constexpr int DM = 1024, NB = 4, SEQ = 4096, DEPTH = 4, CTXL = 256;
constexpr int NLAT = NB * SEQ;
constexpr int NCTX = NB * CTXL;
constexpr int NTOK = NLAT + NCTX;
constexpr int IN_DIM = 1792, FF = 4096, NKEY = CTXL + SEQ;
constexpr float EPS = 1e-6f;
constexpr float LOG2E = 1.4426950408889634f;

struct Params {
    const float *x, *c, *ctx, *c_ctx, *w_mod, *b_mod, *norm1_g, *w_in, *q_norm_g, *k_norm_g, *gmlp_norm_g, *w_spatial, *b_spatial, *w_out, *norm2_g, *w_ff1, *w_ff2;
    float* out;
    bf16_t *wt_in, *wt_out, *wt_ff1, *wt_ff2, *ws_bf;
    float *mod, *rope, *xc, *smax, *ss, *shw_in, *shw_ff1;
    unsigned* bar;
    bf16_t *H, *Q, *Qc, *K, *Vt, *U, *MIX, *ACT;
};

DI unsigned pk2(float a, float b) { f32x2 v = {a, b}; bf2_t r = __builtin_convertvector(v, bf2_t); return __builtin_bit_cast(unsigned, r); }
DI bf16_t f2bf(float a) { return (bf16_t)(pk2(a, 0.f) & 0xffffu); }
DI float fexp2(float x) { return __builtin_amdgcn_exp2f(x); }
DI float gelu_tanh(float x) {
    const float y = 0.7978845608028654f * (x + 0.044715f * x * x * x);
    return x * __builtin_amdgcn_rcpf(1.f + fexp2(-2.f * LOG2E * y));
}
DI float* xrow_ptr(const Params& p, int row) { return row < NLAT ? p.out + (size_t)row * DM : p.xc + (size_t)(row - NLAT) * DM; }

DI void transpose_tile(const float* __restrict__ src, bf16_t* __restrict__ dst, int K, int N, int tk, int tn, ldsp_t smem) {
    LDSP float* t = (LDSP float*)smem;
    int tid = threadIdx.x;
    asm volatile("" : "+v"(tid));
    const int k0 = tk * 64, n0 = tn * 256;
    f32x4 v[8];
#pragma unroll
    for (int i = 0; i < 8; ++i) v[i] = *(const f32x4*)(src + (size_t)(k0 + (tid >> 6) + 8 * i) * N + n0 + (tid & 63) * 4);
#pragma unroll
    for (int i = 0; i < 8; ++i) {
        const int k = (tid >> 6) + 8 * i, n4 = (tid & 63) * 4;
        t[k * 257 + n4 + 0] = v[i][0]; t[k * 257 + n4 + 1] = v[i][1]; t[k * 257 + n4 + 2] = v[i][2]; t[k * 257 + n4 + 3] = v[i][3];
    }
    __syncthreads();
#pragma unroll
    for (int j = 0; j < 4; ++j) {
        const int n = (tid >> 3) + 64 * j, k8 = (tid & 7) * 8;
        u32x4 w;
        w[0] = pk2(t[(k8 + 0) * 257 + n], t[(k8 + 1) * 257 + n]);
        w[1] = pk2(t[(k8 + 2) * 257 + n], t[(k8 + 3) * 257 + n]);
        w[2] = pk2(t[(k8 + 4) * 257 + n], t[(k8 + 5) * 257 + n]);
        w[3] = pk2(t[(k8 + 6) * 257 + n], t[(k8 + 7) * 257 + n]);
        *(u32x4*)(dst + (size_t)(n0 + n) * K + k0 + k8) = w;
    }
    __syncthreads();
}

DI void mod_unit(const Params& p, int l, int cgi, ldsp_t smem) {
    LDSP float* s = (LDSP float*)smem;
    LDSP float* red = (LDSP float*)(smem + 20480);
    int tid = threadIdx.x;
    asm volatile("" : "+v"(tid));
    for (int i = tid; i < 5 * 1024; i += 512) {
        const int cnd = i >> 10, k = i & 1023;
        const float v = cnd < 4 ? p.c[cnd * 1024 + k] : p.c_ctx[k];
        s[i] = v / (1.f + fexp2(-LOG2E * v));
    }
    __syncthreads();
    const int c4 = tid & 15, ks = tid >> 4;
    f32x4 acc[5];
#pragma unroll
    for (int q = 0; q < 5; ++q) acc[q] = (f32x4){0.f, 0.f, 0.f, 0.f};
    const float* wp = p.w_mod + ((size_t)l * 1024 + ks * 32) * 6144 + cgi * 64 + c4 * 4;
#pragma unroll 8
    for (int kk = 0; kk < 32; ++kk) {
        const f32x4 w = *(const f32x4*)(wp + (size_t)kk * 6144);
        const int k = ks * 32 + kk;
#pragma unroll
        for (int q = 0; q < 5; ++q) acc[q] += w * s[q * 1024 + k];
    }
#pragma unroll
    for (int q = 0; q < 5; ++q)
#pragma unroll
        for (int j = 0; j < 4; ++j) red[(ks * 5 + q) * 64 + c4 * 4 + j] = acc[q][j];
    __syncthreads();
    if (tid < 320) {
        const int q = tid >> 6, col = tid & 63;
        float a = 0.f;
        for (int k2 = 0; k2 < 32; ++k2) a += red[(k2 * 5 + q) * 64 + col];
        const int j = cgi * 64 + col;
        p.mod[((size_t)l * 5 + q) * 6144 + j] = a + p.b_mod[(size_t)l * 6144 + j];
    }
    __syncthreads();
}

DI void phase0(const Params& p, ldsp_t smem) {
    constexpr int T_IN = 16 * 7, T_OUT = 16 * 4, T_FF1 = 16 * 16, T_FF2 = 64 * 4;
    constexpr int T_L = T_IN + T_OUT + T_FF1 + T_FF2;
    constexpr int U_T = DEPTH * T_L;
    constexpr int U_MOD = DEPTH * 96;
    constexpr int U_WS = 64;
    constexpr int U_ALL = U_MOD + U_T + U_WS + 1;
    for (int u = blockIdx.x; u < U_ALL; u += gridDim.x) {
        if (u < U_MOD) { mod_unit(p, u / 96, u % 96, smem); continue; }
        int v = u - U_MOD;
        if (v < U_T) {
            const int l = v / T_L; int r = v % T_L;
            if (r < T_IN) { transpose_tile(p.w_in + (size_t)l * DM * IN_DIM, p.wt_in + (size_t)l * IN_DIM * DM, DM, IN_DIM, r / 7, r % 7, smem); continue; }
            r -= T_IN;
            if (r < T_OUT) { transpose_tile(p.w_out + (size_t)l * DM * DM, p.wt_out + (size_t)l * DM * DM, DM, DM, r / 4, r % 4, smem); continue; }
            r -= T_OUT;
            if (r < T_FF1) { transpose_tile(p.w_ff1 + (size_t)l * DM * FF, p.wt_ff1 + (size_t)l * FF * DM, DM, FF, r / 16, r % 16, smem); continue; }
            r -= T_FF1;
            transpose_tile(p.w_ff2 + (size_t)l * FF * DM, p.wt_ff2 + (size_t)l * DM * FF, FF, DM, r / 4, r % 4, smem); continue;
        }
        v -= U_T;
        if (v < U_WS) {
            int tw = threadIdx.x;
            asm volatile("" : "+v"(tw));
            const size_t i = ((size_t)v * 512 + tw) * 8;
            const f32x4 a = *(const f32x4*)(p.w_spatial + i), b = *(const f32x4*)(p.w_spatial + i + 4);
            u32x4 w; w[0] = pk2(a[0], a[1]); w[1] = pk2(a[2], a[3]); w[2] = pk2(b[0], b[1]); w[3] = pk2(b[2], b[3]);
            *(u32x4*)(p.ws_bf + i) = w;
            continue;
        }
        int ti = threadIdx.x;
        asm volatile("" : "+v"(ti));
        if (ti >= 64 && ti < 64 + 9) p.bar[(ti - 64) * 64] = 0u;
        if (ti < DEPTH) {
            float mq = 0.f, mk = 0.f;
            for (int i = 0; i < 64; ++i) { mq = fmaxf(mq, fabsf(p.q_norm_g[ti * 64 + i])); mk = fmaxf(mk, fabsf(p.k_norm_g[ti * 64 + i])); }
            p.smax[ti] = 8.f * mq * mk;
        }
        for (int i = ti; i < 1024; i += 512) {
            const int pos = i >> 4, f = i & 15;
            const float inv = fexp2(-(float)f * (13.287712379549449f / 16.f));
            const float rev = (float)pos * inv * 0.15915494309189535f;
            p.rope[i] = __builtin_amdgcn_cosf(rev);
            p.rope[1024 + i] = __builtin_amdgcn_sinf(rev);
        }
    }
}

DI void phase1(const Params& p) {
    int tid = threadIdx.x;
    asm volatile("" : "+v"(tid));
    const int lane = tid & 63, wid = tid >> 6;
    const int gw = blockIdx.x * 8 + wid, nw = gridDim.x * 8;
    for (int row = gw; row < NTOK; row += nw) {
        const float* src = row < NLAT ? p.x + (size_t)row * DM : p.ctx + (size_t)(row - NLAT) * DM;
        const int cond = row < NLAT ? (row >> 12) : 4;
        const float* mp = p.mod + ((size_t)cond) * 6144;
        f32x4 v[4];
        float ss = 0.f;
#pragma unroll
        for (int i = 0; i < 4; ++i) { v[i] = *(const f32x4*)(src + i * 256 + lane * 4); ss += v[i][0] * v[i][0] + v[i][1] * v[i][1] + v[i][2] * v[i][2] + v[i][3] * v[i][3]; }
#pragma unroll
        for (int o = 1; o < 64; o <<= 1) ss += __shfl_xor(ss, o);
        if (lane < 16) p.ss[(size_t)row * 16 + lane] = lane == 0 ? ss : 0.f;
        bf16_t* hp = p.H + (size_t)row * DM;
        float* xw = xrow_ptr(p, row);
#pragma unroll
        for (int i = 0; i < 4; ++i) {
            const int idx = i * 256 + lane * 4;
            const f32x4 gg = *(const f32x4*)(p.norm1_g + idx), sc = *(const f32x4*)(mp + DM + idx);
            f32x4 y;
#pragma unroll
            for (int j = 0; j < 4; ++j) y[j] = v[i][j] * gg[j] * (1.f + sc[j]);
            u32x2 w; w[0] = pk2(y[0], y[1]); w[1] = pk2(y[2], y[3]);
            *(u32x2*)(hp + idx) = w;
            *(f32x4*)(xw + idx) = v[i];
        }
    }
    {
        const int fr = lane & 15, fq = lane >> 4;
        constexpr int G_IN = IN_DIM / 16, G_FF = FF / 16, G_L = G_IN + G_FF;
        for (int gi = gw; gi < DEPTH * G_L; gi += nw) {
            const int l = gi / G_L, r = gi % G_L;
            const bool which = r >= G_IN;
            const int n0 = (which ? r - G_IN : r) * 16;
            const int N = which ? FF : IN_DIM;
            const bf16_t* W = (which ? p.wt_ff1 + (size_t)l * FF * DM : p.wt_in + (size_t)l * IN_DIM * DM) + (size_t)(n0 + fr) * DM + fq * 8;
            float* dst = which ? p.shw_ff1 + (size_t)l * 5 * FF : p.shw_in + (size_t)l * 5 * IN_DIM;
            const int c = fr < 5 ? fr : fr - 5;
            const float* sh = p.mod + ((size_t)l * 5 + (c < 5 ? c : 0)) * 6144 + (which ? 3 : 0) * DM + fq * 8;
            f32x4 acc = {0.f, 0.f, 0.f, 0.f};
#pragma unroll 8
            for (int ks = 0; ks < 32; ++ks) {
                const bf16x8 wv = *(const bf16x8*)(W + ks * 32);
                const f32x4 s0 = *(const f32x4*)(sh + ks * 32), s1 = *(const f32x4*)(sh + ks * 32 + 4);
                float sv[8] = {s0[0], s0[1], s0[2], s0[3], s1[0], s1[1], s1[2], s1[3]};
                u32x4 aw;
#pragma unroll
                for (int j = 0; j < 4; ++j) {
                    float a0 = sv[2 * j], a1 = sv[2 * j + 1];
                    const unsigned hi = pk2(a0, a1);
                    if (fr >= 5) { a0 -= __uint_as_float(hi << 16); a1 -= __uint_as_float(hi & 0xffff0000u); }
                    aw[j] = fr < 5 ? hi : (fr < 10 ? pk2(a0, a1) : 0u);
                }
                acc = __builtin_amdgcn_mfma_f32_16x16x32_bf16(__builtin_bit_cast(bf16x8, aw), wv, acc, 0, 0, 0);
            }
            const float r4 = __shfl(acc[0], fr + 16);
            const float r5 = __shfl(acc[1], fr + 16), r6 = __shfl(acc[2], fr + 16), r7 = __shfl(acc[3], fr + 16);
            const float r8 = __shfl(acc[0], fr + 32), r9 = __shfl(acc[1], fr + 32);
            if (fq == 0) {
                dst[(size_t)0 * N + n0 + fr] = acc[0] + r5;
                dst[(size_t)1 * N + n0 + fr] = acc[1] + r6;
                dst[(size_t)2 * N + n0 + fr] = acc[2] + r7;
                dst[(size_t)3 * N + n0 + fr] = acc[3] + r8;
                dst[(size_t)4 * N + n0 + fr] = r4 + r9;
            }
        }
    }
}

constexpr int G_TILE_B = 256 * 64 * 2, G_STAGE_B = 2 * G_TILE_B;
DI int lds_byte2(int r, int c) {
    const int st = (r >> 4) * 2 + (c >> 5), ob = (r & 15) * 64 + (c & 31) * 2;
    return st * 1024 + (ob ^ (((ob >> 9) & 1) << 5));
}
DI void stage_rc2(int b, int& R, int& C) {
    const int st = b >> 10, sb = b & 1023, swz = sb ^ (((sb >> 9) & 1) << 5);
    R = (st >> 1) * 16 + swz / 64;
    C = (st & 1) * 32 + (swz % 64) / 2;
}
template <int KS> DI int lds_byte_ks(int r, int c) {
    const int st = (r >> 4) * KS + (c >> 5), ob = (r & 15) * 64 + (c & 31) * 2;
    return st * 1024 + (ob ^ (((ob >> 9) & 1) << 5));
}
template <int KS> DI void stage_rc_ks(int b, int& R, int& C) {
    const int st = b >> 10, sb = b & 1023, swz = sb ^ (((sb >> 9) & 1) << 5);
    R = (st / KS) * 16 + swz / 64;
    C = (st % KS) * 32 + (swz % 64) / 2;
}
#define WAIT_V0() asm volatile("s_waitcnt vmcnt(0)" ::: "memory")

struct TileCtx { int brow, bcol, pn, wr, wc, fr, fq, wid, lane, l; };

DI void tile_coords(int L, int nM, int nN, int& pm, int& pn) {
    const int nwg = nM * nN;
    int wgid = L;
    { const int q = nwg / 8, r = nwg % 8, xcd = wgid % 8, off = wgid / 8; wgid = (xcd < r ? xcd * (q + 1) : r * (q + 1) + (xcd - r) * q) + off; }
    const int nig = 8 * nN, gid = wgid / nig, fm = gid * 8, gsz = (nM - fm) < 8 ? (nM - fm) : 8;
    pm = fm + ((wgid % nig) % gsz); pn = (wgid % nig) / gsz;
}

DI void wave_put(ldsp_t wb, int rowl, int n, int fq, u32x2 w) {
    const int chunk = n * 2 + (fq >> 1);
    *(LDSP u32x2*)(wb + rowl * 128 + ((chunk ^ (rowl & 7)) << 4) + (fq & 1) * 8) = w;
}
DI void wave_rows_store(ldsp_t wb, int lane, bf16_t* dst0, size_t ld) {
#pragma unroll
    for (int i = 0; i < 8; ++i) {
        const int row = i * 8 + (lane >> 3), ch = lane & 7;
        const u32x4 v = *(const LDSP u32x4*)(wb + row * 128 + ((ch ^ (row & 7)) << 4));
        *(u32x4*)(dst0 + (size_t)row * ld + ch * 8) = v;
    }
}

template <int EK> struct EpiResid {
    static DI void run(const f32x4 (&acc)[8][4], const TileCtx& tc, const Params& p, ldsp_t wb) {
        constexpr int GI = EK == 1 ? 2 : 5;
        const int cond = tc.brow < NLAT ? (tc.brow >> 12) : 4;
        const float* gate = p.mod + ((size_t)tc.l * 5 + cond) * 6144 + GI * DM;
        const int col0 = tc.bcol + tc.wc * 64 + tc.fq * 4;
        const bool has_next = EK == 1 || tc.l + 1 < DEPTH;
        const int ln = EK == 1 ? tc.l : (has_next ? tc.l + 1 : tc.l);
        const float* gnx = (EK == 1 ? p.norm2_g : p.norm1_g) + (size_t)ln * DM + col0;
        const float* scn = p.mod + ((size_t)ln * 5 + cond) * 6144 + (EK == 1 ? 4 : 1) * DM + col0;
        float* ssp = p.ss + (size_t)(ln * 2 + (EK == 1 ? 1 : 0)) * NTOK * 16 + (tc.bcol >> 8) * 4 + tc.wc;
        f32x4 gv[4], av[4];
#pragma unroll
        for (int n = 0; n < 4; ++n) {
            gv[n] = *(const f32x4*)(gate + col0 + n * 16);
            const f32x4 g1 = *(const f32x4*)(gnx + n * 16), s1 = *(const f32x4*)(scn + n * 16);
            av[n] = g1 * (1.f + s1);
        }
#pragma unroll
        for (int h = 0; h < 2; ++h) {
#pragma unroll
            for (int mm = 0; mm < 4; ++mm) { __builtin_amdgcn_sched_barrier(0);
                const int m = h * 4 + mm;
                const int row = tc.brow + tc.wr * 128 + m * 16 + tc.fr;
                float* xr = xrow_ptr(p, row) + col0;
                float part = 0.f;
#pragma unroll
                for (int n = 0; n < 4; ++n) {
                    f32x4 xv = *(const f32x4*)(xr + n * 16);
                    xv += gv[n] * acc[m][n];
                    *(f32x4*)(xr + n * 16) = xv;
                    if (has_next) {
                        part += xv[0] * xv[0] + xv[1] * xv[1] + xv[2] * xv[2] + xv[3] * xv[3];
                        const f32x4 hv = xv * av[n];
                        u32x2 w; w[0] = pk2(hv[0], hv[1]); w[1] = pk2(hv[2], hv[3]);
                        wave_put(wb, mm * 16 + tc.fr, n, tc.fq, w);
                    }
                }
                if (has_next) {
                    part += __shfl_xor(part, 16);
                    part += __shfl_xor(part, 32);
                    if (tc.fq == 0) ssp[(size_t)row * 16] = part;
                }
            }
            if (has_next) wave_rows_store(wb, tc.lane, p.H + (size_t)(tc.brow + tc.wr * 128 + h * 64) * DM + tc.bcol + tc.wc * 64, DM);
        }
    }
};
struct EpiFF1 {
    static DI void run(const f32x4 (&acc)[8][4], const TileCtx& tc, const Params& p, ldsp_t wb) {
#pragma unroll
        for (int h = 0; h < 2; ++h) {
#pragma unroll
            for (int mm = 0; mm < 4; ++mm) {
                const int m = h * 4 + mm;
#pragma unroll
                for (int n = 0; n < 4; ++n) {
                    f32x4 a = acc[m][n];
#pragma unroll
                    for (int j = 0; j < 4; ++j) { const float r = fmaxf(a[j], 0.f); a[j] = r * r; }
                    u32x2 w; w[0] = pk2(a[0], a[1]); w[1] = pk2(a[2], a[3]);
                    wave_put(wb, mm * 16 + tc.fr, n, tc.fq, w);
                }
            }
            wave_rows_store(wb, tc.lane, p.ACT + (size_t)(tc.brow + tc.wr * 128 + h * 64) * FF + tc.bcol + tc.wc * 64, FF);
        }
    }
};
template <int BRK> struct EpiIn {
    static DI void run(const f32x4 (&acc)[8][4], const TileCtx& tc, const Params& p, ldsp_t wb) {
        const int l = tc.l, pn = tc.pn, wc = tc.wc, fr = tc.fr, fq = tc.fq;
        if (BRK == 0 || (BRK == 1 && wc < 2)) {
            constexpr bool isq = BRK == 0;
            const int head = isq ? pn * 4 + wc : wc;
            const float* gn = (isq ? p.q_norm_g : p.k_norm_g) + l * 64;
            f32x4 gv[4];
#pragma unroll
            for (int n = 0; n < 4; ++n) gv[n] = *(const f32x4*)(gn + n * 16 + fq * 4);
            const float osc = isq ? 0.125f * LOG2E : 1.f;
            const bool lat = tc.brow < NLAT;
#pragma unroll
            for (int h = 0; h < 2; ++h) {
#pragma unroll
                for (int mm = 0; mm < 4; ++mm) { __builtin_amdgcn_sched_barrier(0);
                    const int m = h * 4 + mm;
                    const int row = tc.brow + tc.wr * 128 + m * 16 + fr;
                    float ss = 0.f;
#pragma unroll
                    for (int n = 0; n < 4; ++n)
#pragma unroll
                        for (int j = 0; j < 4; ++j) ss += acc[m][n][j] * acc[m][n][j];
                    ss += __shfl_xor(ss, 16);
                    ss += __shfl_xor(ss, 32);
                    const float rstd = rsqrtf(ss * (1.f / 64.f) + EPS) * osc;
                    const int t = row & 4095;
#pragma unroll
                    for (int ax = 0; ax < 2; ++ax) {
                        f32x4 x1 = acc[m][2 * ax] * rstd * gv[2 * ax], x2 = acc[m][2 * ax + 1] * rstd * gv[2 * ax + 1];
                        if (lat) {
                            const int pos = ax == 0 ? (t >> 6) : (t & 63);
                            const f32x4 cs = *(const f32x4*)(p.rope + pos * 16 + fq * 4), sn = *(const f32x4*)(p.rope + 1024 + pos * 16 + fq * 4);
                            const f32x4 o1 = x1 * cs - x2 * sn, o2 = x2 * cs + x1 * sn;
                            x1 = o1; x2 = o2;
                        }
                        u32x2 w; w[0] = pk2(x1[0], x1[1]); w[1] = pk2(x1[2], x1[3]);
                        wave_put(wb, mm * 16 + fr, 2 * ax, fq, w);
                        w[0] = pk2(x2[0], x2[1]); w[1] = pk2(x2[2], x2[3]);
                        wave_put(wb, mm * 16 + fr, 2 * ax + 1, fq, w);
                    }
                }
                const int row0 = tc.brow + tc.wr * 128 + h * 64;
                bf16_t* dst0;
                if (lat) {
                    const int b = row0 >> 12, t0 = row0 & 4095;
                    dst0 = isq ? p.Q + ((size_t)(b * 8 + head) * SEQ + t0) * 64 : p.K + ((size_t)(b * 2 + head) * NKEY + CTXL + t0) * 64;
                } else {
                    const int r2 = row0 - NLAT, b = r2 >> 8, t0 = r2 & 255;
                    dst0 = isq ? p.Qc + ((size_t)(b * 8 + head) * CTXL + t0) * 64 : p.K + ((size_t)(b * 2 + head) * NKEY + t0) * 64;
                }
                wave_rows_store(wb, tc.lane, dst0, 64);
            }
        } else if (BRK == 1) {
            const int kvh = wc - 2;
#pragma unroll
            for (int h = 0; h < 2; ++h) {
#pragma unroll
                for (int mm = 0; mm < 4; ++mm) {
                    const int m = h * 4 + mm;
                    const int key = mm * 16 + fr, k16 = key & 15;
                    const int kp = (key & ~15) | ((((k16 >> 2) & 1) << 3) + (k16 & 3) + ((k16 >> 3) << 2));
#pragma unroll
                    for (int n = 0; n < 4; ++n)
#pragma unroll
                        for (int j = 0; j < 4; ++j) {
                            const int d = n * 16 + fq * 4 + j;
                            *(LDSP bf16_t*)(wb + d * 128 + (((kp >> 3) ^ (d & 7)) << 4) + (kp & 7) * 2) = f2bf(acc[m][n][j]);
                        }
                }
                const int row0 = tc.brow + tc.wr * 128 + h * 64;
                int b, pos0;
                if (row0 < NLAT) { b = row0 >> 12; pos0 = CTXL + (row0 & 4095); } else { const int r2 = row0 - NLAT; b = r2 >> 8; pos0 = r2 & 255; }
                wave_rows_store(wb, tc.lane, p.Vt + (size_t)(b * 2 + kvh) * 64 * NKEY + pos0, NKEY);
            }
        } else if (BRK == 2) {
#pragma unroll
            for (int h = 0; h < 2; ++h) {
#pragma unroll
                for (int mm = 0; mm < 4; ++mm) {
                    const int m = h * 4 + mm;
#pragma unroll
                    for (int n = 0; n < 4; ++n) {
                        u32x2 w; w[0] = pk2(gelu_tanh(acc[m][n][0]), gelu_tanh(acc[m][n][1])); w[1] = pk2(gelu_tanh(acc[m][n][2]), gelu_tanh(acc[m][n][3]));
                        wave_put(wb, mm * 16 + fr, n, fq, w);
                    }
                }
                wave_rows_store(wb, tc.lane, p.U + (size_t)(tc.brow + tc.wr * 128 + h * 64) * 1024 + (pn - 3) * 256 + wc * 64, 1024);
            }
        }
    }
};

template <int EK>
DI void gemm_stream(const Params& p, int l, const bf16_t* __restrict__ A, const bf16_t* __restrict__ Bt, int M, int N, int K, ldsp_t shm) {
    const int nM = M / 256, nN = N / 256, nwg = nM * nN;
    int L = blockIdx.x;
    if (L >= nwg) return;
#define G_SA(b) (shm + (b) * G_STAGE_B)
#define G_SB(b) (shm + (b) * G_STAGE_B + G_TILE_B)
#define G_LANE_SETUP() \
    int tid_ = threadIdx.x; \
    asm volatile("" : "+v"(tid_));    \
    const int wid = tid_ >> 6, lane = tid_ & 63, wr = wid >> 2, wc = wid & 3, fr = lane & 15, fq = lane >> 4; \
    unsigned soff[4];        \
    _Pragma("unroll") for (int i = 0; i < 4; ++i) { int sR, sC; stage_rc2(wid * 1024 + i * 8192 + lane * 16, sR, sC); soff[i] = (unsigned)(sR * K + sC) * 2u; }
#define G_STAGE_A(Ap, buf, kt) do { const char* ab_ = (const char*)(Ap) + (size_t)(kt) * 128; \
      _Pragma("unroll") for (int i = 0; i < 4; ++i) \
        __builtin_amdgcn_global_load_lds((const unsigned*)(ab_ + soff[i]), (LDSP unsigned*)(G_SA(buf) + wid * 1024 + i * 8192), 16, 0, 0); } while (0)
#define G_STAGE_B(Bp, buf, kt) do { const char* bb_ = (const char*)(Bp) + (size_t)(kt) * 128; \
      _Pragma("unroll") for (int i = 0; i < 4; ++i) \
        __builtin_amdgcn_global_load_lds((const unsigned*)(bb_ + soff[i]), (LDSP unsigned*)(G_SB(buf) + wid * 1024 + i * 8192), 16, 0, 0); } while (0)
#define G_STAGE(Ap, Bp, buf, kt) do { const char* ab_ = (const char*)(Ap) + (size_t)(kt) * 128; const char* bb_ = (const char*)(Bp) + (size_t)(kt) * 128; \
      _Pragma("unroll") for (int i = 0; i < 4; ++i) { \
        __builtin_amdgcn_global_load_lds((const unsigned*)(ab_ + soff[i]), (LDSP unsigned*)(G_SA(buf) + wid * 1024 + i * 8192), 16, 0, 0); \
        __builtin_amdgcn_global_load_lds((const unsigned*)(bb_ + soff[i]), (LDSP unsigned*)(G_SB(buf) + wid * 1024 + i * 8192), 16, 0, 0); } } while (0)
    const int nt = K / 64;
    int pm, pn;
    tile_coords(L, nM, nN, pm, pn);
    const bf16_t* Ab = A + (size_t)pm * 256 * K;
    const bf16_t* Bb = Bt + (size_t)pn * 256 * K;
    { G_LANE_SETUP(); (void)wr; (void)wc; (void)fr; (void)fq; G_STAGE(Ab, Bb, 0, 0); WAIT_V0(); __syncthreads(); }
    while (true) {
        G_LANE_SETUP();
        const int aoff = lds_byte2(wr * 128 + fr, fq * 8), boff = lds_byte2(wc * 64 + fr, fq * 8);
        f32x4 acc[8][4];
#pragma unroll
        for (int m = 0; m < 8; ++m)
#pragma unroll
            for (int n = 0; n < 4; ++n) acc[m][n] = (f32x4){0.f, 0.f, 0.f, 0.f};
        const int Ln = L + gridDim.x;
        const bool has_next = Ln < nwg;
        int pm2 = pm, pn2 = pn;
        if (has_next) tile_coords(Ln, nM, nN, pm2, pn2);
        const bf16_t* Ab2 = A + (size_t)pm2 * 256 * K;
        const bf16_t* Bb2 = Bt + (size_t)pn2 * 256 * K;
        bf16x8 Aa[4], Ab_[4], Bk0[4], Bk1[4];
#define G_RDA(AF, buf, ks, mh) do { _Pragma("unroll") for (int m = 0; m < 4; ++m) AF[m] = *(const LDSP bf16x8*)(G_SA(buf) + aoff + ((mh) * 4 + m) * 2048 + (ks) * 1024); } while (0)
#define G_RDB(BF, buf, ks) do { _Pragma("unroll") for (int n = 0; n < 4; ++n) BF[n] = *(const LDSP bf16x8*)(G_SB(buf) + boff + n * 2048 + (ks) * 1024); } while (0)
#define G_MMA(AF, BF, mh) do { __builtin_amdgcn_s_setprio(1); \
            _Pragma("unroll") for (int m = 0; m < 4; ++m) _Pragma("unroll") for (int n = 0; n < 4; ++n) \
                acc[(mh) * 4 + m][n] = __builtin_amdgcn_mfma_f32_16x16x32_bf16(BF[n], AF[m], acc[(mh) * 4 + m][n], 0, 0, 0); \
            __builtin_amdgcn_s_setprio(0); } while (0)
#define G_SB0() __builtin_amdgcn_sched_barrier(0)
        for (int t = 0; t < nt; ++t) {
            const int cur = t & 1;
            G_RDA(Aa, cur, 0, 0); G_RDB(Bk0, cur, 0); G_SB0();
            if (t > 0) G_MMA(Ab_, Bk1, 1);
            G_SB0();
            if (t + 1 < nt) G_STAGE_B(Bb, cur ^ 1, t + 1);
            else if (has_next) G_STAGE_B(Bb2, cur ^ 1, 0);
            G_RDA(Ab_, cur, 0, 1); G_SB0();
            G_MMA(Aa, Bk0, 0); G_SB0();
            if (t + 1 < nt) G_STAGE_A(Ab, cur ^ 1, t + 1);
            else if (has_next) G_STAGE_A(Ab2, cur ^ 1, 0);
            G_RDA(Aa, cur, 1, 0); G_RDB(Bk1, cur, 1); G_SB0();
            G_MMA(Ab_, Bk0, 1); G_SB0();
            G_RDA(Ab_, cur, 1, 1); G_SB0();
            G_MMA(Aa, Bk1, 0); G_SB0();
            asm volatile("s_waitcnt lgkmcnt(0)" ::: "memory");
            WAIT_V0(); __syncthreads();
        }
        G_MMA(Ab_, Bk1, 1);
        G_SB0();
        {
            int tid2 = threadIdx.x, pme = pm, pne = pn;
            asm volatile("" : "+v"(tid2), "+s"(pme), "+s"(pne));
            TileCtx tc;
            tc.wid = tid2 >> 6; tc.lane = tid2 & 63; tc.wr = tc.wid >> 2; tc.wc = tc.wid & 3; tc.fr = tc.lane & 15; tc.fq = tc.lane >> 4; tc.l = l;
            tc.brow = pme * 256; tc.bcol = pne * 256; tc.pn = pne;
            ldsp_t ex = shm + G_STAGE_B + tc.wid * 8192;
            if (EK == 0 || EK == 2) {
                const int cond = tc.brow < NLAT ? (tc.brow >> 12) : 4;
                const float* ssp = p.ss + ((size_t)(l * 2 + (EK == 0 ? 0 : 1)) * NTOK + tc.brow + tc.wr * 128 + tc.fr) * 16 + tc.fq * 4;
                const float* shw = (EK == 0 ? p.shw_in + ((size_t)l * 5 + cond) * IN_DIM : p.shw_ff1 + ((size_t)l * 5 + cond) * FF) + tc.bcol + tc.wc * 64 + tc.fq * 4;
                f32x4 shv[4];
#pragma unroll
                for (int n = 0; n < 4; ++n) shv[n] = *(const f32x4*)(shw + n * 16);
#pragma unroll
                for (int m = 0; m < 8; ++m) {
                    const f32x4 pp = *(const f32x4*)(ssp + m * 256);
                    float sq = pp[0] + pp[1] + pp[2] + pp[3];
                    sq += __shfl_xor(sq, 16);
                    sq += __shfl_xor(sq, 32);
                    const float rstd = rsqrtf(sq * (1.f / DM) + EPS);
#pragma unroll
                    for (int n = 0; n < 4; ++n) acc[m][n] = acc[m][n] * rstd + shv[n];
                }
            }
            if (EK == 0) {
                if (pne < 2) EpiIn<0>::run(acc, tc, p, ex);
                else if (pne == 2) EpiIn<1>::run(acc, tc, p, ex);
                else EpiIn<2>::run(acc, tc, p, ex);
            } else if (EK == 1) EpiResid<1>::run(acc, tc, p, ex);
            else if (EK == 2) EpiFF1::run(acc, tc, p, ex);
            else EpiResid<3>::run(acc, tc, p, ex);
        }
        __syncthreads();
        if (!has_next) break;
        L = Ln; pm = pm2; pn = pn2; Ab = Ab2; Bb = Bb2;
    }
}

template <int EK>
DI void ctx_item(const Params& p, int l, int grow, int gcol, int slot, f32x4 s0, f32x4 s1, bool lead) {
    if (EK == 2) {
        const float* pp = p.ss + ((size_t)(l * 2 + 1) * NTOK + NLAT + grow) * 16;
        const f32x4 q0 = *(const f32x4*)pp, q1 = *(const f32x4*)(pp + 4), q2 = *(const f32x4*)(pp + 8), q3 = *(const f32x4*)(pp + 12);
        const f32x4 qs = q0 + q1 + q2 + q3;
        const float rstd = rsqrtf((qs[0] + qs[1] + qs[2] + qs[3]) * (1.f / DM) + EPS);
        const float* shw = p.shw_ff1 + ((size_t)l * 5 + 4) * FF + gcol;
        const f32x4 h0 = *(const f32x4*)shw, h1 = *(const f32x4*)(shw + 4);
        s0 = s0 * rstd + h0; s1 = s1 * rstd + h1;
#pragma unroll
        for (int j = 0; j < 4; ++j) { float r0 = fmaxf(s0[j], 0.f), r1 = fmaxf(s1[j], 0.f); s0[j] = r0 * r0; s1[j] = r1 * r1; }
        u32x4 w; w[0] = pk2(s0[0], s0[1]); w[1] = pk2(s0[2], s0[3]); w[2] = pk2(s1[0], s1[1]); w[3] = pk2(s1[2], s1[3]);
        *(u32x4*)(p.ACT + (size_t)(NLAT + grow) * FF + gcol) = w;
    } else {
        const float* gate = p.mod + ((size_t)l * 5 + 4) * 6144 + (EK == 1 ? 2 : 5) * DM + gcol;
        float* xr = p.xc + (size_t)grow * DM + gcol;
        const f32x4 g0 = *(const f32x4*)gate, g1 = *(const f32x4*)(gate + 4);
        f32x4 x0 = *(const f32x4*)xr, x1 = *(const f32x4*)(xr + 4);
        x0 += g0 * s0; x1 += g1 * s1;
        *(f32x4*)xr = x0; *(f32x4*)(xr + 4) = x1;
        const int ln = EK == 1 ? l : l + 1;
        const float* gnx = (EK == 1 ? p.norm2_g : p.norm1_g) + (size_t)ln * DM + gcol;
        const float* scn = p.mod + ((size_t)ln * 5 + 4) * 6144 + (EK == 1 ? 4 : 1) * DM + gcol;
        const f32x4 a0 = *(const f32x4*)gnx * (1.f + *(const f32x4*)scn), a1 = *(const f32x4*)(gnx + 4) * (1.f + *(const f32x4*)(scn + 4));
        const f32x4 y0 = x0 * a0, y1 = x1 * a1;
        u32x4 w; w[0] = pk2(y0[0], y0[1]); w[1] = pk2(y0[2], y0[3]); w[2] = pk2(y1[0], y1[1]); w[3] = pk2(y1[2], y1[3]);
        *(u32x4*)(p.H + (size_t)(NLAT + grow) * DM + gcol) = w;
        float part = x0[0] * x0[0] + x0[1] * x0[1] + x0[2] * x0[2] + x0[3] * x0[3] + x1[0] * x1[0] + x1[1] * x1[1] + x1[2] * x1[2] + x1[3] * x1[3];
        part += __shfl_xor(part, 1); part += __shfl_xor(part, 2); part += __shfl_xor(part, 4);
        if (lead) p.ss[((size_t)(ln * 2 + (EK == 1 ? 1 : 0)) * NTOK + NLAT + grow) * 16 + slot] = part;
    }
}

template <int EK, int TS, int KS>
DI void ctx_tiles(const Params& p, int l, const bf16_t* __restrict__ A, const bf16_t* __restrict__ Bt, int N, int K, ldsp_t shm) {
    constexpr int WM = TS / 2, WN = TS / 4, MT = WM / 16, NT = WN / 16, BKC = 32 * KS;
    constexpr int TILE_A = TS * BKC * 2, PP = TILE_A / 8192;
    const int ntn = N / TS, ntiles = (NCTX / TS) * ntn, nt = K / BKC;
    for (int u = blockIdx.x; u < ntiles; u += gridDim.x) {
        const int tm = u / ntn, tn = u % ntn;
        int tid = threadIdx.x;
        asm volatile("" : "+v"(tid));
        const int wid = tid >> 6, lane = tid & 63, wr = wid >> 2, wc = wid & 3, fr = lane & 15, fq = lane >> 4;
        unsigned soff[PP];
#pragma unroll
        for (int i = 0; i < PP; ++i) { int sR, sC; stage_rc_ks<KS>((wid * PP + i) * 1024 + lane * 16, sR, sC); soff[i] = (unsigned)(sR * K + sC) * 2u; }
        const bf16_t* Ab = A + (size_t)tm * TS * K;
        const bf16_t* Bb = Bt + (size_t)tn * TS * K;
#define C_STAGE(buf, kt) do { const char* ab_ = (const char*)Ab + (size_t)(kt) * (BKC * 2); const char* bb_ = (const char*)Bb + (size_t)(kt) * (BKC * 2); \
      _Pragma("unroll") for (int i = 0; i < PP; ++i) { \
        __builtin_amdgcn_global_load_lds((const unsigned*)(ab_ + soff[i]), (LDSP unsigned*)(shm + (buf) * 2 * TILE_A + (wid * PP + i) * 1024), 16, 0, 0); \
        __builtin_amdgcn_global_load_lds((const unsigned*)(bb_ + soff[i]), (LDSP unsigned*)(shm + (buf) * 2 * TILE_A + TILE_A + (wid * PP + i) * 1024), 16, 0, 0); } } while (0)
        f32x4 acc[MT][NT];
#pragma unroll
        for (int m = 0; m < MT; ++m)
#pragma unroll
            for (int n = 0; n < NT; ++n) acc[m][n] = (f32x4){0.f, 0.f, 0.f, 0.f};
        const int aoff = lds_byte_ks<KS>(wr * WM + fr, fq * 8), boff = lds_byte_ks<KS>(wc * WN + fr, fq * 8);
        C_STAGE(0, 0); WAIT_V0(); __syncthreads();
        for (int t = 0; t < nt; ++t) {
            const int cur = t & 1;
            if (t + 1 < nt) C_STAGE(cur ^ 1, t + 1);
            ldsp_t sa = shm + cur * 2 * TILE_A, sb = sa + TILE_A;
#pragma unroll
            for (int ks = 0; ks < KS; ++ks) {
                bf16x8 At[MT], Bf[NT];
#pragma unroll
                for (int m = 0; m < MT; ++m) At[m] = *(const LDSP bf16x8*)(sa + aoff + m * (KS * 1024) + ks * 1024);
#pragma unroll
                for (int n = 0; n < NT; ++n) Bf[n] = *(const LDSP bf16x8*)(sb + boff + n * (KS * 1024) + ks * 1024);
#pragma unroll
                for (int m = 0; m < MT; ++m)
#pragma unroll
                    for (int n = 0; n < NT; ++n) acc[m][n] = __builtin_amdgcn_mfma_f32_16x16x32_bf16(Bf[n], At[m], acc[m][n], 0, 0, 0);
            }
            WAIT_V0(); __syncthreads();
        }
#pragma unroll
        for (int m = 0; m < MT; ++m)
#pragma unroll
            for (int n = 0; n < NT; ++n) {
                const int row = wr * WM + m * 16 + fr, ch = (wc * WN + n * 16 + fq * 4) >> 2;
                *(LDSP f32x4*)(shm + row * (TS * 4) + ((ch ^ (row & 15)) << 4)) = acc[m][n];
            }
        __syncthreads();
#pragma unroll
        for (int it = 0; it < (TS * TS / 8) / 512; ++it) {
            const int item = it * 512 + tid, row = item / (TS / 8), c8 = item % (TS / 8);
            const f32x4 s0 = *(const LDSP f32x4*)(shm + row * (TS * 4) + (((2 * c8) ^ (row & 15)) << 4));
            const f32x4 s1 = *(const LDSP f32x4*)(shm + row * (TS * 4) + (((2 * c8 + 1) ^ (row & 15)) << 4));
            ctx_item<EK>(p, l, tm * TS + row, tn * TS + c8 * 8, tn, s0, s1, c8 == 0);
        }
        __syncthreads();
    }
}

DI void attn_unit(const Params& p, int l, int b, int kvh, int qb, bool isctx, ldsp_t smem) {
    int tid = threadIdx.x;
    asm volatile("" : "+v"(tid));
    const int wid = tid >> 6, lane = tid & 63, r = lane & 31, hh = lane >> 5;
    const int head = kvh * 4 + (wid >> 1);
    const int t0 = qb * 64 + (wid & 1) * 32;
    const int nkeys = isctx ? CTXL : NKEY;
    const bf16_t* Qp = isctx ? p.Qc + ((size_t)(b * 8 + head) * CTXL + t0) * 64 : p.Q + ((size_t)(b * 8 + head) * SEQ + t0) * 64;
    const bf16_t* Kp = p.K + (size_t)(b * 2 + kvh) * NKEY * 64;
    const bf16_t* Vp = p.Vt + (size_t)(b * 2 + kvh) * 64 * NKEY;
    const int orow = isctx ? NLAT + b * CTXL + t0 : b * SEQ + t0;
    bf16_t* Op = p.MIX + (size_t)orow * DM + head * 64;
    const float cexp = p.smax[l] * LOG2E;

    bf16x8 qf[4];
#pragma unroll
    for (int ks = 0; ks < 4; ++ks) qf[ks] = *(const bf16x8*)(Qp + (size_t)r * 64 + ks * 16 + 8 * hh);
    f32x16 o[2];
#pragma unroll
    for (int i = 0; i < 16; ++i) { o[0][i] = 0.f; o[1][i] = 0.f; }
    float rs0 = 0.f, rs1 = 0.f;

    const int srow = tid >> 3, sch = tid & 7;
    const int kdst = srow * 128 + ((sch ^ ((srow >> 1) & 7)) << 4);
    const bf16_t* kg = Kp + (size_t)srow * 64 + sch * 8;
    const bf16_t* vg = Vp + (size_t)srow * NKEY + sch * 8;
    const int rsw = (r >> 1) & 7;
    const int ntile = nkeys / 64;

#define ATT_QK(SD, kb) do { _Pragma("unroll") for (int kt = 0; kt < 2; ++kt) { \
        _Pragma("unroll") for (int i = 0; i < 16; ++i) SD[kt][i] = -cexp; \
        _Pragma("unroll") for (int ks = 0; ks < 4; ++ks) { \
            const bf16x8 a_ = *(const LDSP bf16x8*)((kb) + (kt * 32 + r) * 128 + (((ks * 2 + hh) ^ rsw) << 4)); \
            SD[kt] = __builtin_amdgcn_mfma_f32_32x32x16_bf16(a_, qf[ks], SD[kt], 0, 0, 0); } } } while (0)

    u32x4 kst, vst;
    f32x16 sA[2], sB[2];
    {
        kst = *(const u32x4*)kg;
        *(LDSP u32x4*)(smem + kdst) = kst;
        kst = *(const u32x4*)(kg + (size_t)64 * 64);
        vst = *(const u32x4*)vg;
        __syncthreads();
        ATT_QK(sA, smem);
        *(LDSP u32x4*)(smem + 8192 + kdst) = kst;
        *(LDSP u32x4*)(smem + 16384 + kdst) = vst;
    }
#define ATT_STEP(t, SC, SN) do { \
        const int par = (t) & 1; \
        __syncthreads(); \
        { const int t2_ = (t) + 2 < ntile ? (t) + 2 : ntile - 1, t1_ = (t) + 1 < ntile ? (t) + 1 : ntile - 1; \
          kst = *(const u32x4*)(kg + (size_t)t2_ * 64 * 64); vst = *(const u32x4*)(vg + t1_ * 64); } \
        bf16x8 kf[8], vf[4], vh[4]; \
        ldsp_t kb_ = smem + (par ^ 1) * 8192; ldsp_t vb_ = smem + 16384 + par * 8192; \
        _Pragma("unroll") for (int kt = 0; kt < 2; ++kt) _Pragma("unroll") for (int ks = 0; ks < 4; ++ks) \
            kf[kt * 4 + ks] = *(const LDSP bf16x8*)(kb_ + (kt * 32 + r) * 128 + (((ks * 2 + hh) ^ rsw) << 4)); \
        _Pragma("unroll") for (int c = 0; c < 2; ++c) _Pragma("unroll") for (int dt = 0; dt < 2; ++dt) \
            vf[c * 2 + dt] = *(const LDSP bf16x8*)(vb_ + (dt * 32 + r) * 128 + (((c * 2 + hh) ^ rsw) << 4)); \
        __builtin_amdgcn_sched_barrier(0); \
        _Pragma("unroll") for (int kt = 0; kt < 2; ++kt) _Pragma("unroll") for (int i = 0; i < 16; ++i) SN[kt][i] = -cexp;     \
        _Pragma("unroll") for (int ks = 0; ks < 4; ++ks) _Pragma("unroll") for (int kt = 0; kt < 2; ++kt) \
            SN[kt] = __builtin_amdgcn_mfma_f32_32x32x16_bf16(kf[kt * 4 + ks], qf[ks], SN[kt], 0, 0, 0); \
        _Pragma("unroll") for (int c = 2; c < 4; ++c) _Pragma("unroll") for (int dt = 0; dt < 2; ++dt) \
            vh[(c - 2) * 2 + dt] = *(const LDSP bf16x8*)(vb_ + (dt * 32 + r) * 128 + (((c * 2 + hh) ^ rsw) << 4)); \
        __builtin_amdgcn_sched_barrier(0); \
        _Pragma("unroll") for (int kt = 0; kt < 2; ++kt) { \
            _Pragma("unroll") for (int i = 0; i < 16; ++i) { \
                const float e_ = fexp2(SC[kt][i]); \
                if (i & 1) rs1 += e_; else rs0 += e_; \
                SC[kt][i] = e_; } } \
        _Pragma("unroll") for (int c = 0; c < 4; ++c) { \
            u32x4 pw; \
            pw[0] = pk2(SC[c >> 1][8 * (c & 1) + 0], SC[c >> 1][8 * (c & 1) + 1]); pw[1] = pk2(SC[c >> 1][8 * (c & 1) + 2], SC[c >> 1][8 * (c & 1) + 3]); \
            pw[2] = pk2(SC[c >> 1][8 * (c & 1) + 4], SC[c >> 1][8 * (c & 1) + 5]); pw[3] = pk2(SC[c >> 1][8 * (c & 1) + 6], SC[c >> 1][8 * (c & 1) + 7]); \
            const bf16x8 pb = __builtin_bit_cast(bf16x8, pw); \
            _Pragma("unroll") for (int dt = 0; dt < 2; ++dt) o[dt] = __builtin_amdgcn_mfma_f32_32x32x16_bf16(c < 2 ? vf[c * 2 + dt] : vh[(c - 2) * 2 + dt], pb, o[dt], 0, 0, 0); } \
        *(LDSP u32x4*)(smem + par * 8192 + kdst) = kst; \
        *(LDSP u32x4*)(smem + 16384 + (par ^ 1) * 8192 + kdst) = vst; \
    } while (0)

    for (int t = 0; t < ntile; t += 2) {
        ATT_STEP(t, sA, sB);
        ATT_STEP(t + 1, sB, sA);
    }
    const float lrun = rs0 + rs1;
    const float ltot = lrun + __shfl_xor(lrun, 32);
    const float inv = 1.f / ltot;
#pragma unroll
    for (int dt = 0; dt < 2; ++dt)
#pragma unroll
        for (int g4 = 0; g4 < 4; ++g4) {
            u32x2 w; w[0] = pk2(o[dt][4 * g4 + 0] * inv, o[dt][4 * g4 + 1] * inv); w[1] = pk2(o[dt][4 * g4 + 2] * inv, o[dt][4 * g4 + 3] * inv);
            *(u32x2*)(Op + (size_t)r * DM + dt * 32 + 8 * g4 + 4 * hh) = w;
        }
    __syncthreads();
}

DI void gmlp_unit(const Params& p, int l, int T, int g, ldsp_t smem) {
    int tid = threadIdx.x;
    asm volatile("" : "+v"(tid));
    const int wid = tid >> 6, lane = tid & 63, fr = lane & 15, fq = lane >> 4;
    {
        const int q = tid >> 2, part = tid & 3;
        const bf16_t* src = p.U + (size_t)(T * 128 + q) * 1024 + 512 + g * 128 + part * 32;
        u32x4 raw[4];
#pragma unroll
        for (int i = 0; i < 4; ++i) raw[i] = *(const u32x4*)(src + i * 8);
        float a = 0.f, b = 0.f;
#pragma unroll
        for (int i = 0; i < 4; ++i)
#pragma unroll
            for (int j = 0; j < 4; ++j) {
                const float lo = __uint_as_float(raw[i][j] << 16), hi = __uint_as_float(raw[i][j] & 0xffff0000u);
                a += lo + hi; b += lo * lo + hi * hi;
            }
        a += __shfl_xor(a, 1); a += __shfl_xor(a, 2);
        b += __shfl_xor(b, 1); b += __shfl_xor(b, 2);
        const float mean = a * (1.f / 128.f);
        const float rstd = rsqrtf(fmaxf(b * (1.f / 128.f) - mean * mean, 0.f) + EPS);
        const float* gn = p.gmlp_norm_g + l * 512 + g * 128 + part * 32;
#pragma unroll
        for (int i = 0; i < 4; ++i)
#pragma unroll
            for (int j = 0; j < 4; ++j) {
                const int c0 = part * 32 + i * 8 + j * 2;
                const float lo = __uint_as_float(raw[i][j] << 16), hi = __uint_as_float(raw[i][j] & 0xffff0000u);
                const unsigned w = pk2((lo - mean) * rstd * gn[i * 8 + j * 2], (hi - mean) * rstd * gn[i * 8 + j * 2 + 1]);
                *(LDSP bf16_t*)(smem + c0 * 256 + (((q >> 3) ^ (c0 & 15)) << 4) + (q & 7) * 2) = (bf16_t)(w & 0xffffu);
                *(LDSP bf16_t*)(smem + (c0 + 1) * 256 + (((q >> 3) ^ ((c0 + 1) & 15)) << 4) + (q & 7) * 2) = (bf16_t)(w >> 16);
            }
    }
    __syncthreads();
    const int prow = wid * 16 + fr;
    const bf16_t* wsp = p.ws_bf + ((size_t)(l * 4 + g) * 128 + prow) * 128 + fq * 8;
    bf16x8 a[4];
#pragma unroll
    for (int ks = 0; ks < 4; ++ks) a[ks] = *(const bf16x8*)(wsp + ks * 32);
    f32x4 acc[8];
#pragma unroll
    for (int n = 0; n < 8; ++n) {
        acc[n] = (f32x4){0.f, 0.f, 0.f, 0.f};
        const int c = n * 16 + fr;
#pragma unroll
        for (int ks = 0; ks < 4; ++ks) {
            const bf16x8 bq = *(const LDSP bf16x8*)(smem + c * 256 + (((ks * 4 + fq) ^ (c & 15)) << 4));
            acc[n] = __builtin_amdgcn_mfma_f32_16x16x32_bf16(bq, a[ks], acc[n], 0, 0, 0);
        }
    }
    const float bs = p.b_spatial[(size_t)(l * 4 + g) * 128 + prow];
    const int row = T * 128 + prow;
    const bf16_t* up = p.U + (size_t)row * 1024 + g * 128 + fq * 4;
    bf16_t* mp = p.MIX + (size_t)row * DM + 512 + g * 128 + fq * 4;
#pragma unroll
    for (int n = 0; n < 8; ++n) {
        const u32x2 uu = *(const u32x2*)(up + n * 16);
        const float u0 = __uint_as_float(uu[0] << 16), u1 = __uint_as_float(uu[0] & 0xffff0000u), u2 = __uint_as_float(uu[1] << 16), u3 = __uint_as_float(uu[1] & 0xffff0000u);
        u32x2 w; w[0] = pk2((acc[n][0] + bs) * u0, (acc[n][1] + bs) * u1); w[1] = pk2((acc[n][2] + bs) * u2, (acc[n][3] + bs) * u3);
        *(u32x2*)(mp + n * 16) = w;
    }
    __syncthreads();
}

DI void mixer_phase(const Params& p, int l, ldsp_t smem) {
    const bool last = l == DEPTH - 1;
    for (int u = blockIdx.x; u < 512; u += gridDim.x) attn_unit(p, l, (u & 7) >> 1, u & 1, u >> 3, false, smem);
    if (!last)
        for (int u = blockIdx.x; u < 32; u += gridDim.x) attn_unit(p, l, (u & 7) >> 1, u & 1, u >> 3, true, smem);
    const int nT = last ? 128 : 136;
    for (int u = blockIdx.x; u < nT * 4; u += gridDim.x) gmlp_unit(p, l, u >> 2, u & 3, smem);
}

DI void grid_barrier(unsigned* bar, unsigned k) {
    asm volatile("s_waitcnt vmcnt(0)" ::: "memory");
    __syncthreads();
    if (threadIdx.x == 0) {
        __builtin_amdgcn_fence(__ATOMIC_RELEASE, "agent");
        asm volatile("s_waitcnt vmcnt(0)" ::: "memory");
        const unsigned j = blockIdx.x & 7u, G = gridDim.x;
        const unsigned nsub = (G - j + 7u) >> 3, ngrp = G < 8u ? G : 8u;
        const unsigned old = __hip_atomic_fetch_add(bar + 64 * (1 + j), 1u, __ATOMIC_RELAXED, __HIP_MEMORY_SCOPE_AGENT);
        if (old + 1u == k * nsub) __hip_atomic_fetch_add(bar, 1u, __ATOMIC_RELAXED, __HIP_MEMORY_SCOPE_AGENT);
        unsigned sp = 0;
        while (__hip_atomic_load(bar, __ATOMIC_RELAXED, __HIP_MEMORY_SCOPE_AGENT) < k * ngrp) { __builtin_amdgcn_s_sleep(1); if (++sp > (1u << 22)) break; }
        __builtin_amdgcn_fence(__ATOMIC_ACQUIRE, "agent");
        asm volatile("s_waitcnt vmcnt(0)" ::: "memory");
    }
    __syncthreads();
}

constexpr int N_PHASES = 2 + DEPTH * 5;
DI void run_phase(const Params& p, int ph, ldsp_t smem) {
    if (ph == 0) { phase0(p, smem); return; }
    if (ph == 1) { phase1(p); return; }
    const int l = (ph - 2) / 5, k = (ph - 2) % 5;
    const bool last = l == DEPTH - 1;
    switch (k) {
        case 0: gemm_stream<0>(p, l, p.H, p.wt_in + (size_t)l * IN_DIM * DM, NTOK, IN_DIM, DM, smem); break;
        case 1: mixer_phase(p, l, smem); break;
        case 2: gemm_stream<1>(p, l, p.MIX, p.wt_out + (size_t)l * DM * DM, NLAT, DM, DM, smem);
                if (!last) ctx_tiles<1, 64, 8>(p, l, p.MIX + (size_t)NLAT * DM, p.wt_out + (size_t)l * DM * DM, DM, DM, smem);
                break;
        case 3: gemm_stream<2>(p, l, p.H, p.wt_ff1 + (size_t)l * FF * DM, NLAT, FF, DM, smem);
                if (!last) ctx_tiles<2, 128, 4>(p, l, p.H + (size_t)NLAT * DM, p.wt_ff1 + (size_t)l * FF * DM, FF, DM, smem);
                break;
        default: gemm_stream<3>(p, l, p.ACT, p.wt_ff2 + (size_t)l * DM * FF, NLAT, DM, FF, smem);
                if (!last) ctx_tiles<3, 64, 8>(p, l, p.ACT + (size_t)NLAT * FF, p.wt_ff2 + (size_t)l * DM * FF, DM, FF, smem);
                break;
    }
}

template <bool COOP>
__global__ void __launch_bounds__(512) mk_kernel(Params p, int ph_lo, int ph_hi) {
    __shared__ __attribute__((aligned(1024))) char smem_raw[2 * G_STAGE_B + 8192];
    ldsp_t smem = (ldsp_t)smem_raw;
    for (int ph = ph_lo; ph < ph_hi; ++ph) {
        run_phase(p, ph, smem);
#ifdef DUP_K
        if (ph > 1 && (ph - 2) % 5 == DUP_K) { cg::this_grid().sync(); run_phase(p, ph, smem); }
#endif
        if (COOP && ph + 1 < ph_hi) {
            if (ph == 0) cg::this_grid().sync();
            else grid_barrier(p.bar, (unsigned)ph);
        }
    }
}

extern "C" void kernel_launch(void* const* d_in, const int* in_sizes, int n_in, void* d_out, int out_size, void* d_ws, size_t ws_size, hipStream_t stream) {
    Params p{};
    p.x = (const float*)d_in[0]; p.c = (const float*)d_in[1]; p.ctx = (const float*)d_in[2]; p.c_ctx = (const float*)d_in[3];
    p.w_mod = (const float*)d_in[4]; p.b_mod = (const float*)d_in[5]; p.norm1_g = (const float*)d_in[6]; p.w_in = (const float*)d_in[7];
    p.q_norm_g = (const float*)d_in[8]; p.k_norm_g = (const float*)d_in[9]; p.gmlp_norm_g = (const float*)d_in[10]; p.w_spatial = (const float*)d_in[11];
    p.b_spatial = (const float*)d_in[12]; p.w_out = (const float*)d_in[13]; p.norm2_g = (const float*)d_in[14]; p.w_ff1 = (const float*)d_in[15]; p.w_ff2 = (const float*)d_in[16];
    p.out = (float*)d_out;
    char* w = (char*)d_ws; size_t off = 0;
    auto take = [&](size_t bytes) { char* r = w + off; off += (bytes + 1023) & ~(size_t)1023; return r; };
    p.wt_in = (bf16_t*)take((size_t)DEPTH * IN_DIM * DM * 2);
    p.wt_out = (bf16_t*)take((size_t)DEPTH * DM * DM * 2);
    p.wt_ff1 = (bf16_t*)take((size_t)DEPTH * FF * DM * 2);
    p.wt_ff2 = (bf16_t*)take((size_t)DEPTH * FF * DM * 2);
    p.ws_bf = (bf16_t*)take((size_t)DEPTH * 4 * 128 * 128 * 2);
    p.mod = (float*)take((size_t)DEPTH * 5 * 6144 * 4);
    p.rope = (float*)take(2048 * 4);
    p.xc = (float*)take((size_t)NCTX * DM * 4);
    p.smax = (float*)take(1024);
    p.bar = (unsigned*)take(4096);
    p.ss = (float*)take((size_t)DEPTH * 2 * NTOK * 16 * 4);
    p.shw_in = (float*)take((size_t)DEPTH * 5 * IN_DIM * 4);
    p.shw_ff1 = (float*)take((size_t)DEPTH * 5 * FF * 4);
    p.H = (bf16_t*)take((size_t)NTOK * DM * 2);
    p.ACT = (bf16_t*)take((size_t)NTOK * FF * 2);
    {
        char* a = (char*)p.ACT; size_t o2 = 0;
        auto take2 = [&](size_t bytes) { char* r = a + o2; o2 += (bytes + 1023) & ~(size_t)1023; return r; };
        p.Q = (bf16_t*)take2((size_t)NLAT * 512 * 2);
        p.Qc = (bf16_t*)take2((size_t)NCTX * 512 * 2);
        p.K = (bf16_t*)take2((size_t)NB * 2 * NKEY * 64 * 2);
        p.Vt = (bf16_t*)take2((size_t)NB * 2 * NKEY * 64 * 2);
        p.U = (bf16_t*)take2((size_t)NTOK * 1024 * 2);
        p.MIX = (bf16_t*)take2((size_t)NTOK * DM * 2);
    }
    if (off > ws_size) { fprintf(stderr, "workspace too small: need %zu have %zu\n", off, ws_size); return; }
#if MK_COOP
    static int grid_blocks = 0;
    if (!grid_blocks) {
        int dev = 0, cus = 0, per_cu = 0;
        hipGetDevice(&dev);
        hipDeviceGetAttribute(&cus, hipDeviceAttributeMultiprocessorCount, dev);
        hipOccupancyMaxActiveBlocksPerMultiprocessor(&per_cu, mk_kernel<true>, 512, 0);
        if (per_cu < 1) per_cu = 1;
        grid_blocks = cus * 1;
    }
    int lo = 0, hi = N_PHASES;
    void* args[] = {&p, &lo, &hi};
    hipError_t e = hipLaunchCooperativeKernel((void*)mk_kernel<true>, dim3(grid_blocks), dim3(512), args, 0, stream);
    if (e != hipSuccess) fprintf(stderr, "cooperative launch failed: %s (grid %d)\n", hipGetErrorString(e), grid_blocks);
#else
    for (int ph = 0; ph < N_PHASES; ++ph) mk_kernel<false><<<256, 512, 0, stream>>>(p, ph, ph + 1);
#endif
}
```

```cpp
#include <hip/hip_runtime.h>
#include <hip/hip_cooperative_groups.h>
#include <stdint.h>
#include <cstdio>
namespace cg = cooperative_groups;

#ifndef MK_COOP
#define MK_COOP 1
#endif

#define DI __device__ __forceinline__
#define LDSP __attribute__((address_space(3)))
typedef LDSP char* ldsp_t;
typedef unsigned short bf16_t;
typedef short bf16x8 __attribute__((ext_vector_type(8)));
typedef float f32x2 __attribute__((ext_vector_type(2)));
typedef float f32x4 __attribute__((ext_vector_type(4)));
typedef float f32x16 __attribute__((ext_vector_type(16)));
typedef unsigned u32x2 __attribute__((ext_vector_type(2)));
typedef unsigned u32x4 __attribute__((ext_vector_type(4)));
typedef __bf16 bf2_t __attribute__((ext_vector_type(2)));

constexpr int DM = 1024, NB = 4, SEQ = 4096, DEPTH = 4, CTXL = 256;
constexpr int NLAT = NB * SEQ;
constexpr int NCTX = NB * CTXL;
constexpr int NTOK = NLAT + NCTX;
constexpr int IN_DIM = 1792, FF = 4096, NKEY = CTXL + SEQ;
constexpr float EPS = 1e-6f;
constexpr float LOG2E = 1.4426950408889634f;

struct Params {
    const float *x, *c, *ctx, *c_ctx, *w_mod, *b_mod, *norm1_g, *w_in, *q_norm_g, *k_norm_g, *gmlp_norm_g, *w_spatial, *b_spatial, *w_out, *norm2_g, *w_ff1, *w_ff2;
    float* out;
    bf16_t *wt_in, *wt_out, *wt_ff1, *wt_ff2, *ws_bf;
    float *mod, *rope, *xc, *smax, *ss, *shw_in, *shw_ff1;
    unsigned* bar;
    bf16_t *H, *Q, *Qc, *K, *Vt, *U, *MIX, *ACT;
};

DI unsigned pk2(float a, float b) { f32x2 v = {a, b}; bf2_t r = __builtin_convertvector(v, bf2_t); return __builtin_bit_cast(unsigned, r); }
DI bf16_t f2bf(float a) { return (bf16_t)(pk2(a, 0.f) & 0xffffu); }
DI float fexp2(float x) { return __builtin_amdgcn_exp2f(x); }
DI float gelu_tanh(float x) {
    const float y = 0.7978845608028654f * (x + 0.044715f * x * x * x);
    return x * __builtin_amdgcn_rcpf(1.f + fexp2(-2.f * LOG2E * y));
}
DI float* xrow_ptr(const Params& p, int row) { return row < NLAT ? p.out + (size_t)row * DM : p.xc + (size_t)(row - NLAT) * DM; }

DI void transpose_tile(const float* __restrict__ src, bf16_t* __restrict__ dst, int K, int N, int tk, int tn, ldsp_t smem) {
    LDSP float* t = (LDSP float*)smem;
    int tid = threadIdx.x;
    asm volatile("" : "+v"(tid));
    const int k0 = tk * 64, n0 = tn * 256;
    f32x4 v[8];
#pragma unroll
    for (int i = 0; i < 8; ++i) v[i] = *(const f32x4*)(src + (size_t)(k0 + (tid >> 6) + 8 * i) * N + n0 + (tid & 63) * 4);
#pragma unroll
    for (int i = 0; i < 8; ++i) {
        const int k = (tid >> 6) + 8 * i, n4 = (tid & 63) * 4;
        t[k * 257 + n4 + 0] = v[i][0]; t[k * 257 + n4 + 1] = v[i][1]; t[k * 257 + n4 + 2] = v[i][2]; t[k * 257 + n4 + 3] = v[i][3];
    }
    __syncthreads();
#pragma unroll
    for (int j = 0; j < 4; ++j) {
        const int n = (tid >> 3) + 64 * j, k8 = (tid & 7) * 8;
        u32x4 w;
        w[0] = pk2(t[(k8 + 0) * 257 + n], t[(k8 + 1) * 257 + n]);
        w[1] = pk2(t[(k8 + 2) * 257 + n], t[(k8 + 3) * 257 + n]);
        w[2] = pk2(t[(k8 + 4) * 257 + n], t[(k8 + 5) * 257 + n]);
        w[3] = pk2(t[(k8 + 6) * 257 + n], t[(k8 + 7) * 257 + n]);
        *(u32x4*)(dst + (size_t)(n0 + n) * K + k0 + k8) = w;
    }
    __syncthreads();
}

DI void mod_unit(const Params& p, int l, int cgi, ldsp_t smem) {
    LDSP float* s = (LDSP float*)smem;
    LDSP float* red = (LDSP float*)(smem + 20480);
    int tid = threadIdx.x;
    asm volatile("" : "+v"(tid));
    for (int i = tid; i < 5 * 1024; i += 512) {
        const int cnd = i >> 10, k = i & 1023;
        const float v = cnd < 4 ? p.c[cnd * 1024 + k] : p.c_ctx[k];
        s[i] = v / (1.f + fexp2(-LOG2E * v));
    }
    __syncthreads();
    const int c4 = tid & 15, ks = tid >> 4;
    f32x4 acc[5];
#pragma unroll
    for (int q = 0; q < 5; ++q) acc[q] = (f32x4){0.f, 0.f, 0.f, 0.f};
    const float* wp = p.w_mod + ((size_t)l * 1024 + ks * 32) * 6144 + cgi * 64 + c4 * 4;
#pragma unroll 8
    for (int kk = 0; kk < 32; ++kk) {
        const f32x4 w = *(const f32x4*)(wp + (size_t)kk * 6144);
        const int k = ks * 32 + kk;
#pragma unroll
        for (int q = 0; q < 5; ++q) acc[q] += w * s[q * 1024 + k];
    }
#pragma unroll
    for (int q = 0; q < 5; ++q)
#pragma unroll
        for (int j = 0; j < 4; ++j) red[(ks * 5 + q) * 64 + c4 * 4 + j] = acc[q][j];
    __syncthreads();
    if (tid < 320) {
        const int q = tid >> 6, col = tid & 63;
        float a = 0.f;
        for (int k2 = 0; k2 < 32; ++k2) a += red[(k2 * 5 + q) * 64 + col];
        const int j = cgi * 64 + col;
        p.mod[((size_t)l * 5 + q) * 6144 + j] = a + p.b_mod[(size_t)l * 6144 + j];
    }
    __syncthreads();
}

DI void phase0(const Params& p, ldsp_t smem) {
    constexpr int T_IN = 16 * 7, T_OUT = 16 * 4, T_FF1 = 16 * 16, T_FF2 = 64 * 4;
    constexpr int T_L = T_IN + T_OUT + T_FF1 + T_FF2;
    constexpr int U_T = DEPTH * T_L;
    constexpr int U_MOD = DEPTH * 96;
    constexpr int U_WS = 64;
    constexpr int U_ALL = U_MOD + U_T + U_WS + 1;
    for (int u = blockIdx.x; u < U_ALL; u += gridDim.x) {
        if (u < U_MOD) { mod_unit(p, u / 96, u % 96, smem); continue; }
        int v = u - U_MOD;
        if (v < U_T) {
            const int l = v / T_L; int r = v % T_L;
            if (r < T_IN) { transpose_tile(p.w_in + (size_t)l * DM * IN_DIM, p.wt_in + (size_t)l * IN_DIM * DM, DM, IN_DIM, r / 7, r % 7, smem); continue; }
            r -= T_IN;
            if (r < T_OUT) { transpose_tile(p.w_out + (size_t)l * DM * DM, p.wt_out + (size_t)l * DM * DM, DM, DM, r / 4, r % 4, smem); continue; }
            r -= T_OUT;
            if (r < T_FF1) { transpose_tile(p.w_ff1 + (size_t)l * DM * FF, p.wt_ff1 + (size_t)l * FF * DM, DM, FF, r / 16, r % 16, smem); continue; }
            r -= T_FF1;
            transpose_tile(p.w_ff2 + (size_t)l * FF * DM, p.wt_ff2 + (size_t)l * DM * FF, FF, DM, r / 4, r % 4, smem); continue;
        }
        v -= U_T;
        if (v < U_WS) {
            int tw = threadIdx.x;
            asm volatile("" : "+v"(tw));
            const size_t i = ((size_t)v * 512 + tw) * 8;
            const f32x4 a = *(const f32x4*)(p.w_spatial + i), b = *(const f32x4*)(p.w_spatial + i + 4);
            u32x4 w; w[0] = pk2(a[0], a[1]); w[1] = pk2(a[2], a[3]); w[2] = pk2(b[0], b[1]); w[3] = pk2(b[2], b[3]);
            *(u32x4*)(p.ws_bf + i) = w;
            continue;
        }
        int ti = threadIdx.x;
        asm volatile("" : "+v"(ti));
        if (ti >= 64 && ti < 64 + 9) p.bar[(ti - 64) * 64] = 0u;
        if (ti < DEPTH) {
            float mq = 0.f, mk = 0.f;
            for (int i = 0; i < 64; ++i) { mq = fmaxf(mq, fabsf(p.q_norm_g[ti * 64 + i])); mk = fmaxf(mk, fabsf(p.k_norm_g[ti * 64 + i])); }
            p.smax[ti] = 8.f * mq * mk;
        }
        for (int i = ti; i < 1024; i += 512) {
            const int pos = i >> 4, f = i & 15;
            const float inv = fexp2(-(float)f * (13.287712379549449f / 16.f));
            const float rev = (float)pos * inv * 0.15915494309189535f;
            p.rope[i] = __builtin_amdgcn_cosf(rev);
            p.rope[1024 + i] = __builtin_amdgcn_sinf(rev);
        }
    }
}

DI void phase1(const Params& p) {
    int tid = threadIdx.x;
    asm volatile("" : "+v"(tid));
    const int lane = tid & 63, wid = tid >> 6;
    const int gw = blockIdx.x * 8 + wid, nw = gridDim.x * 8;
    for (int row = gw; row < NTOK; row += nw) {
        const float* src = row < NLAT ? p.x + (size_t)row * DM : p.ctx + (size_t)(row - NLAT) * DM;
        const int cond = row < NLAT ? (row >> 12) : 4;
        const float* mp = p.mod + ((size_t)cond) * 6144;
        f32x4 v[4];
        float ss = 0.f;
#pragma unroll
        for (int i = 0; i < 4; ++i) { v[i] = *(const f32x4*)(src + i * 256 + lane * 4); ss += v[i][0] * v[i][0] + v[i][1] * v[i][1] + v[i][2] * v[i][2] + v[i][3] * v[i][3]; }
#pragma unroll
        for (int o = 1; o < 64; o <<= 1) ss += __shfl_xor(ss, o);
        if (lane < 16) p.ss[(size_t)row * 16 + lane] = lane == 0 ? ss : 0.f;
        bf16_t* hp = p.H + (size_t)row * DM;
        float* xw = xrow_ptr(p, row);
#pragma unroll
        for (int i = 0; i < 4; ++i) {
            const int idx = i * 256 + lane * 4;
            const f32x4 gg = *(const f32x4*)(p.norm1_g + idx), sc = *(const f32x4*)(mp + DM + idx);
            f32x4 y;
#pragma unroll
            for (int j = 0; j < 4; ++j) y[j] = v[i][j] * gg[j] * (1.f + sc[j]);
            u32x2 w; w[0] = pk2(y[0], y[1]); w[1] = pk2(y[2], y[3]);
            *(u32x2*)(hp + idx) = w;
            *(f32x4*)(xw + idx) = v[i];
        }
    }
    {
        const int fr = lane & 15, fq = lane >> 4;
        constexpr int G_IN = IN_DIM / 16, G_FF = FF / 16, G_L = G_IN + G_FF;
        for (int gi = gw; gi < DEPTH * G_L; gi += nw) {
            const int l = gi / G_L, r = gi % G_L;
            const bool which = r >= G_IN;
            const int n0 = (which ? r - G_IN : r) * 16;
            const int N = which ? FF : IN_DIM;
            const bf16_t* W = (which ? p.wt_ff1 + (size_t)l * FF * DM : p.wt_in + (size_t)l * IN_DIM * DM) + (size_t)(n0 + fr) * DM + fq * 8;
            float* dst = which ? p.shw_ff1 + (size_t)l * 5 * FF : p.shw_in + (size_t)l * 5 * IN_DIM;
            const int c = fr < 5 ? fr : fr - 5;
            const float* sh = p.mod + ((size_t)l * 5 + (c < 5 ? c : 0)) * 6144 + (which ? 3 : 0) * DM + fq * 8;
            f32x4 acc = {0.f, 0.f, 0.f, 0.f};
#pragma unroll 8
            for (int ks = 0; ks < 32; ++ks) {
                const bf16x8 wv = *(const bf16x8*)(W + ks * 32);
                const f32x4 s0 = *(const f32x4*)(sh + ks * 32), s1 = *(const f32x4*)(sh + ks * 32 + 4);
                float sv[8] = {s0[0], s0[1], s0[2], s0[3], s1[0], s1[1], s1[2], s1[3]};
                u32x4 aw;
#pragma unroll
                for (int j = 0; j < 4; ++j) {
                    float a0 = sv[2 * j], a1 = sv[2 * j + 1];
                    const unsigned hi = pk2(a0, a1);
                    if (fr >= 5) { a0 -= __uint_as_float(hi << 16); a1 -= __uint_as_float(hi & 0xffff0000u); }
                    aw[j] = fr < 5 ? hi : (fr < 10 ? pk2(a0, a1) : 0u);
                }
                acc = __builtin_amdgcn_mfma_f32_16x16x32_bf16(__builtin_bit_cast(bf16x8, aw), wv, acc, 0, 0, 0);
            }
            const float r4 = __shfl(acc[0], fr + 16);
            const float r5 = __shfl(acc[1], fr + 16), r6 = __shfl(acc[2], fr + 16), r7 = __shfl(acc[3], fr + 16);
            const float r8 = __shfl(acc[0], fr + 32), r9 = __shfl(acc[1], fr + 32);
            if (fq == 0) {
                dst[(size_t)0 * N + n0 + fr] = acc[0] + r5;
                dst[(size_t)1 * N + n0 + fr] = acc[1] + r6;
                dst[(size_t)2 * N + n0 + fr] = acc[2] + r7;
                dst[(size_t)3 * N + n0 + fr] = acc[3] + r8;
                dst[(size_t)4 * N + n0 + fr] = r4 + r9;
            }
        }
    }
}

constexpr int G_TILE_B = 256 * 64 * 2, G_STAGE_B = 2 * G_TILE_B;
DI int lds_byte2(int r, int c) {
    const int st = (r >> 4) * 2 + (c >> 5), ob = (r & 15) * 64 + (c & 31) * 2;
    return st * 1024 + (ob ^ (((ob >> 9) & 1) << 5));
}
DI void stage_rc2(int b, int& R, int& C) {
    const int st = b >> 10, sb = b & 1023, swz = sb ^ (((sb >> 9) & 1) << 5);
    R = (st >> 1) * 16 + swz / 64;
    C = (st & 1) * 32 + (swz % 64) / 2;
}
template <int KS> DI int lds_byte_ks(int r, int c) {
    const int st = (r >> 4) * KS + (c >> 5), ob = (r & 15) * 64 + (c & 31) * 2;
    return st * 1024 + (ob ^ (((ob >> 9) & 1) << 5));
}
template <int KS> DI void stage_rc_ks(int b, int& R, int& C) {
    const int st = b >> 10, sb = b & 1023, swz = sb ^ (((sb >> 9) & 1) << 5);
    R = (st / KS) * 16 + swz / 64;
    C = (st % KS) * 32 + (swz % 64) / 2;
}
#define WAIT_V0() asm volatile("s_waitcnt vmcnt(0)" ::: "memory")

struct TileCtx { int brow, bcol, pn, wr, wc, fr, fq, wid, lane, l; };

DI void tile_coords(int L, int nM, int nN, int& pm, int& pn) {
    const int nwg = nM * nN;
    int wgid = L;
    { const int q = nwg / 8, r = nwg % 8, xcd = wgid % 8, off = wgid / 8; wgid = (xcd < r ? xcd * (q + 1) : r * (q + 1) + (xcd - r) * q) + off; }
    const int nig = 8 * nN, gid = wgid / nig, fm = gid * 8, gsz = (nM - fm) < 8 ? (nM - fm) : 8;
    pm = fm + ((wgid % nig) % gsz); pn = (wgid % nig) / gsz;
}

DI void wave_put(ldsp_t wb, int rowl, int n, int fq, u32x2 w) {
    const int chunk = n * 2 + (fq >> 1);
    *(LDSP u32x2*)(wb + rowl * 128 + ((chunk ^ (rowl & 7)) << 4) + (fq & 1) * 8) = w;
}
DI void wave_rows_store(ldsp_t wb, int lane, bf16_t* dst0, size_t ld) {
#pragma unroll
    for (int i = 0; i < 8; ++i) {
        const int row = i * 8 + (lane >> 3), ch = lane & 7;
        const u32x4 v = *(const LDSP u32x4*)(wb + row * 128 + ((ch ^ (row & 7)) << 4));
        *(u32x4*)(dst0 + (size_t)row * ld + ch * 8) = v;
    }
}

template <int EK> struct EpiResid {
    static DI void run(const f32x4 (&acc)[8][4], const TileCtx& tc, const Params& p, ldsp_t wb) {
        constexpr int GI = EK == 1 ? 2 : 5;
        const int cond = tc.brow < NLAT ? (tc.brow >> 12) : 4;
        const float* gate = p.mod + ((size_t)tc.l * 5 + cond) * 6144 + GI * DM;
        const int col0 = tc.bcol + tc.wc * 64 + tc.fq * 4;
        const bool has_next = EK == 1 || tc.l + 1 < DEPTH;
        const int ln = EK == 1 ? tc.l : (has_next ? tc.l + 1 : tc.l);
        const float* gnx = (EK == 1 ? p.norm2_g : p.norm1_g) + (size_t)ln * DM + col0;
        const float* scn = p.mod + ((size_t)ln * 5 + cond) * 6144 + (EK == 1 ? 4 : 1) * DM + col0;
        float* ssp = p.ss + (size_t)(ln * 2 + (EK == 1 ? 1 : 0)) * NTOK * 16 + (tc.bcol >> 8) * 4 + tc.wc;
        f32x4 gv[4], av[4];
#pragma unroll
        for (int n = 0; n < 4; ++n) {
            gv[n] = *(const f32x4*)(gate + col0 + n * 16);
            const f32x4 g1 = *(const f32x4*)(gnx + n * 16), s1 = *(const f32x4*)(scn + n * 16);
            av[n] = g1 * (1.f + s1);
        }
#pragma unroll
        for (int h = 0; h < 2; ++h) {
#pragma unroll
            for (int mm = 0; mm < 4; ++mm) { __builtin_amdgcn_sched_barrier(0);
                const int m = h * 4 + mm;
                const int row = tc.brow + tc.wr * 128 + m * 16 + tc.fr;
                float* xr = xrow_ptr(p, row) + col0;
                float part = 0.f;
#pragma unroll
                for (int n = 0; n < 4; ++n) {
                    f32x4 xv = *(const f32x4*)(xr + n * 16);
                    xv += gv[n] * acc[m][n];
                    *(f32x4*)(xr + n * 16) = xv;
                    if (has_next) {
                        part += xv[0] * xv[0] + xv[1] * xv[1] + xv[2] * xv[2] + xv[3] * xv[3];
                        const f32x4 hv = xv * av[n];
                        u32x2 w; w[0] = pk2(hv[0], hv[1]); w[1] = pk2(hv[2], hv[3]);
                        wave_put(wb, mm * 16 + tc.fr, n, tc.fq, w);
                    }
                }
                if (has_next) {
                    part += __shfl_xor(part, 16);
                    part += __shfl_xor(part, 32);
                    if (tc.fq == 0) ssp[(size_t)row * 16] = part;
                }
            }
            if (has_next) wave_rows_store(wb, tc.lane, p.H + (size_t)(tc.brow + tc.wr * 128 + h * 64) * DM + tc.bcol + tc.wc * 64, DM);
        }
    }
};
struct EpiFF1 {
    static DI void run(const f32x4 (&acc)[8][4], const TileCtx& tc, const Params& p, ldsp_t wb) {
#pragma unroll
        for (int h = 0; h < 2; ++h) {
#pragma unroll
            for (int mm = 0; mm < 4; ++mm) {
                const int m = h * 4 + mm;
#pragma unroll
                for (int n = 0; n < 4; ++n) {
                    f32x4 a = acc[m][n];
#pragma unroll
                    for (int j = 0; j < 4; ++j) { const float r = fmaxf(a[j], 0.f); a[j] = r * r; }
                    u32x2 w; w[0] = pk2(a[0], a[1]); w[1] = pk2(a[2], a[3]);
                    wave_put(wb, mm * 16 + tc.fr, n, tc.fq, w);
                }
            }
            wave_rows_store(wb, tc.lane, p.ACT + (size_t)(tc.brow + tc.wr * 128 + h * 64) * FF + tc.bcol + tc.wc * 64, FF);
        }
    }
};
template <int BRK> struct EpiIn {
    static DI void run(const f32x4 (&acc)[8][4], const TileCtx& tc, const Params& p, ldsp_t wb) {
        const int l = tc.l, pn = tc.pn, wc = tc.wc, fr = tc.fr, fq = tc.fq;
        if (BRK == 0 || (BRK == 1 && wc < 2)) {
            constexpr bool isq = BRK == 0;
            const int head = isq ? pn * 4 + wc : wc;
            const float* gn = (isq ? p.q_norm_g : p.k_norm_g) + l * 64;
            f32x4 gv[4];
#pragma unroll
            for (int n = 0; n < 4; ++n) gv[n] = *(const f32x4*)(gn + n * 16 + fq * 4);
            const float osc = isq ? 0.125f * LOG2E : 1.f;
            const bool lat = tc.brow < NLAT;
#pragma unroll
            for (int h = 0; h < 2; ++h) {
#pragma unroll
                for (int mm = 0; mm < 4; ++mm) { __builtin_amdgcn_sched_barrier(0);
                    const int m = h * 4 + mm;
                    const int row = tc.brow + tc.wr * 128 + m * 16 + fr;
                    float ss = 0.f;
#pragma unroll
                    for (int n = 0; n < 4; ++n)
#pragma unroll
                        for (int j = 0; j < 4; ++j) ss += acc[m][n][j] * acc[m][n][j];
                    ss += __shfl_xor(ss, 16);
                    ss += __shfl_xor(ss, 32);
                    const float rstd = rsqrtf(ss * (1.f / 64.f) + EPS) * osc;
                    const int t = row & 4095;
#pragma unroll
                    for (int ax = 0; ax < 2; ++ax) {
                        f32x4 x1 = acc[m][2 * ax] * rstd * gv[2 * ax], x2 = acc[m][2 * ax + 1] * rstd * gv[2 * ax + 1];
                        if (lat) {
                            const int pos = ax == 0 ? (t >> 6) : (t & 63);
                            const f32x4 cs = *(const f32x4*)(p.rope + pos * 16 + fq * 4), sn = *(const f32x4*)(p.rope + 1024 + pos * 16 + fq * 4);
                            const f32x4 o1 = x1 * cs - x2 * sn, o2 = x2 * cs + x1 * sn;
                            x1 = o1; x2 = o2;
                        }
                        u32x2 w; w[0] = pk2(x1[0], x1[1]); w[1] = pk2(x1[2], x1[3]);
                        wave_put(wb, mm * 16 + fr, 2 * ax, fq, w);
                        w[0] = pk2(x2[0], x2[1]); w[1] = pk2(x2[2], x2[3]);
                        wave_put(wb, mm * 16 + fr, 2 * ax + 1, fq, w);
                    }
                }
                const int row0 = tc.brow + tc.wr * 128 + h * 64;
                bf16_t* dst0;
                if (lat) {
                    const int b = row0 >> 12, t0 = row0 & 4095;
                    dst0 = isq ? p.Q + ((size_t)(b * 8 + head) * SEQ + t0) * 64 : p.K + ((size_t)(b * 2 + head) * NKEY + CTXL + t0) * 64;
                } else {
                    const int r2 = row0 - NLAT, b = r2 >> 8, t0 = r2 & 255;
                    dst0 = isq ? p.Qc + ((size_t)(b * 8 + head) * CTXL + t0) * 64 : p.K + ((size_t)(b * 2 + head) * NKEY + t0) * 64;
                }
                wave_rows_store(wb, tc.lane, dst0, 64);
            }
        } else if (BRK == 1) {
            const int kvh = wc - 2;
#pragma unroll
            for (int h = 0; h < 2; ++h) {
#pragma unroll
                for (int mm = 0; mm < 4; ++mm) {
                    const int m = h * 4 + mm;
                    const int key = mm * 16 + fr, k16 = key & 15;
                    const int kp = (key & ~15) | ((((k16 >> 2) & 1) << 3) + (k16 & 3) + ((k16 >> 3) << 2));
#pragma unroll
                    for (int n = 0; n < 4; ++n)
#pragma unroll
                        for (int j = 0; j < 4; ++j) {
                            const int d = n * 16 + fq * 4 + j;
                            *(LDSP bf16_t*)(wb + d * 128 + (((kp >> 3) ^ (d & 7)) << 4) + (kp & 7) * 2) = f2bf(acc[m][n][j]);
                        }
                }
                const int row0 = tc.brow + tc.wr * 128 + h * 64;
                int b, pos0;
                if (row0 < NLAT) { b = row0 >> 12; pos0 = CTXL + (row0 & 4095); } else { const int r2 = row0 - NLAT; b = r2 >> 8; pos0 = r2 & 255; }
                wave_rows_store(wb, tc.lane, p.Vt + (size_t)(b * 2 + kvh) * 64 * NKEY + pos0, NKEY);
            }
        } else if (BRK == 2) {
#pragma unroll
            for (int h = 0; h < 2; ++h) {
#pragma unroll
                for (int mm = 0; mm < 4; ++mm) {
                    const int m = h * 4 + mm;
#pragma unroll
                    for (int n = 0; n < 4; ++n) {
                        u32x2 w; w[0] = pk2(gelu_tanh(acc[m][n][0]), gelu_tanh(acc[m][n][1])); w[1] = pk2(gelu_tanh(acc[m][n][2]), gelu_tanh(acc[m][n][3]));
                        wave_put(wb, mm * 16 + fr, n, fq, w);
                    }
                }
                wave_rows_store(wb, tc.lane, p.U + (size_t)(tc.brow + tc.wr * 128 + h * 64) * 1024 + (pn - 3) * 256 + wc * 64, 1024);
            }
        }
    }
};

template <int EK>
DI void gemm_stream(const Params& p, int l, const bf16_t* __restrict__ A, const bf16_t* __restrict__ Bt, int M, int N, int K, ldsp_t shm) {
    const int nM = M / 256, nN = N / 256, nwg = nM * nN;
    int L = blockIdx.x;
    if (L >= nwg) return;
#define G_SA(b) (shm + (b) * G_STAGE_B)
#define G_SB(b) (shm + (b) * G_STAGE_B + G_TILE_B)
#define G_LANE_SETUP() \
    int tid_ = threadIdx.x; \
    asm volatile("" : "+v"(tid_));    \
    const int wid = tid_ >> 6, lane = tid_ & 63, wr = wid >> 2, wc = wid & 3, fr = lane & 15, fq = lane >> 4; \
    unsigned soff[4];        \
    _Pragma("unroll") for (int i = 0; i < 4; ++i) { int sR, sC; stage_rc2(wid * 1024 + i * 8192 + lane * 16, sR, sC); soff[i] = (unsigned)(sR * K + sC) * 2u; }
#define G_STAGE_A(Ap, buf, kt) do { const char* ab_ = (const char*)(Ap) + (size_t)(kt) * 128; \
      _Pragma("unroll") for (int i = 0; i < 4; ++i) \
        __builtin_amdgcn_global_load_lds((const unsigned*)(ab_ + soff[i]), (LDSP unsigned*)(G_SA(buf) + wid * 1024 + i * 8192), 16, 0, 0); } while (0)
#define G_STAGE_B(Bp, buf, kt) do { const char* bb_ = (const char*)(Bp) + (size_t)(kt) * 128; \
      _Pragma("unroll") for (int i = 0; i < 4; ++i) \
        __builtin_amdgcn_global_load_lds((const unsigned*)(bb_ + soff[i]), (LDSP unsigned*)(G_SB(buf) + wid * 1024 + i * 8192), 16, 0, 0); } while (0)
#define G_STAGE(Ap, Bp, buf, kt) do { const char* ab_ = (const char*)(Ap) + (size_t)(kt) * 128; const char* bb_ = (const char*)(Bp) + (size_t)(kt) * 128; \
      _Pragma("unroll") for (int i = 0; i < 4; ++i) { \
        __builtin_amdgcn_global_load_lds((const unsigned*)(ab_ + soff[i]), (LDSP unsigned*)(G_SA(buf) + wid * 1024 + i * 8192), 16, 0, 0); \
        __builtin_amdgcn_global_load_lds((const unsigned*)(bb_ + soff[i]), (LDSP unsigned*)(G_SB(buf) + wid * 1024 + i * 8192), 16, 0, 0); } } while (0)
    const int nt = K / 64;
    int pm, pn;
    tile_coords(L, nM, nN, pm, pn);
    const bf16_t* Ab = A + (size_t)pm * 256 * K;
    const bf16_t* Bb = Bt + (size_t)pn * 256 * K;
    { G_LANE_SETUP(); (void)wr; (void)wc; (void)fr; (void)fq; G_STAGE(Ab, Bb, 0, 0); WAIT_V0(); __syncthreads(); }
    while (true) {
        G_LANE_SETUP();
        const int aoff = lds_byte2(wr * 128 + fr, fq * 8), boff = lds_byte2(wc * 64 + fr, fq * 8);
        f32x4 acc[8][4];
#pragma unroll
        for (int m = 0; m < 8; ++m)
#pragma unroll
            for (int n = 0; n < 4; ++n) acc[m][n] = (f32x4){0.f, 0.f, 0.f, 0.f};
        const int Ln = L + gridDim.x;
        const bool has_next = Ln < nwg;
        int pm2 = pm, pn2 = pn;
        if (has_next) tile_coords(Ln, nM, nN, pm2, pn2);
        const bf16_t* Ab2 = A + (size_t)pm2 * 256 * K;
        const bf16_t* Bb2 = Bt + (size_t)pn2 * 256 * K;
        bf16x8 Aa[4], Ab_[4], Bk0[4], Bk1[4];
#define G_RDA(AF, buf, ks, mh) do { _Pragma("unroll") for (int m = 0; m < 4; ++m) AF[m] = *(const LDSP bf16x8*)(G_SA(buf) + aoff + ((mh) * 4 + m) * 2048 + (ks) * 1024); } while (0)
#define G_RDB(BF, buf, ks) do { _Pragma("unroll") for (int n = 0; n < 4; ++n) BF[n] = *(const LDSP bf16x8*)(G_SB(buf) + boff + n * 2048 + (ks) * 1024); } while (0)
#define G_MMA(AF, BF, mh) do { __builtin_amdgcn_s_setprio(1); \
            _Pragma("unroll") for (int m = 0; m < 4; ++m) _Pragma("unroll") for (int n = 0; n < 4; ++n) \
                acc[(mh) * 4 + m][n] = __builtin_amdgcn_mfma_f32_16x16x32_bf16(BF[n], AF[m], acc[(mh) * 4 + m][n], 0, 0, 0); \
            __builtin_amdgcn_s_setprio(0); } while (0)
#define G_SB0() __builtin_amdgcn_sched_barrier(0)
        for (int t = 0; t < nt; ++t) {
            const int cur = t & 1;
            G_RDA(Aa, cur, 0, 0); G_RDB(Bk0, cur, 0);
            if (t + 1 < nt) G_STAGE_B(Bb, cur ^ 1, t + 1);
            else if (has_next) G_STAGE_B(Bb2, cur ^ 1, 0);
            G_SB0();
            if (t > 0) G_MMA(Ab_, Bk1, 1);
            G_SB0();
            if (t + 1 < nt) G_STAGE_A(Ab, cur ^ 1, t + 1);
            else if (has_next) G_STAGE_A(Ab2, cur ^ 1, 0);
            G_RDA(Ab_, cur, 0, 1); G_SB0();
            G_MMA(Aa, Bk0, 0); G_SB0();
            G_RDA(Aa, cur, 1, 0); G_RDB(Bk1, cur, 1); G_SB0();
            G_MMA(Ab_, Bk0, 1); G_SB0();
            G_RDA(Ab_, cur, 1, 1); G_SB0();
            G_MMA(Aa, Bk1, 0); G_SB0();
            asm volatile("s_waitcnt lgkmcnt(0)" ::: "memory");
            WAIT_V0(); __syncthreads();
        }
        G_MMA(Ab_, Bk1, 1);
        G_SB0();
        {
            int tid2 = threadIdx.x, pme = pm, pne = pn;
            asm volatile("" : "+v"(tid2), "+s"(pme), "+s"(pne));
            TileCtx tc;
            tc.wid = tid2 >> 6; tc.lane = tid2 & 63; tc.wr = tc.wid >> 2; tc.wc = tc.wid & 3; tc.fr = tc.lane & 15; tc.fq = tc.lane >> 4; tc.l = l;
            tc.brow = pme * 256; tc.bcol = pne * 256; tc.pn = pne;
            ldsp_t ex = shm + G_STAGE_B + tc.wid * 8192;
            if (EK == 0 || EK == 2) {
                const int cond = tc.brow < NLAT ? (tc.brow >> 12) : 4;
                const float* ssp = p.ss + ((size_t)(l * 2 + (EK == 0 ? 0 : 1)) * NTOK + tc.brow + tc.wr * 128 + tc.fr) * 16 + tc.fq * 4;
                const float* shw = (EK == 0 ? p.shw_in + ((size_t)l * 5 + cond) * IN_DIM : p.shw_ff1 + ((size_t)l * 5 + cond) * FF) + tc.bcol + tc.wc * 64 + tc.fq * 4;
                f32x4 shv[4];
#pragma unroll
                for (int n = 0; n < 4; ++n) shv[n] = *(const f32x4*)(shw + n * 16);
#pragma unroll
                for (int m = 0; m < 8; ++m) {
                    const f32x4 pp = *(const f32x4*)(ssp + m * 256);
                    float sq = pp[0] + pp[1] + pp[2] + pp[3];
                    sq += __shfl_xor(sq, 16);
                    sq += __shfl_xor(sq, 32);
                    const float rstd = rsqrtf(sq * (1.f / DM) + EPS);
#pragma unroll
                    for (int n = 0; n < 4; ++n) acc[m][n] = acc[m][n] * rstd + shv[n];
                }
            }
            if (EK == 0) {
                if (pne < 2) EpiIn<0>::run(acc, tc, p, ex);
                else if (pne == 2) EpiIn<1>::run(acc, tc, p, ex);
                else EpiIn<2>::run(acc, tc, p, ex);
            } else if (EK == 1) EpiResid<1>::run(acc, tc, p, ex);
            else if (EK == 2) EpiFF1::run(acc, tc, p, ex);
            else EpiResid<3>::run(acc, tc, p, ex);
        }
        __syncthreads();
        if (!has_next) break;
        L = Ln; pm = pm2; pn = pn2; Ab = Ab2; Bb = Bb2;
    }
}

template <int EK>
DI void ctx_item(const Params& p, int l, int grow, int gcol, int slot, f32x4 s0, f32x4 s1, bool lead) {
    if (EK == 2) {
        const float* pp = p.ss + ((size_t)(l * 2 + 1) * NTOK + NLAT + grow) * 16;
        const f32x4 q0 = *(const f32x4*)pp, q1 = *(const f32x4*)(pp + 4), q2 = *(const f32x4*)(pp + 8), q3 = *(const f32x4*)(pp + 12);
        const f32x4 qs = q0 + q1 + q2 + q3;
        const float rstd = rsqrtf((qs[0] + qs[1] + qs[2] + qs[3]) * (1.f / DM) + EPS);
        const float* shw = p.shw_ff1 + ((size_t)l * 5 + 4) * FF + gcol;
        const f32x4 h0 = *(const f32x4*)shw, h1 = *(const f32x4*)(shw + 4);
        s0 = s0 * rstd + h0; s1 = s1 * rstd + h1;
#pragma unroll
        for (int j = 0; j < 4; ++j) { float r0 = fmaxf(s0[j], 0.f), r1 = fmaxf(s1[j], 0.f); s0[j] = r0 * r0; s1[j] = r1 * r1; }
        u32x4 w; w[0] = pk2(s0[0], s0[1]); w[1] = pk2(s0[2], s0[3]); w[2] = pk2(s1[0], s1[1]); w[3] = pk2(s1[2], s1[3]);
        *(u32x4*)(p.ACT + (size_t)(NLAT + grow) * FF + gcol) = w;
    } else {
        const float* gate = p.mod + ((size_t)l * 5 + 4) * 6144 + (EK == 1 ? 2 : 5) * DM + gcol;
        float* xr = p.xc + (size_t)grow * DM + gcol;
        const f32x4 g0 = *(const f32x4*)gate, g1 = *(const f32x4*)(gate + 4);
        f32x4 x0 = *(const f32x4*)xr, x1 = *(const f32x4*)(xr + 4);
        x0 += g0 * s0; x1 += g1 * s1;
        *(f32x4*)xr = x0; *(f32x4*)(xr + 4) = x1;
        const int ln = EK == 1 ? l : l + 1;
        const float* gnx = (EK == 1 ? p.norm2_g : p.norm1_g) + (size_t)ln * DM + gcol;
        const float* scn = p.mod + ((size_t)ln * 5 + 4) * 6144 + (EK == 1 ? 4 : 1) * DM + gcol;
        const f32x4 a0 = *(const f32x4*)gnx * (1.f + *(const f32x4*)scn), a1 = *(const f32x4*)(gnx + 4) * (1.f + *(const f32x4*)(scn + 4));
        const f32x4 y0 = x0 * a0, y1 = x1 * a1;
        u32x4 w; w[0] = pk2(y0[0], y0[1]); w[1] = pk2(y0[2], y0[3]); w[2] = pk2(y1[0], y1[1]); w[3] = pk2(y1[2], y1[3]);
        *(u32x4*)(p.H + (size_t)(NLAT + grow) * DM + gcol) = w;
        float part = x0[0] * x0[0] + x0[1] * x0[1] + x0[2] * x0[2] + x0[3] * x0[3] + x1[0] * x1[0] + x1[1] * x1[1] + x1[2] * x1[2] + x1[3] * x1[3];
        part += __shfl_xor(part, 1); part += __shfl_xor(part, 2); part += __shfl_xor(part, 4);
        if (lead) p.ss[((size_t)(ln * 2 + (EK == 1 ? 1 : 0)) * NTOK + NLAT + grow) * 16 + slot] = part;
    }
}

template <int EK, int TS, int KS>
DI void ctx_tiles(const Params& p, int l, const bf16_t* __restrict__ A, const bf16_t* __restrict__ Bt, int N, int K, ldsp_t shm) {
    constexpr int WM = TS / 2, WN = TS / 4, MT = WM / 16, NT = WN / 16, BKC = 32 * KS;
    constexpr int TILE_A = TS * BKC * 2, PP = TILE_A / 8192;
    const int ntn = N / TS, ntiles = (NCTX / TS) * ntn, nt = K / BKC;
    for (int u = blockIdx.x; u < ntiles; u += gridDim.x) {
        const int tm = u / ntn, tn = u % ntn;
        int tid = threadIdx.x;
        asm volatile("" : "+v"(tid));
        const int wid = tid >> 6, lane = tid & 63, wr = wid >> 2, wc = wid & 3, fr = lane & 15, fq = lane >> 4;
        unsigned soff[PP];
#pragma unroll
        for (int i = 0; i < PP; ++i) { int sR, sC; stage_rc_ks<KS>((wid * PP + i) * 1024 + lane * 16, sR, sC); soff[i] = (unsigned)(sR * K + sC) * 2u; }
        const bf16_t* Ab = A + (size_t)tm * TS * K;
        const bf16_t* Bb = Bt + (size_t)tn * TS * K;
#define C_STAGE(buf, kt) do { const char* ab_ = (const char*)Ab + (size_t)(kt) * (BKC * 2); const char* bb_ = (const char*)Bb + (size_t)(kt) * (BKC * 2); \
      _Pragma("unroll") for (int i = 0; i < PP; ++i) { \
        __builtin_amdgcn_global_load_lds((const unsigned*)(ab_ + soff[i]), (LDSP unsigned*)(shm + (buf) * 2 * TILE_A + (wid * PP + i) * 1024), 16, 0, 0); \
        __builtin_amdgcn_global_load_lds((const unsigned*)(bb_ + soff[i]), (LDSP unsigned*)(shm + (buf) * 2 * TILE_A + TILE_A + (wid * PP + i) * 1024), 16, 0, 0); } } while (0)
        f32x4 acc[MT][NT];
#pragma unroll
        for (int m = 0; m < MT; ++m)
#pragma unroll
            for (int n = 0; n < NT; ++n) acc[m][n] = (f32x4){0.f, 0.f, 0.f, 0.f};
        const int aoff = lds_byte_ks<KS>(wr * WM + fr, fq * 8), boff = lds_byte_ks<KS>(wc * WN + fr, fq * 8);
        C_STAGE(0, 0); WAIT_V0(); __syncthreads();
        for (int t = 0; t < nt; ++t) {
            const int cur = t & 1;
            if (t + 1 < nt) C_STAGE(cur ^ 1, t + 1);
            ldsp_t sa = shm + cur * 2 * TILE_A, sb = sa + TILE_A;
#pragma unroll
            for (int ks = 0; ks < KS; ++ks) {
                bf16x8 At[MT], Bf[NT];
#pragma unroll
                for (int m = 0; m < MT; ++m) At[m] = *(const LDSP bf16x8*)(sa + aoff + m * (KS * 1024) + ks * 1024);
#pragma unroll
                for (int n = 0; n < NT; ++n) Bf[n] = *(const LDSP bf16x8*)(sb + boff + n * (KS * 1024) + ks * 1024);
#pragma unroll
                for (int m = 0; m < MT; ++m)
#pragma unroll
                    for (int n = 0; n < NT; ++n) acc[m][n] = __builtin_amdgcn_mfma_f32_16x16x32_bf16(Bf[n], At[m], acc[m][n], 0, 0, 0);
            }
            WAIT_V0(); __syncthreads();
        }
#pragma unroll
        for (int m = 0; m < MT; ++m)
#pragma unroll
            for (int n = 0; n < NT; ++n) {
                const int row = wr * WM + m * 16 + fr, ch = (wc * WN + n * 16 + fq * 4) >> 2;
                *(LDSP f32x4*)(shm + row * (TS * 4) + ((ch ^ (row & 15)) << 4)) = acc[m][n];
            }
        __syncthreads();
#pragma unroll
        for (int it = 0; it < (TS * TS / 8) / 512; ++it) {
            const int item = it * 512 + tid, row = item / (TS / 8), c8 = item % (TS / 8);
            const f32x4 s0 = *(const LDSP f32x4*)(shm + row * (TS * 4) + (((2 * c8) ^ (row & 15)) << 4));
            const f32x4 s1 = *(const LDSP f32x4*)(shm + row * (TS * 4) + (((2 * c8 + 1) ^ (row & 15)) << 4));
            ctx_item<EK>(p, l, tm * TS + row, tn * TS + c8 * 8, tn, s0, s1, c8 == 0);
        }
        __syncthreads();
    }
}

DI void attn_unit(const Params& p, int l, int b, int kvh, int qb, bool isctx, ldsp_t smem) {
    int tid = threadIdx.x;
    asm volatile("" : "+v"(tid));
    const int wid = tid >> 6, lane = tid & 63, r = lane & 31, hh = lane >> 5;
    const int head = kvh * 4 + (wid >> 1);
    const int t0 = qb * 64 + (wid & 1) * 32;
    const int nkeys = isctx ? CTXL : NKEY;
    const bf16_t* Qp = isctx ? p.Qc + ((size_t)(b * 8 + head) * CTXL + t0) * 64 : p.Q + ((size_t)(b * 8 + head) * SEQ + t0) * 64;
    const bf16_t* Kp = p.K + (size_t)(b * 2 + kvh) * NKEY * 64;
    const bf16_t* Vp = p.Vt + (size_t)(b * 2 + kvh) * 64 * NKEY;
    const int orow = isctx ? NLAT + b * CTXL + t0 : b * SEQ + t0;
    bf16_t* Op = p.MIX + (size_t)orow * DM + head * 64;
    const float cexp = p.smax[l] * LOG2E;

    bf16x8 qf[4];
#pragma unroll
    for (int ks = 0; ks < 4; ++ks) qf[ks] = *(const bf16x8*)(Qp + (size_t)r * 64 + ks * 16 + 8 * hh);
    f32x16 o[2];
#pragma unroll
    for (int i = 0; i < 16; ++i) { o[0][i] = 0.f; o[1][i] = 0.f; }
    float rs0 = 0.f, rs1 = 0.f;

    const int srow = tid >> 3, sch = tid & 7;
    const int kdst = srow * 128 + ((sch ^ ((srow >> 1) & 7)) << 4);
    const bf16_t* kg = Kp + (size_t)srow * 64 + sch * 8;
    const bf16_t* vg = Vp + (size_t)srow * NKEY + sch * 8;
    const int rsw = (r >> 1) & 7;
    const int ntile = nkeys / 64;

#define ATT_QK(SD, kb) do { _Pragma("unroll") for (int kt = 0; kt < 2; ++kt) { \
        _Pragma("unroll") for (int i = 0; i < 16; ++i) SD[kt][i] = -cexp; \
        _Pragma("unroll") for (int ks = 0; ks < 4; ++ks) { \
            const bf16x8 a_ = *(const LDSP bf16x8*)((kb) + (kt * 32 + r) * 128 + (((ks * 2 + hh) ^ rsw) << 4)); \
            SD[kt] = __builtin_amdgcn_mfma_f32_32x32x16_bf16(a_, qf[ks], SD[kt], 0, 0, 0); } } } while (0)

    u32x4 kst, vst;
    f32x16 sA[2], sB[2];
    {
        kst = *(const u32x4*)kg;
        *(LDSP u32x4*)(smem + kdst) = kst;
        kst = *(const u32x4*)(kg + (size_t)64 * 64);
        vst = *(const u32x4*)vg;
        __syncthreads();
        ATT_QK(sA, smem);
        *(LDSP u32x4*)(smem + 8192 + kdst) = kst;
        *(LDSP u32x4*)(smem + 16384 + kdst) = vst;
    }
#define ATT_STEP(t, SC, SN) do { \
        const int par = (t) & 1; \
        __syncthreads(); \
        { const int t2_ = (t) + 2 < ntile ? (t) + 2 : ntile - 1, t1_ = (t) + 1 < ntile ? (t) + 1 : ntile - 1; \
          kst = *(const u32x4*)(kg + (size_t)t2_ * 64 * 64); vst = *(const u32x4*)(vg + t1_ * 64); } \
        bf16x8 kf[8], vf[4], vh[4]; \
        ldsp_t kb_ = smem + (par ^ 1) * 8192; ldsp_t vb_ = smem + 16384 + par * 8192; \
        _Pragma("unroll") for (int kt = 0; kt < 2; ++kt) _Pragma("unroll") for (int ks = 0; ks < 4; ++ks) \
            kf[kt * 4 + ks] = *(const LDSP bf16x8*)(kb_ + (kt * 32 + r) * 128 + (((ks * 2 + hh) ^ rsw) << 4)); \
        _Pragma("unroll") for (int c = 0; c < 2; ++c) _Pragma("unroll") for (int dt = 0; dt < 2; ++dt) \
            vf[c * 2 + dt] = *(const LDSP bf16x8*)(vb_ + (dt * 32 + r) * 128 + (((c * 2 + hh) ^ rsw) << 4)); \
        __builtin_amdgcn_sched_barrier(0); \
        _Pragma("unroll") for (int kt = 0; kt < 2; ++kt) _Pragma("unroll") for (int i = 0; i < 16; ++i) SN[kt][i] = -cexp;     \
        _Pragma("unroll") for (int ks = 0; ks < 4; ++ks) _Pragma("unroll") for (int kt = 0; kt < 2; ++kt) \
            SN[kt] = __builtin_amdgcn_mfma_f32_32x32x16_bf16(kf[kt * 4 + ks], qf[ks], SN[kt], 0, 0, 0); \
        _Pragma("unroll") for (int c = 2; c < 4; ++c) _Pragma("unroll") for (int dt = 0; dt < 2; ++dt) \
            vh[(c - 2) * 2 + dt] = *(const LDSP bf16x8*)(vb_ + (dt * 32 + r) * 128 + (((c * 2 + hh) ^ rsw) << 4)); \
        __builtin_amdgcn_sched_barrier(0); \
        _Pragma("unroll") for (int kt = 0; kt < 2; ++kt) { \
            _Pragma("unroll") for (int i = 0; i < 16; ++i) { \
                const float e_ = fexp2(SC[kt][i]); \
                if (i & 1) rs1 += e_; else rs0 += e_; \
                SC[kt][i] = e_; } } \
        _Pragma("unroll") for (int c = 0; c < 4; ++c) { \
            u32x4 pw; \
            pw[0] = pk2(SC[c >> 1][8 * (c & 1) + 0], SC[c >> 1][8 * (c & 1) + 1]); pw[1] = pk2(SC[c >> 1][8 * (c & 1) + 2], SC[c >> 1][8 * (c & 1) + 3]); \
            pw[2] = pk2(SC[c >> 1][8 * (c & 1) + 4], SC[c >> 1][8 * (c & 1) + 5]); pw[3] = pk2(SC[c >> 1][8 * (c & 1) + 6], SC[c >> 1][8 * (c & 1) + 7]); \
            const bf16x8 pb = __builtin_bit_cast(bf16x8, pw); \
            _Pragma("unroll") for (int dt = 0; dt < 2; ++dt) o[dt] = __builtin_amdgcn_mfma_f32_32x32x16_bf16(c < 2 ? vf[c * 2 + dt] : vh[(c - 2) * 2 + dt], pb, o[dt], 0, 0, 0); } \
        *(LDSP u32x4*)(smem + par * 8192 + kdst) = kst; \
        *(LDSP u32x4*)(smem + 16384 + (par ^ 1) * 8192 + kdst) = vst; \
    } while (0)

    for (int t = 0; t < ntile; t += 2) {
        ATT_STEP(t, sA, sB);
        ATT_STEP(t + 1, sB, sA);
    }
    const float lrun = rs0 + rs1;
    const float ltot = lrun + __shfl_xor(lrun, 32);
    const float inv = 1.f / ltot;
#pragma unroll
    for (int dt = 0; dt < 2; ++dt)
#pragma unroll
        for (int g4 = 0; g4 < 4; ++g4) {
            u32x2 w; w[0] = pk2(o[dt][4 * g4 + 0] * inv, o[dt][4 * g4 + 1] * inv); w[1] = pk2(o[dt][4 * g4 + 2] * inv, o[dt][4 * g4 + 3] * inv);
            *(u32x2*)(Op + (size_t)r * DM + dt * 32 + 8 * g4 + 4 * hh) = w;
        }
    __syncthreads();
}

DI void gmlp_unit(const Params& p, int l, int T, int g, ldsp_t smem) {
    int tid = threadIdx.x;
    asm volatile("" : "+v"(tid));
    const int wid = tid >> 6, lane = tid & 63, fr = lane & 15, fq = lane >> 4;
    {
        const int q = tid >> 2, part = tid & 3;
        const bf16_t* src = p.U + (size_t)(T * 128 + q) * 1024 + 512 + g * 128 + part * 32;
        u32x4 raw[4];
#pragma unroll
        for (int i = 0; i < 4; ++i) raw[i] = *(const u32x4*)(src + i * 8);
        float a = 0.f, b = 0.f;
#pragma unroll
        for (int i = 0; i < 4; ++i)
#pragma unroll
            for (int j = 0; j < 4; ++j) {
                const float lo = __uint_as_float(raw[i][j] << 16), hi = __uint_as_float(raw[i][j] & 0xffff0000u);
                a += lo + hi; b += lo * lo + hi * hi;
            }
        a += __shfl_xor(a, 1); a += __shfl_xor(a, 2);
        b += __shfl_xor(b, 1); b += __shfl_xor(b, 2);
        const float mean = a * (1.f / 128.f);
        const float rstd = rsqrtf(fmaxf(b * (1.f / 128.f) - mean * mean, 0.f) + EPS);
        const float* gn = p.gmlp_norm_g + l * 512 + g * 128 + part * 32;
#pragma unroll
        for (int i = 0; i < 4; ++i)
#pragma unroll
            for (int j = 0; j < 4; ++j) {
                const int c0 = part * 32 + i * 8 + j * 2;
                const float lo = __uint_as_float(raw[i][j] << 16), hi = __uint_as_float(raw[i][j] & 0xffff0000u);
                const unsigned w = pk2((lo - mean) * rstd * gn[i * 8 + j * 2], (hi - mean) * rstd * gn[i * 8 + j * 2 + 1]);
                *(LDSP bf16_t*)(smem + c0 * 256 + (((q >> 3) ^ (c0 & 15)) << 4) + (q & 7) * 2) = (bf16_t)(w & 0xffffu);
                *(LDSP bf16_t*)(smem + (c0 + 1) * 256 + (((q >> 3) ^ ((c0 + 1) & 15)) << 4) + (q & 7) * 2) = (bf16_t)(w >> 16);
            }
    }
    __syncthreads();
    const int prow = wid * 16 + fr;
    const bf16_t* wsp = p.ws_bf + ((size_t)(l * 4 + g) * 128 + prow) * 128 + fq * 8;
    bf16x8 a[4];
#pragma unroll
    for (int ks = 0; ks < 4; ++ks) a[ks] = *(const bf16x8*)(wsp + ks * 32);
    f32x4 acc[8];
#pragma unroll
    for (int n = 0; n < 8; ++n) {
        acc[n] = (f32x4){0.f, 0.f, 0.f, 0.f};
        const int c = n * 16 + fr;
#pragma unroll
        for (int ks = 0; ks < 4; ++ks) {
            const bf16x8 bq = *(const LDSP bf16x8*)(smem + c * 256 + (((ks * 4 + fq) ^ (c & 15)) << 4));
            acc[n] = __builtin_amdgcn_mfma_f32_16x16x32_bf16(bq, a[ks], acc[n], 0, 0, 0);
        }
    }
    const float bs = p.b_spatial[(size_t)(l * 4 + g) * 128 + prow];
    const int row = T * 128 + prow;
    const bf16_t* up = p.U + (size_t)row * 1024 + g * 128 + fq * 4;
    bf16_t* mp = p.MIX + (size_t)row * DM + 512 + g * 128 + fq * 4;
#pragma unroll
    for (int n = 0; n < 8; ++n) {
        const u32x2 uu = *(const u32x2*)(up + n * 16);
        const float u0 = __uint_as_float(uu[0] << 16), u1 = __uint_as_float(uu[0] & 0xffff0000u), u2 = __uint_as_float(uu[1] << 16), u3 = __uint_as_float(uu[1] & 0xffff0000u);
        u32x2 w; w[0] = pk2((acc[n][0] + bs) * u0, (acc[n][1] + bs) * u1); w[1] = pk2((acc[n][2] + bs) * u2, (acc[n][3] + bs) * u3);
        *(u32x2*)(mp + n * 16) = w;
    }
    __syncthreads();
}

DI void mixer_phase(const Params& p, int l, ldsp_t smem) {
    const bool last = l == DEPTH - 1;
    for (int u = blockIdx.x; u < 512; u += gridDim.x) attn_unit(p, l, (u & 7) >> 1, u & 1, u >> 3, false, smem);
    if (!last)
        for (int u = blockIdx.x; u < 32; u += gridDim.x) attn_unit(p, l, (u & 7) >> 1, u & 1, u >> 3, true, smem);
    const int nT = last ? 128 : 136;
    for (int u = blockIdx.x; u < nT * 4; u += gridDim.x) gmlp_unit(p, l, u >> 2, u & 3, smem);
}

DI void grid_barrier(unsigned* bar, unsigned k) {
    asm volatile("s_waitcnt vmcnt(0)" ::: "memory");
    __syncthreads();
    if (threadIdx.x == 0) {
        __builtin_amdgcn_fence(__ATOMIC_RELEASE, "agent");
        asm volatile("s_waitcnt vmcnt(0)" ::: "memory");
        const unsigned j = blockIdx.x & 7u, G = gridDim.x;
        const unsigned nsub = (G - j + 7u) >> 3, ngrp = G < 8u ? G : 8u;
        const unsigned old = __hip_atomic_fetch_add(bar + 64 * (1 + j), 1u, __ATOMIC_RELAXED, __HIP_MEMORY_SCOPE_AGENT);
        if (old + 1u == k * nsub) __hip_atomic_fetch_add(bar, 1u, __ATOMIC_RELAXED, __HIP_MEMORY_SCOPE_AGENT);
        unsigned sp = 0;
        while (__hip_atomic_load(bar, __ATOMIC_RELAXED, __HIP_MEMORY_SCOPE_AGENT) < k * ngrp) { __builtin_amdgcn_s_sleep(1); if (++sp > (1u << 22)) break; }
        __builtin_amdgcn_fence(__ATOMIC_ACQUIRE, "agent");
        asm volatile("s_waitcnt vmcnt(0)" ::: "memory");
    }
    __syncthreads();
}

constexpr int N_PHASES = 2 + DEPTH * 5;
DI void run_phase(const Params& p, int ph, ldsp_t smem) {
    if (ph == 0) { phase0(p, smem); return; }
    if (ph == 1) { phase1(p); return; }
    const int l = (ph - 2) / 5, k = (ph - 2) % 5;
    const bool last = l == DEPTH - 1;
    switch (k) {
        case 0: gemm_stream<0>(p, l, p.H, p.wt_in + (size_t)l * IN_DIM * DM, NTOK, IN_DIM, DM, smem); break;
        case 1: mixer_phase(p, l, smem); break;
        case 2: gemm_stream<1>(p, l, p.MIX, p.wt_out + (size_t)l * DM * DM, NLAT, DM, DM, smem);
                if (!last) ctx_tiles<1, 64, 8>(p, l, p.MIX + (size_t)NLAT * DM, p.wt_out + (size_t)l * DM * DM, DM, DM, smem);
                break;
        case 3: gemm_stream<2>(p, l, p.H, p.wt_ff1 + (size_t)l * FF * DM, NLAT, FF, DM, smem);
                if (!last) ctx_tiles<2, 128, 4>(p, l, p.H + (size_t)NLAT * DM, p.wt_ff1 + (size_t)l * FF * DM, FF, DM, smem);
                break;
        default: gemm_stream<3>(p, l, p.ACT, p.wt_ff2 + (size_t)l * DM * FF, NLAT, DM, FF, smem);
                if (!last) ctx_tiles<3, 64, 8>(p, l, p.ACT + (size_t)NLAT * FF, p.wt_ff2 + (size_t)l * DM * FF, DM, FF, smem);
                break;
    }
}

template <bool COOP>
__global__ void __launch_bounds__(512) mk_kernel(Params p, int ph_lo, int ph_hi) {
    __shared__ __attribute__((aligned(1024))) char smem_raw[2 * G_STAGE_B + 8192];
    ldsp_t smem = (ldsp_t)smem_raw;
    for (int ph = ph_lo; ph < ph_hi; ++ph) {
        run_phase(p, ph, smem);
#ifdef DUP_K
        if (ph > 1 && (ph - 2) % 5 == DUP_K) { cg::this_grid().sync(); run_phase(p, ph, smem); }
#endif
        if (COOP && ph + 1 < ph_hi) {
            if (ph == 0) cg::this_grid().sync();
            else grid_barrier(p.bar, (unsigned)ph);
        }
    }
}

extern "C" void kernel_launch(void* const* d_in, const int* in_sizes, int n_in, void* d_out, int out_size, void* d_ws, size_t ws_size, hipStream_t stream) {
    Params p{};
    p.x = (const float*)d_in[0]; p.c = (const float*)d_in[1]; p.ctx = (const float*)d_in[2]; p.c_ctx = (const float*)d_in[3];
    p.w_mod = (const float*)d_in[4]; p.b_mod = (const float*)d_in[5]; p.norm1_g = (const float*)d_in[6]; p.w_in = (const float*)d_in[7];
    p.q_norm_g = (const float*)d_in[8]; p.k_norm_g = (const float*)d_in[9]; p.gmlp_norm_g = (const float*)d_in[10]; p.w_spatial = (const float*)d_in[11];
    p.b_spatial = (const float*)d_in[12]; p.w_out = (const float*)d_in[13]; p.norm2_g = (const float*)d_in[14]; p.w_ff1 = (const float*)d_in[15]; p.w_ff2 = (const float*)d_in[16];
    p.out = (float*)d_out;
    char* w = (char*)d_ws; size_t off = 0;
    auto take = [&](size_t bytes) { char* r = w + off; off += (bytes + 1023) & ~(size_t)1023; return r; };
    p.wt_in = (bf16_t*)take((size_t)DEPTH * IN_DIM * DM * 2);
    p.wt_out = (bf16_t*)take((size_t)DEPTH * DM * DM * 2);
    p.wt_ff1 = (bf16_t*)take((size_t)DEPTH * FF * DM * 2);
    p.wt_ff2 = (bf16_t*)take((size_t)DEPTH * FF * DM * 2);
    p.ws_bf = (bf16_t*)take((size_t)DEPTH * 4 * 128 * 128 * 2);
    p.mod = (float*)take((size_t)DEPTH * 5 * 6144 * 4);
    p.rope = (float*)take(2048 * 4);
    p.xc = (float*)take((size_t)NCTX * DM * 4);
    p.smax = (float*)take(1024);
    p.bar = (unsigned*)take(4096);
    p.ss = (float*)take((size_t)DEPTH * 2 * NTOK * 16 * 4);
    p.shw_in = (float*)take((size_t)DEPTH * 5 * IN_DIM * 4);
    p.shw_ff1 = (float*)take((size_t)DEPTH * 5 * FF * 4);
    p.H = (bf16_t*)take((size_t)NTOK * DM * 2);
    p.ACT = (bf16_t*)take((size_t)NTOK * FF * 2);
    {
        char* a = (char*)p.ACT; size_t o2 = 0;
        auto take2 = [&](size_t bytes) { char* r = a + o2; o2 += (bytes + 1023) & ~(size_t)1023; return r; };
        p.Q = (bf16_t*)take2((size_t)NLAT * 512 * 2);
        p.Qc = (bf16_t*)take2((size_t)NCTX * 512 * 2);
        p.K = (bf16_t*)take2((size_t)NB * 2 * NKEY * 64 * 2);
        p.Vt = (bf16_t*)take2((size_t)NB * 2 * NKEY * 64 * 2);
        p.U = (bf16_t*)take2((size_t)NTOK * 1024 * 2);
        p.MIX = (bf16_t*)take2((size_t)NTOK * DM * 2);
    }
    if (off > ws_size) { fprintf(stderr, "workspace too small: need %zu have %zu\n", off, ws_size); return; }
#if MK_COOP
    static int grid_blocks = 0;
    if (!grid_blocks) {
        int dev = 0, cus = 0, per_cu = 0;
        hipGetDevice(&dev);
        hipDeviceGetAttribute(&cus, hipDeviceAttributeMultiprocessorCount, dev);
        hipOccupancyMaxActiveBlocksPerMultiprocessor(&per_cu, mk_kernel<true>, 512, 0);
        if (per_cu < 1) per_cu = 1;
        grid_blocks = cus * 1;
    }
    int lo = 0, hi = N_PHASES;
    void* args[] = {&p, &lo, &hi};
    hipError_t e = hipLaunchCooperativeKernel((void*)mk_kernel<true>, dim3(grid_blocks), dim3(512), args, 0, stream);
    if (e != hipSuccess) fprintf(stderr, "cooperative launch failed: %s (grid %d)\n", hipGetErrorString(e), grid_blocks);
#else
    for (int ph = 0; ph < N_PHASES; ++ph) mk_kernel<false><<<256, 512, 0, stream>>>(p, ph, ph + 1);
#endif
}
```

```cpp
#include <hip/hip_runtime.h>
#include <hip/hip_cooperative_groups.h>
#include <stdint.h>
#include <cstdio>
namespace cg = cooperative_groups;

#ifndef MK_COOP
#define MK_COOP 1
#endif

#define DI __device__ __forceinline__
#define LDSP __attribute__((address_space(3)))
typedef LDSP char* ldsp_t;
typedef unsigned short bf16_t;
typedef short bf16x8 __attribute__((ext_vector_type(8)));
typedef float f32x2 __attribute__((ext_vector_type(2)));
typedef float f32x4 __attribute__((ext_vector_type(4)));
typedef float f32x16 __attribute__((ext_vector_type(16)));
typedef unsigned u32x2 __attribute__((ext_vector_type(2)));
typedef unsigned u32x4 __attribute__((ext_vector_type(4)));
typedef __bf16 bf2_t __attribute__((ext_vector_type(2)));

constexpr int DM = 1024, NB = 4, SEQ = 4096, DEPTH = 4, CTXL = 256;
constexpr int NLAT = NB * SEQ;
constexpr int NCTX = NB * CTXL;
constexpr int NTOK = NLAT + NCTX;
constexpr int IN_DIM = 1792, FF = 4096, NKEY = CTXL + SEQ;
constexpr float EPS = 1e-6f;
constexpr float LOG2E = 1.4426950408889634f;

struct Params {
    const float *x, *c, *ctx, *c_ctx, *w_mod, *b_mod, *norm1_g, *w_in, *q_norm_g, *k_norm_g, *gmlp_norm_g, *w_spatial, *b_spatial, *w_out, *norm2_g, *w_ff1, *w_ff2;
    float* out;
    bf16_t *wt_in, *wt_out, *wt_ff1, *wt_ff2, *ws_bf;
    float *mod, *rope, *xc, *smax, *ss, *shw_in, *shw_ff1;
    unsigned* bar;
    bf16_t *H, *Q, *Qc, *K, *Vt, *U, *MIX, *ACT;
};

DI unsigned pk2(float a, float b) { f32x2 v = {a, b}; bf2_t r = __builtin_convertvector(v, bf2_t); return __builtin_bit_cast(unsigned, r); }
DI bf16_t f2bf(float a) { return (bf16_t)(pk2(a, 0.f) & 0xffffu); }
DI float fexp2(float x) { return __builtin_amdgcn_exp2f(x); }
DI float gelu_tanh(float x) {
    const float y = 0.7978845608028654f * (x + 0.044715f * x * x * x);
    return x * __builtin_amdgcn_rcpf(1.f + fexp2(-2.f * LOG2E * y));
}
DI float* xrow_ptr(const Params& p, int row) { return row < NLAT ? p.out + (size_t)row * DM : p.xc + (size_t)(row - NLAT) * DM; }

DI void transpose_tile(const float* __restrict__ src, bf16_t* __restrict__ dst, int K, int N, int tk, int tn, ldsp_t smem) {
    LDSP float* t = (LDSP float*)smem;
    int tid = threadIdx.x;
    asm volatile("" : "+v"(tid));
    const int k0 = tk * 64, n0 = tn * 256;
    f32x4 v[8];
#pragma unroll
    for (int i = 0; i < 8; ++i) v[i] = *(const f32x4*)(src + (size_t)(k0 + (tid >> 6) + 8 * i) * N + n0 + (tid & 63) * 4);
#pragma unroll
    for (int i = 0; i < 8; ++i) {
        const int k = (tid >> 6) + 8 * i, n4 = (tid & 63) * 4;
        t[k * 257 + n4 + 0] = v[i][0]; t[k * 257 + n4 + 1] = v[i][1]; t[k * 257 + n4 + 2] = v[i][2]; t[k * 257 + n4 + 3] = v[i][3];
    }
    __syncthreads();
#pragma unroll
    for (int j = 0; j < 4; ++j) {
        const int n = (tid >> 3) + 64 * j, k8 = (tid & 7) * 8;
        u32x4 w;
        w[0] = pk2(t[(k8 + 0) * 257 + n], t[(k8 + 1) * 257 + n]);
        w[1] = pk2(t[(k8 + 2) * 257 + n], t[(k8 + 3) * 257 + n]);
        w[2] = pk2(t[(k8 + 4) * 257 + n], t[(k8 + 5) * 257 + n]);
        w[3] = pk2(t[(k8 + 6) * 257 + n], t[(k8 + 7) * 257 + n]);
        *(u32x4*)(dst + (size_t)(n0 + n) * K + k0 + k8) = w;
    }
    __syncthreads();
}

DI void mod_unit(const Params& p, int l, int cgi, ldsp_t smem) {
    LDSP float* s = (LDSP float*)smem;
    LDSP float* red = (LDSP float*)(smem + 20480);
    int tid = threadIdx.x;
    asm volatile("" : "+v"(tid));
    for (int i = tid; i < 5 * 1024; i += 512) {
        const int cnd = i >> 10, k = i & 1023;
        const float v = cnd < 4 ? p.c[cnd * 1024 + k] : p.c_ctx[k];
        s[i] = v / (1.f + fexp2(-LOG2E * v));
    }
    __syncthreads();
    const int c4 = tid & 15, ks = tid >> 4;
    f32x4 acc[5];
#pragma unroll
    for (int q = 0; q < 5; ++q) acc[q] = (f32x4){0.f, 0.f, 0.f, 0.f};
    const float* wp = p.w_mod + ((size_t)l * 1024 + ks * 32) * 6144 + cgi * 64 + c4 * 4;
#pragma unroll 8
    for (int kk = 0; kk < 32; ++kk) {
        const f32x4 w = *(const f32x4*)(wp + (size_t)kk * 6144);
        const int k = ks * 32 + kk;
#pragma unroll
        for (int q = 0; q < 5; ++q) acc[q] += w * s[q * 1024 + k];
    }
#pragma unroll
    for (int q = 0; q < 5; ++q)
#pragma unroll
        for (int j = 0; j < 4; ++j) red[(ks * 5 + q) * 64 + c4 * 4 + j] = acc[q][j];
    __syncthreads();
    if (tid < 320) {
        const int q = tid >> 6, col = tid & 63;
        float a = 0.f;
        for (int k2 = 0; k2 < 32; ++k2) a += red[(k2 * 5 + q) * 64 + col];
        const int j = cgi * 64 + col;
        p.mod[((size_t)l * 5 + q) * 6144 + j] = a + p.b_mod[(size_t)l * 6144 + j];
    }
    __syncthreads();
}

DI void phase0(const Params& p, ldsp_t smem) {
    constexpr int T_IN = 16 * 7, T_OUT = 16 * 4, T_FF1 = 16 * 16, T_FF2 = 64 * 4;
    constexpr int T_L = T_IN + T_OUT + T_FF1 + T_FF2;
    constexpr int U_T = DEPTH * T_L;
    constexpr int U_MOD = DEPTH * 96;
    constexpr int U_WS = 64;
    constexpr int U_ALL = U_MOD + U_T + U_WS + 1;
    for (int u = blockIdx.x; u < U_ALL; u += gridDim.x) {
        if (u < U_MOD) { mod_unit(p, u / 96, u % 96, smem); continue; }
        int v = u - U_MOD;
        if (v < U_T) {
            const int l = v / T_L; int r = v % T_L;
            if (r < T_IN) { transpose_tile(p.w_in + (size_t)l * DM * IN_DIM, p.wt_in + (size_t)l * IN_DIM * DM, DM, IN_DIM, r / 7, r % 7, smem); continue; }
            r -= T_IN;
            if (r < T_OUT) { transpose_tile(p.w_out + (size_t)l * DM * DM, p.wt_out + (size_t)l * DM * DM, DM, DM, r / 4, r % 4, smem); continue; }
            r -= T_OUT;
            if (r < T_FF1) { transpose_tile(p.w_ff1 + (size_t)l * DM * FF, p.wt_ff1 + (size_t)l * FF * DM, DM, FF, r / 16, r % 16, smem); continue; }
            r -= T_FF1;
            transpose_tile(p.w_ff2 + (size_t)l * FF * DM, p.wt_ff2 + (size_t)l * DM * FF, FF, DM, r / 4, r % 4, smem); continue;
        }
        v -= U_T;
        if (v < U_WS) {
            int tw = threadIdx.x;
            asm volatile("" : "+v"(tw));
            const size_t i = ((size_t)v * 512 + tw) * 8;
            const f32x4 a = *(const f32x4*)(p.w_spatial + i), b = *(const f32x4*)(p.w_spatial + i + 4);
            u32x4 w; w[0] = pk2(a[0], a[1]); w[1] = pk2(a[2], a[3]); w[2] = pk2(b[0], b[1]); w[3] = pk2(b[2], b[3]);
            *(u32x4*)(p.ws_bf + i) = w;
            continue;
        }
        int ti = threadIdx.x;
        asm volatile("" : "+v"(ti));
        if (ti >= 64 && ti < 64 + 9) p.bar[(ti - 64) * 64] = 0u;
        if (ti < DEPTH) {
            float mq = 0.f, mk = 0.f;
            for (int i = 0; i < 64; ++i) { mq = fmaxf(mq, fabsf(p.q_norm_g[ti * 64 + i])); mk = fmaxf(mk, fabsf(p.k_norm_g[ti * 64 + i])); }
            p.smax[ti] = 8.f * mq * mk;
        }
        for (int i = ti; i < 1024; i += 512) {
            const int pos = i >> 4, f = i & 15;
            const float inv = fexp2(-(float)f * (13.287712379549449f / 16.f));
            const float rev = (float)pos * inv * 0.15915494309189535f;
            p.rope[i] = __builtin_amdgcn_cosf(rev);
            p.rope[1024 + i] = __builtin_amdgcn_sinf(rev);
        }
    }
}

DI void phase1(const Params& p) {
    int tid = threadIdx.x;
    asm volatile("" : "+v"(tid));
    const int lane = tid & 63, wid = tid >> 6;
    const int gw = blockIdx.x * 8 + wid, nw = gridDim.x * 8;
    for (int row = gw; row < NTOK; row += nw) {
        const float* src = row < NLAT ? p.x + (size_t)row * DM : p.ctx + (size_t)(row - NLAT) * DM;
        const int cond = row < NLAT ? (row >> 12) : 4;
        const float* mp = p.mod + ((size_t)cond) * 6144;
        f32x4 v[4];
        float ss = 0.f;
#pragma unroll
        for (int i = 0; i < 4; ++i) { v[i] = *(const f32x4*)(src + i * 256 + lane * 4); ss += v[i][0] * v[i][0] + v[i][1] * v[i][1] + v[i][2] * v[i][2] + v[i][3] * v[i][3]; }
#pragma unroll
        for (int o = 1; o < 64; o <<= 1) ss += __shfl_xor(ss, o);
        if (lane < 16) p.ss[(size_t)row * 16 + lane] = lane == 0 ? ss : 0.f;
        bf16_t* hp = p.H + (size_t)row * DM;
        float* xw = xrow_ptr(p, row);
#pragma unroll
        for (int i = 0; i < 4; ++i) {
            const int idx = i * 256 + lane * 4;
            const f32x4 gg = *(const f32x4*)(p.norm1_g + idx), sc = *(const f32x4*)(mp + DM + idx);
            f32x4 y;
#pragma unroll
            for (int j = 0; j < 4; ++j) y[j] = v[i][j] * gg[j] * (1.f + sc[j]);
            u32x2 w; w[0] = pk2(y[0], y[1]); w[1] = pk2(y[2], y[3]);
            *(u32x2*)(hp + idx) = w;
            *(f32x4*)(xw + idx) = v[i];
        }
    }
    {
        const int fr = lane & 15, fq = lane >> 4;
        constexpr int G_IN = IN_DIM / 16, G_FF = FF / 16, G_L = G_IN + G_FF;
        for (int gi = gw; gi < DEPTH * G_L; gi += nw) {
            const int l = gi / G_L, r = gi % G_L;
            const bool which = r >= G_IN;
            const int n0 = (which ? r - G_IN : r) * 16;
            const int N = which ? FF : IN_DIM;
            const bf16_t* W = (which ? p.wt_ff1 + (size_t)l * FF * DM : p.wt_in + (size_t)l * IN_DIM * DM) + (size_t)(n0 + fr) * DM + fq * 8;
            float* dst = which ? p.shw_ff1 + (size_t)l * 5 * FF : p.shw_in + (size_t)l * 5 * IN_DIM;
            const int c = fr < 5 ? fr : fr - 5;
            const float* sh = p.mod + ((size_t)l * 5 + (c < 5 ? c : 0)) * 6144 + (which ? 3 : 0) * DM + fq * 8;
            f32x4 acc = {0.f, 0.f, 0.f, 0.f};
#pragma unroll 8
            for (int ks = 0; ks < 32; ++ks) {
                const bf16x8 wv = *(const bf16x8*)(W + ks * 32);
                const f32x4 s0 = *(const f32x4*)(sh + ks * 32), s1 = *(const f32x4*)(sh + ks * 32 + 4);
                float sv[8] = {s0[0], s0[1], s0[2], s0[3], s1[0], s1[1], s1[2], s1[3]};
                u32x4 aw;
#pragma unroll
                for (int j = 0; j < 4; ++j) {
                    float a0 = sv[2 * j], a1 = sv[2 * j + 1];
                    const unsigned hi = pk2(a0, a1);
                    if (fr >= 5) { a0 -= __uint_as_float(hi << 16); a1 -= __uint_as_float(hi & 0xffff0000u); }
                    aw[j] = fr < 5 ? hi : (fr < 10 ? pk2(a0, a1) : 0u);
                }
                acc = __builtin_amdgcn_mfma_f32_16x16x32_bf16(__builtin_bit_cast(bf16x8, aw), wv, acc, 0, 0, 0);
            }
            const float r4 = __shfl(acc[0], fr + 16);
            const float r5 = __shfl(acc[1], fr + 16), r6 = __shfl(acc[2], fr + 16), r7 = __shfl(acc[3], fr + 16);
            const float r8 = __shfl(acc[0], fr + 32), r9 = __shfl(acc[1], fr + 32);
            if (fq == 0) {
                dst[(size_t)0 * N + n0 + fr] = acc[0] + r5;
                dst[(size_t)1 * N + n0 + fr] = acc[1] + r6;
                dst[(size_t)2 * N + n0 + fr] = acc[2] + r7;
                dst[(size_t)3 * N + n0 + fr] = acc[3] + r8;
                dst[(size_t)4 * N + n0 + fr] = r4 + r9;
            }
        }
    }
}

constexpr int G_TILE_B = 256 * 64 * 2, G_STAGE_B = 2 * G_TILE_B;
DI int lds_byte2(int r, int c) {
    const int st = (r >> 4) * 2 + (c >> 5), ob = (r & 15) * 64 + (c & 31) * 2;
    return st * 1024 + (ob ^ (((ob >> 9) & 1) << 5));
}
DI void stage_rc2(int b, int& R, int& C) {
    const int st = b >> 10, sb = b & 1023, swz = sb ^ (((sb >> 9) & 1) << 5);
    R = (st >> 1) * 16 + swz / 64;
    C = (st & 1) * 32 + (swz % 64) / 2;
}
template <int KS> DI int lds_byte_ks(int r, int c) {
    const int st = (r >> 4) * KS + (c >> 5), ob = (r & 15) * 64 + (c & 31) * 2;
    return st * 1024 + (ob ^ (((ob >> 9) & 1) << 5));
}
template <int KS> DI void stage_rc_ks(int b, int& R, int& C) {
    const int st = b >> 10, sb = b & 1023, swz = sb ^ (((sb >> 9) & 1) << 5);
    R = (st / KS) * 16 + swz / 64;
    C = (st % KS) * 32 + (swz % 64) / 2;
}
#define WAIT_V0() asm volatile("s_waitcnt vmcnt(0)" ::: "memory")

struct TileCtx { int brow, bcol, pn, wr, wc, fr, fq, wid, lane, l; };

DI void tile_coords(int L, int nM, int nN, int& pm, int& pn) {
    const int nwg = nM * nN;
    int wgid = L;
    { const int q = nwg / 8, r = nwg % 8, xcd = wgid % 8, off = wgid / 8; wgid = (xcd < r ? xcd * (q + 1) : r * (q + 1) + (xcd - r) * q) + off; }
    const int nig = 8 * nN, gid = wgid / nig, fm = gid * 8, gsz = (nM - fm) < 8 ? (nM - fm) : 8;
    pm = fm + ((wgid % nig) % gsz); pn = (wgid % nig) / gsz;
}

DI void wave_put(ldsp_t wb, int rowl, int n, int fq, u32x2 w) {
    const int chunk = n * 2 + (fq >> 1);
    *(LDSP u32x2*)(wb + rowl * 128 + ((chunk ^ (rowl & 7)) << 4) + (fq & 1) * 8) = w;
}
DI void wave_rows_store(ldsp_t wb, int lane, bf16_t* dst0, size_t ld) {
#pragma unroll
    for (int i = 0; i < 8; ++i) {
        const int row = i * 8 + (lane >> 3), ch = lane & 7;
        const u32x4 v = *(const LDSP u32x4*)(wb + row * 128 + ((ch ^ (row & 7)) << 4));
        *(u32x4*)(dst0 + (size_t)row * ld + ch * 8) = v;
    }
}

template <int EK> struct EpiResid {
    static DI void run(const f32x4 (&acc)[8][4], const TileCtx& tc, const Params& p, ldsp_t wb) {
        constexpr int GI = EK == 1 ? 2 : 5;
        const int cond = tc.brow < NLAT ? (tc.brow >> 12) : 4;
        const float* gate = p.mod + ((size_t)tc.l * 5 + cond) * 6144 + GI * DM;
        const int col0 = tc.bcol + tc.wc * 64 + tc.fq * 4;
        const bool has_next = EK == 1 || tc.l + 1 < DEPTH;
        const int ln = EK == 1 ? tc.l : (has_next ? tc.l + 1 : tc.l);
        const float* gnx = (EK == 1 ? p.norm2_g : p.norm1_g) + (size_t)ln * DM + col0;
        const float* scn = p.mod + ((size_t)ln * 5 + cond) * 6144 + (EK == 1 ? 4 : 1) * DM + col0;
        float* ssp = p.ss + (size_t)(ln * 2 + (EK == 1 ? 1 : 0)) * NTOK * 16 + (tc.bcol >> 8) * 4 + tc.wc;
        f32x4 gv[4], av[4];
#pragma unroll
        for (int n = 0; n < 4; ++n) {
            gv[n] = *(const f32x4*)(gate + col0 + n * 16);
            const f32x4 g1 = *(const f32x4*)(gnx + n * 16), s1 = *(const f32x4*)(scn + n * 16);
            av[n] = g1 * (1.f + s1);
        }
#pragma unroll
        for (int h = 0; h < 2; ++h) {
#pragma unroll
            for (int mm = 0; mm < 4; ++mm) { __builtin_amdgcn_sched_barrier(0);
                const int m = h * 4 + mm;
                const int row = tc.brow + tc.wr * 128 + m * 16 + tc.fr;
                float* xr = xrow_ptr(p, row) + col0;
                float part = 0.f;
#pragma unroll
                for (int n = 0; n < 4; ++n) {
                    f32x4 xv = *(const f32x4*)(xr + n * 16);
                    xv += gv[n] * acc[m][n];
                    *(f32x4*)(xr + n * 16) = xv;
                    if (has_next) {
                        part += xv[0] * xv[0] + xv[1] * xv[1] + xv[2] * xv[2] + xv[3] * xv[3];
                        const f32x4 hv = xv * av[n];
                        u32x2 w; w[0] = pk2(hv[0], hv[1]); w[1] = pk2(hv[2], hv[3]);
                        wave_put(wb, mm * 16 + tc.fr, n, tc.fq, w);
                    }
                }
                if (has_next) {
                    part += __shfl_xor(part, 16);
                    part += __shfl_xor(part, 32);
                    if (tc.fq == 0) ssp[(size_t)row * 16] = part;
                }
            }
            if (has_next) wave_rows_store(wb, tc.lane, p.H + (size_t)(tc.brow + tc.wr * 128 + h * 64) * DM + tc.bcol + tc.wc * 64, DM);
        }
    }
};
struct EpiFF1 {
    static DI void run(const f32x4 (&acc)[8][4], const TileCtx& tc, const Params& p, ldsp_t wb) {
#pragma unroll
        for (int h = 0; h < 2; ++h) {
#pragma unroll
            for (int mm = 0; mm < 4; ++mm) {
                const int m = h * 4 + mm;
#pragma unroll
                for (int n = 0; n < 4; ++n) {
                    f32x4 a = acc[m][n];
#pragma unroll
                    for (int j = 0; j < 4; ++j) { const float r = fmaxf(a[j], 0.f); a[j] = r * r; }
                    u32x2 w; w[0] = pk2(a[0], a[1]); w[1] = pk2(a[2], a[3]);
                    wave_put(wb, mm * 16 + tc.fr, n, tc.fq, w);
                }
            }
            wave_rows_store(wb, tc.lane, p.ACT + (size_t)(tc.brow + tc.wr * 128 + h * 64) * FF + tc.bcol + tc.wc * 64, FF);
        }
    }
};
template <int BRK> struct EpiIn {
    static DI void run(const f32x4 (&acc)[8][4], const TileCtx& tc, const Params& p, ldsp_t wb) {
        const int l = tc.l, pn = tc.pn, wc = tc.wc, fr = tc.fr, fq = tc.fq;
        if (BRK == 0 || (BRK == 1 && wc < 2)) {
            constexpr bool isq = BRK == 0;
            const int head = isq ? pn * 4 + wc : wc;
            const float* gn = (isq ? p.q_norm_g : p.k_norm_g) + l * 64;
            f32x4 gv[4];
#pragma unroll
            for (int n = 0; n < 4; ++n) gv[n] = *(const f32x4*)(gn + n * 16 + fq * 4);
            const float osc = isq ? 0.125f * LOG2E : 1.f;
            const bool lat = tc.brow < NLAT;
#pragma unroll
            for (int h = 0; h < 2; ++h) {
#pragma unroll
                for (int mm = 0; mm < 4; ++mm) { __builtin_amdgcn_sched_barrier(0);
                    const int m = h * 4 + mm;
                    const int row = tc.brow + tc.wr * 128 + m * 16 + fr;
                    float ss = 0.f;
#pragma unroll
                    for (int n = 0; n < 4; ++n)
#pragma unroll
                        for (int j = 0; j < 4; ++j) ss += acc[m][n][j] * acc[m][n][j];
                    ss += __shfl_xor(ss, 16);
                    ss += __shfl_xor(ss, 32);
                    const float rstd = rsqrtf(ss * (1.f / 64.f) + EPS) * osc;
                    const int t = row & 4095;
#pragma unroll
                    for (int ax = 0; ax < 2; ++ax) {
                        f32x4 x1 = acc[m][2 * ax] * rstd * gv[2 * ax], x2 = acc[m][2 * ax + 1] * rstd * gv[2 * ax + 1];
                        if (lat) {
                            const int pos = ax == 0 ? (t >> 6) : (t & 63);
                            const f32x4 cs = *(const f32x4*)(p.rope + pos * 16 + fq * 4), sn = *(const f32x4*)(p.rope + 1024 + pos * 16 + fq * 4);
                            const f32x4 o1 = x1 * cs - x2 * sn, o2 = x2 * cs + x1 * sn;
                            x1 = o1; x2 = o2;
                        }
                        u32x2 w; w[0] = pk2(x1[0], x1[1]); w[1] = pk2(x1[2], x1[3]);
                        wave_put(wb, mm * 16 + fr, 2 * ax, fq, w);
                        w[0] = pk2(x2[0], x2[1]); w[1] = pk2(x2[2], x2[3]);
                        wave_put(wb, mm * 16 + fr, 2 * ax + 1, fq, w);
                    }
                }
                const int row0 = tc.brow + tc.wr * 128 + h * 64;
                bf16_t* dst0;
                if (lat) {
                    const int b = row0 >> 12, t0 = row0 & 4095;
                    dst0 = isq ? p.Q + ((size_t)(b * 8 + head) * SEQ + t0) * 64 : p.K + ((size_t)(b * 2 + head) * NKEY + CTXL + t0) * 64;
                } else {
                    const int r2 = row0 - NLAT, b = r2 >> 8, t0 = r2 & 255;
                    dst0 = isq ? p.Qc + ((size_t)(b * 8 + head) * CTXL + t0) * 64 : p.K + ((size_t)(b * 2 + head) * NKEY + t0) * 64;
                }
                wave_rows_store(wb, tc.lane, dst0, 64);
            }
        } else if (BRK == 1) {
            const int kvh = wc - 2;
#pragma unroll
            for (int h = 0; h < 2; ++h) {
#pragma unroll
                for (int mm = 0; mm < 4; ++mm) {
                    const int m = h * 4 + mm;
                    const int key = mm * 16 + fr, k16 = key & 15;
                    const int kp = (key & ~15) | ((((k16 >> 2) & 1) << 3) + (k16 & 3) + ((k16 >> 3) << 2));
#pragma unroll
                    for (int n = 0; n < 4; ++n)
#pragma unroll
                        for (int j = 0; j < 4; ++j) {
                            const int d = n * 16 + fq * 4 + j;
                            *(LDSP bf16_t*)(wb + d * 128 + (((kp >> 3) ^ (d & 7)) << 4) + (kp & 7) * 2) = f2bf(acc[m][n][j]);
                        }
                }
                const int row0 = tc.brow + tc.wr * 128 + h * 64;
                int b, pos0;
                if (row0 < NLAT) { b = row0 >> 12; pos0 = CTXL + (row0 & 4095); } else { const int r2 = row0 - NLAT; b = r2 >> 8; pos0 = r2 & 255; }
                wave_rows_store(wb, tc.lane, p.Vt + (size_t)(b * 2 + kvh) * 64 * NKEY + pos0, NKEY);
            }
        } else if (BRK == 2) {
#pragma unroll
            for (int h = 0; h < 2; ++h) {
#pragma unroll
                for (int mm = 0; mm < 4; ++mm) {
                    const int m = h * 4 + mm;
#pragma unroll
                    for (int n = 0; n < 4; ++n) {
                        u32x2 w; w[0] = pk2(gelu_tanh(acc[m][n][0]), gelu_tanh(acc[m][n][1])); w[1] = pk2(gelu_tanh(acc[m][n][2]), gelu_tanh(acc[m][n][3]));
                        wave_put(wb, mm * 16 + fr, n, fq, w);
                    }
                }
                wave_rows_store(wb, tc.lane, p.U + (size_t)(tc.brow + tc.wr * 128 + h * 64) * 1024 + (pn - 3) * 256 + wc * 64, 1024);
            }
        }
    }
};

template <int EK>
DI void gemm_stream(const Params& p, int l, const bf16_t* __restrict__ A, const bf16_t* __restrict__ Bt, int M, int N, int K, ldsp_t shm) {
    const int nM = M / 256, nN = N / 256, nwg = nM * nN;
    int L = blockIdx.x;
    if (L >= nwg) return;
#define G_SA(b) (shm + (b) * G_STAGE_B)
#define G_SB(b) (shm + (b) * G_STAGE_B + G_TILE_B)
#define G_LANE_SETUP() \
    int tid_ = threadIdx.x; \
    asm volatile("" : "+v"(tid_));    \
    const int wid = tid_ >> 6, lane = tid_ & 63, wr = wid >> 2, wc = wid & 3, fr = lane & 15, fq = lane >> 4; \
    unsigned soff[4];        \
    _Pragma("unroll") for (int i = 0; i < 4; ++i) { int sR, sC; stage_rc2(wid * 1024 + i * 8192 + lane * 16, sR, sC); soff[i] = (unsigned)(sR * K + sC) * 2u; }
#define G_STAGE_A(Ap, buf, kt) do { const char* ab_ = (const char*)(Ap) + (size_t)(kt) * 128; \
      _Pragma("unroll") for (int i = 0; i < 4; ++i) \
        __builtin_amdgcn_global_load_lds((const unsigned*)(ab_ + soff[i]), (LDSP unsigned*)(G_SA(buf) + wid * 1024 + i * 8192), 16, 0, 0); } while (0)
#define G_STAGE_B(Bp, buf, kt) do { const char* bb_ = (const char*)(Bp) + (size_t)(kt) * 128; \
      _Pragma("unroll") for (int i = 0; i < 4; ++i) \
        __builtin_amdgcn_global_load_lds((const unsigned*)(bb_ + soff[i]), (LDSP unsigned*)(G_SB(buf) + wid * 1024 + i * 8192), 16, 0, 0); } while (0)
#define G_STAGE(Ap, Bp, buf, kt) do { const char* ab_ = (const char*)(Ap) + (size_t)(kt) * 128; const char* bb_ = (const char*)(Bp) + (size_t)(kt) * 128; \
      _Pragma("unroll") for (int i = 0; i < 4; ++i) { \
        __builtin_amdgcn_global_load_lds((const unsigned*)(ab_ + soff[i]), (LDSP unsigned*)(G_SA(buf) + wid * 1024 + i * 8192), 16, 0, 0); \
        __builtin_amdgcn_global_load_lds((const unsigned*)(bb_ + soff[i]), (LDSP unsigned*)(G_SB(buf) + wid * 1024 + i * 8192), 16, 0, 0); } } while (0)
    const int nt = K / 64;
    int pm, pn;
    tile_coords(L, nM, nN, pm, pn);
    const bf16_t* Ab = A + (size_t)pm * 256 * K;
    const bf16_t* Bb = Bt + (size_t)pn * 256 * K;
    { G_LANE_SETUP(); (void)wr; (void)wc; (void)fr; (void)fq; G_STAGE(Ab, Bb, 0, 0); WAIT_V0(); __syncthreads(); }
    while (true) {
        G_LANE_SETUP();
        const int aoff = lds_byte2(wr * 128 + fr, fq * 8), boff = lds_byte2(wc * 64 + fr, fq * 8);
        f32x4 acc[8][4];
#pragma unroll
        for (int m = 0; m < 8; ++m)
#pragma unroll
            for (int n = 0; n < 4; ++n) acc[m][n] = (f32x4){0.f, 0.f, 0.f, 0.f};
        const int Ln = L + gridDim.x;
        const bool has_next = Ln < nwg;
        int pm2 = pm, pn2 = pn;
        if (has_next) tile_coords(Ln, nM, nN, pm2, pn2);
        const bf16_t* Ab2 = A + (size_t)pm2 * 256 * K;
        const bf16_t* Bb2 = Bt + (size_t)pn2 * 256 * K;
        bf16x8 Aa[4], Ab_[4], Bk0[4], Bk1[4];
#define G_RDA(AF, buf, ks, mh) do { _Pragma("unroll") for (int m = 0; m < 4; ++m) AF[m] = *(const LDSP bf16x8*)(G_SA(buf) + aoff + ((mh) * 4 + m) * 2048 + (ks) * 1024); } while (0)
#define G_RDB(BF, buf, ks) do { _Pragma("unroll") for (int n = 0; n < 4; ++n) BF[n] = *(const LDSP bf16x8*)(G_SB(buf) + boff + n * 2048 + (ks) * 1024); } while (0)
#define G_MMA(AF, BF, mh) do { __builtin_amdgcn_s_setprio(1); \
            _Pragma("unroll") for (int m = 0; m < 4; ++m) _Pragma("unroll") for (int n = 0; n < 4; ++n) \
                acc[(mh) * 4 + m][n] = __builtin_amdgcn_mfma_f32_16x16x32_bf16(BF[n], AF[m], acc[(mh) * 4 + m][n], 0, 0, 0); \
            __builtin_amdgcn_s_setprio(0); } while (0)
#define G_SB0() __builtin_amdgcn_sched_barrier(0)
        for (int t = 0; t < nt; ++t) {
            const int cur = t & 1;
            G_RDA(Aa, cur, 0, 0); G_RDB(Bk0, cur, 0);
            if (t + 1 < nt) G_STAGE_B(Bb, cur ^ 1, t + 1);
            else if (has_next) G_STAGE_B(Bb2, cur ^ 1, 0);
            G_SB0();
            if (t > 0) G_MMA(Ab_, Bk1, 1);
            G_SB0();
            if (t + 1 < nt) G_STAGE_A(Ab, cur ^ 1, t + 1);
            else if (has_next) G_STAGE_A(Ab2, cur ^ 1, 0);
            G_RDA(Ab_, cur, 0, 1); G_SB0();
            G_MMA(Aa, Bk0, 0); G_SB0();
            G_RDA(Aa, cur, 1, 0); G_RDB(Bk1, cur, 1); G_SB0();
            G_MMA(Ab_, Bk0, 1); G_SB0();
            G_RDA(Ab_, cur, 1, 1); G_SB0();
            G_MMA(Aa, Bk1, 0); G_SB0();
            asm volatile("s_waitcnt lgkmcnt(0)" ::: "memory");
            WAIT_V0(); __syncthreads();
        }
        G_MMA(Ab_, Bk1, 1);
        G_SB0();
        {
            int tid2 = threadIdx.x, pme = pm, pne = pn;
            asm volatile("" : "+v"(tid2), "+s"(pme), "+s"(pne));
            TileCtx tc;
            tc.wid = tid2 >> 6; tc.lane = tid2 & 63; tc.wr = tc.wid >> 2; tc.wc = tc.wid & 3; tc.fr = tc.lane & 15; tc.fq = tc.lane >> 4; tc.l = l;
            tc.brow = pme * 256; tc.bcol = pne * 256; tc.pn = pne;
            ldsp_t ex = shm + G_STAGE_B + tc.wid * 8192;
            if (EK == 0 || EK == 2) {
                const int cond = tc.brow < NLAT ? (tc.brow >> 12) : 4;
                const float* ssp = p.ss + ((size_t)(l * 2 + (EK == 0 ? 0 : 1)) * NTOK + tc.brow + tc.wr * 128 + tc.fr) * 16 + tc.fq * 4;
                const float* shw = (EK == 0 ? p.shw_in + ((size_t)l * 5 + cond) * IN_DIM : p.shw_ff1 + ((size_t)l * 5 + cond) * FF) + tc.bcol + tc.wc * 64 + tc.fq * 4;
                f32x4 shv[4];
#pragma unroll
                for (int n = 0; n < 4; ++n) shv[n] = *(const f32x4*)(shw + n * 16);
#pragma unroll
                for (int m = 0; m < 8; ++m) {
                    const f32x4 pp = *(const f32x4*)(ssp + m * 256);
                    float sq = pp[0] + pp[1] + pp[2] + pp[3];
                    sq += __shfl_xor(sq, 16);
                    sq += __shfl_xor(sq, 32);
                    const float rstd = rsqrtf(sq * (1.f / DM) + EPS);
#pragma unroll
                    for (int n = 0; n < 4; ++n) acc[m][n] = acc[m][n] * rstd + shv[n];
                }
            }
            if (EK == 0) {
                if (pne < 2) EpiIn<0>::run(acc, tc, p, ex);
                else if (pne == 2) EpiIn<1>::run(acc, tc, p, ex);
                else EpiIn<2>::run(acc, tc, p, ex);
            } else if (EK == 1) EpiResid<1>::run(acc, tc, p, ex);
            else if (EK == 2) EpiFF1::run(acc, tc, p, ex);
            else EpiResid<3>::run(acc, tc, p, ex);
        }
        __syncthreads();
        if (!has_next) break;
        L = Ln; pm = pm2; pn = pn2; Ab = Ab2; Bb = Bb2;
    }
}

template <int EK>
DI void ctx_item(const Params& p, int l, int grow, int gcol, int slot, f32x4 s0, f32x4 s1, bool lead) {
    if (EK == 2) {
        const float* pp = p.ss + ((size_t)(l * 2 + 1) * NTOK + NLAT + grow) * 16;
        const f32x4 q0 = *(const f32x4*)pp, q1 = *(const f32x4*)(pp + 4), q2 = *(const f32x4*)(pp + 8), q3 = *(const f32x4*)(pp + 12);
        const f32x4 qs = q0 + q1 + q2 + q3;
        const float rstd = rsqrtf((qs[0] + qs[1] + qs[2] + qs[3]) * (1.f / DM) + EPS);
        const float* shw = p.shw_ff1 + ((size_t)l * 5 + 4) * FF + gcol;
        const f32x4 h0 = *(const f32x4*)shw, h1 = *(const f32x4*)(shw + 4);
        s0 = s0 * rstd + h0; s1 = s1 * rstd + h1;
#pragma unroll
        for (int j = 0; j < 4; ++j) { float r0 = fmaxf(s0[j], 0.f), r1 = fmaxf(s1[j], 0.f); s0[j] = r0 * r0; s1[j] = r1 * r1; }
        u32x4 w; w[0] = pk2(s0[0], s0[1]); w[1] = pk2(s0[2], s0[3]); w[2] = pk2(s1[0], s1[1]); w[3] = pk2(s1[2], s1[3]);
        *(u32x4*)(p.ACT + (size_t)(NLAT + grow) * FF + gcol) = w;
    } else {
        const float* gate = p.mod + ((size_t)l * 5 + 4) * 6144 + (EK == 1 ? 2 : 5) * DM + gcol;
        float* xr = p.xc + (size_t)grow * DM + gcol;
        const f32x4 g0 = *(const f32x4*)gate, g1 = *(const f32x4*)(gate + 4);
        f32x4 x0 = *(const f32x4*)xr, x1 = *(const f32x4*)(xr + 4);
        x0 += g0 * s0; x1 += g1 * s1;
        *(f32x4*)xr = x0; *(f32x4*)(xr + 4) = x1;
        const int ln = EK == 1 ? l : l + 1;
        const float* gnx = (EK == 1 ? p.norm2_g : p.norm1_g) + (size_t)ln * DM + gcol;
        const float* scn = p.mod + ((size_t)ln * 5 + 4) * 6144 + (EK == 1 ? 4 : 1) * DM + gcol;
        const f32x4 a0 = *(const f32x4*)gnx * (1.f + *(const f32x4*)scn), a1 = *(const f32x4*)(gnx + 4) * (1.f + *(const f32x4*)(scn + 4));
        const f32x4 y0 = x0 * a0, y1 = x1 * a1;
        u32x4 w; w[0] = pk2(y0[0], y0[1]); w[1] = pk2(y0[2], y0[3]); w[2] = pk2(y1[0], y1[1]); w[3] = pk2(y1[2], y1[3]);
        *(u32x4*)(p.H + (size_t)(NLAT + grow) * DM + gcol) = w;
        float part = x0[0] * x0[0] + x0[1] * x0[1] + x0[2] * x0[2] + x0[3] * x0[3] + x1[0] * x1[0] + x1[1] * x1[1] + x1[2] * x1[2] + x1[3] * x1[3];
        part += __shfl_xor(part, 1); part += __shfl_xor(part, 2); part += __shfl_xor(part, 4);
        if (lead) p.ss[((size_t)(ln * 2 + (EK == 1 ? 1 : 0)) * NTOK + NLAT + grow) * 16 + slot] = part;
    }
}

template <int EK, int TS, int KS>
DI void ctx_tiles(const Params& p, int l, const bf16_t* __restrict__ A, const bf16_t* __restrict__ Bt, int N, int K, ldsp_t shm) {
    constexpr int WM = TS / 2, WN = TS / 4, MT = WM / 16, NT = WN / 16, BKC = 32 * KS;
    constexpr int TILE_A = TS * BKC * 2, PP = TILE_A / 8192;
    const int ntn = N / TS, ntiles = (NCTX / TS) * ntn, nt = K / BKC;
    for (int u = blockIdx.x; u < ntiles; u += gridDim.x) {
        const int tm = u / ntn, tn = u % ntn;
        int tid = threadIdx.x;
        asm volatile("" : "+v"(tid));
        const int wid = tid >> 6, lane = tid & 63, wr = wid >> 2, wc = wid & 3, fr = lane & 15, fq = lane >> 4;
        unsigned soff[PP];
#pragma unroll
        for (int i = 0; i < PP; ++i) { int sR, sC; stage_rc_ks<KS>((wid * PP + i) * 1024 + lane * 16, sR, sC); soff[i] = (unsigned)(sR * K + sC) * 2u; }
        const bf16_t* Ab = A + (size_t)tm * TS * K;
        const bf16_t* Bb = Bt + (size_t)tn * TS * K;
#define C_STAGE(buf, kt) do { const char* ab_ = (const char*)Ab + (size_t)(kt) * (BKC * 2); const char* bb_ = (const char*)Bb + (size_t)(kt) * (BKC * 2); \
      _Pragma("unroll") for (int i = 0; i < PP; ++i) { \
        __builtin_amdgcn_global_load_lds((const unsigned*)(ab_ + soff[i]), (LDSP unsigned*)(shm + (buf) * 2 * TILE_A + (wid * PP + i) * 1024), 16, 0, 0); \
        __builtin_amdgcn_global_load_lds((const unsigned*)(bb_ + soff[i]), (LDSP unsigned*)(shm + (buf) * 2 * TILE_A + TILE_A + (wid * PP + i) * 1024), 16, 0, 0); } } while (0)
        f32x4 acc[MT][NT];
#pragma unroll
        for (int m = 0; m < MT; ++m)
#pragma unroll
            for (int n = 0; n < NT; ++n) acc[m][n] = (f32x4){0.f, 0.f, 0.f, 0.f};
        const int aoff = lds_byte_ks<KS>(wr * WM + fr, fq * 8), boff = lds_byte_ks<KS>(wc * WN + fr, fq * 8);
        C_STAGE(0, 0); WAIT_V0(); __syncthreads();
        for (int t = 0; t < nt; ++t) {
            const int cur = t & 1;
            if (t + 1 < nt) C_STAGE(cur ^ 1, t + 1);
            ldsp_t sa = shm + cur * 2 * TILE_A, sb = sa + TILE_A;
#pragma unroll
            for (int ks = 0; ks < KS; ++ks) {
                bf16x8 At[MT], Bf[NT];
#pragma unroll
                for (int m = 0; m < MT; ++m) At[m] = *(const LDSP bf16x8*)(sa + aoff + m * (KS * 1024) + ks * 1024);
#pragma unroll
                for (int n = 0; n < NT; ++n) Bf[n] = *(const LDSP bf16x8*)(sb + boff + n * (KS * 1024) + ks * 1024);
#pragma unroll
                for (int m = 0; m < MT; ++m)
#pragma unroll
                    for (int n = 0; n < NT; ++n) acc[m][n] = __builtin_amdgcn_mfma_f32_16x16x32_bf16(Bf[n], At[m], acc[m][n], 0, 0, 0);
            }
            WAIT_V0(); __syncthreads();
        }
#pragma unroll
        for (int m = 0; m < MT; ++m)
#pragma unroll
            for (int n = 0; n < NT; ++n) {
                const int row = wr * WM + m * 16 + fr, ch = (wc * WN + n * 16 + fq * 4) >> 2;
                *(LDSP f32x4*)(shm + row * (TS * 4) + ((ch ^ (row & 15)) << 4)) = acc[m][n];
            }
        __syncthreads();
#pragma unroll
        for (int it = 0; it < (TS * TS / 8) / 512; ++it) {
            const int item = it * 512 + tid, row = item / (TS / 8), c8 = item % (TS / 8);
            const f32x4 s0 = *(const LDSP f32x4*)(shm + row * (TS * 4) + (((2 * c8) ^ (row & 15)) << 4));
            const f32x4 s1 = *(const LDSP f32x4*)(shm + row * (TS * 4) + (((2 * c8 + 1) ^ (row & 15)) << 4));
            ctx_item<EK>(p, l, tm * TS + row, tn * TS + c8 * 8, tn, s0, s1, c8 == 0);
        }
        __syncthreads();
    }
}

DI void attn_unit(const Params& p, int l, int b, int kvh, int qb, bool isctx, ldsp_t smem) {
    int tid = threadIdx.x;
    asm volatile("" : "+v"(tid));
    const int wid = tid >> 6, lane = tid & 63, r = lane & 31, hh = lane >> 5;
    const int head = kvh * 4 + (wid >> 1);
    const int t0 = qb * 64 + (wid & 1) * 32;
    const int nkeys = isctx ? CTXL : NKEY;
    const bf16_t* Qp = isctx ? p.Qc + ((size_t)(b * 8 + head) * CTXL + t0) * 64 : p.Q + ((size_t)(b * 8 + head) * SEQ + t0) * 64;
    const bf16_t* Kp = p.K + (size_t)(b * 2 + kvh) * NKEY * 64;
    const bf16_t* Vp = p.Vt + (size_t)(b * 2 + kvh) * 64 * NKEY;
    const int orow = isctx ? NLAT + b * CTXL + t0 : b * SEQ + t0;
    bf16_t* Op = p.MIX + (size_t)orow * DM + head * 64;
    const float cexp = p.smax[l] * LOG2E;

    bf16x8 qf[4];
#pragma unroll
    for (int ks = 0; ks < 4; ++ks) qf[ks] = *(const bf16x8*)(Qp + (size_t)r * 64 + ks * 16 + 8 * hh);
    f32x16 o[2];
#pragma unroll
    for (int i = 0; i < 16; ++i) { o[0][i] = 0.f; o[1][i] = 0.f; }
    float rs0 = 0.f, rs1 = 0.f;

    const int srow = tid >> 3, sch = tid & 7;
    const int kdst = srow * 128 + ((sch ^ ((srow >> 1) & 7)) << 4);
    const bf16_t* kg = Kp + (size_t)srow * 64 + sch * 8;
    const bf16_t* vg = Vp + (size_t)srow * NKEY + sch * 8;
    const int rsw = (r >> 1) & 7;
    const int ntile = nkeys / 64;

#define ATT_QK(SD, kb) do { _Pragma("unroll") for (int kt = 0; kt < 2; ++kt) { \
        _Pragma("unroll") for (int i = 0; i < 16; ++i) SD[kt][i] = -cexp; \
        _Pragma("unroll") for (int ks = 0; ks < 4; ++ks) { \
            const bf16x8 a_ = *(const LDSP bf16x8*)((kb) + (kt * 32 + r) * 128 + (((ks * 2 + hh) ^ rsw) << 4)); \
            SD[kt] = __builtin_amdgcn_mfma_f32_32x32x16_bf16(a_, qf[ks], SD[kt], 0, 0, 0); } } } while (0)

    u32x4 kst, vst;
    f32x16 sA[2], sB[2];
    {
        kst = *(const u32x4*)kg;
        *(LDSP u32x4*)(smem + kdst) = kst;
        kst = *(const u32x4*)(kg + (size_t)64 * 64);
        vst = *(const u32x4*)vg;
        __syncthreads();
        ATT_QK(sA, smem);
        *(LDSP u32x4*)(smem + 8192 + kdst) = kst;
        *(LDSP u32x4*)(smem + 16384 + kdst) = vst;
    }
#define ATT_STEP(t, SC, SN) do { \
        const int par = (t) & 1; \
        __syncthreads(); \
        { const int t2_ = (t) + 2 < ntile ? (t) + 2 : ntile - 1, t1_ = (t) + 1 < ntile ? (t) + 1 : ntile - 1; \
          kst = *(const u32x4*)(kg + (size_t)t2_ * 64 * 64); vst = *(const u32x4*)(vg + t1_ * 64); } \
        bf16x8 kf[8], vf[4], vh[4]; \
        ldsp_t kb_ = smem + (par ^ 1) * 8192; ldsp_t vb_ = smem + 16384 + par * 8192; \
        _Pragma("unroll") for (int kt = 0; kt < 2; ++kt) _Pragma("unroll") for (int ks = 0; ks < 4; ++ks) \
            kf[kt * 4 + ks] = *(const LDSP bf16x8*)(kb_ + (kt * 32 + r) * 128 + (((ks * 2 + hh) ^ rsw) << 4)); \
        _Pragma("unroll") for (int c = 0; c < 2; ++c) _Pragma("unroll") for (int dt = 0; dt < 2; ++dt) \
            vf[c * 2 + dt] = *(const LDSP bf16x8*)(vb_ + (dt * 32 + r) * 128 + (((c * 2 + hh) ^ rsw) << 4)); \
        __builtin_amdgcn_sched_barrier(0); \
        _Pragma("unroll") for (int kt = 0; kt < 2; ++kt) _Pragma("unroll") for (int i = 0; i < 16; ++i) SN[kt][i] = -cexp;     \
        _Pragma("unroll") for (int ks = 0; ks < 4; ++ks) _Pragma("unroll") for (int kt = 0; kt < 2; ++kt) \
            SN[kt] = __builtin_amdgcn_mfma_f32_32x32x16_bf16(kf[kt * 4 + ks], qf[ks], SN[kt], 0, 0, 0); \
        _Pragma("unroll") for (int c = 2; c < 4; ++c) _Pragma("unroll") for (int dt = 0; dt < 2; ++dt) \
            vh[(c - 2) * 2 + dt] = *(const LDSP bf16x8*)(vb_ + (dt * 32 + r) * 128 + (((c * 2 + hh) ^ rsw) << 4)); \
        _Pragma("unroll") for (int kt = 0; kt < 2; ++kt) { \
            _Pragma("unroll") for (int i = 0; i < 16; ++i) { \
                const float e_ = fexp2(SC[kt][i]); \
                if (i & 1) rs1 += e_; else rs0 += e_; \
                SC[kt][i] = e_; } } \
        _Pragma("unroll") for (int c = 0; c < 4; ++c) { \
            u32x4 pw; \
            pw[0] = pk2(SC[c >> 1][8 * (c & 1) + 0], SC[c >> 1][8 * (c & 1) + 1]); pw[1] = pk2(SC[c >> 1][8 * (c & 1) + 2], SC[c >> 1][8 * (c & 1) + 3]); \
            pw[2] = pk2(SC[c >> 1][8 * (c & 1) + 4], SC[c >> 1][8 * (c & 1) + 5]); pw[3] = pk2(SC[c >> 1][8 * (c & 1) + 6], SC[c >> 1][8 * (c & 1) + 7]); \
            const bf16x8 pb = __builtin_bit_cast(bf16x8, pw); \
            _Pragma("unroll") for (int dt = 0; dt < 2; ++dt) o[dt] = __builtin_amdgcn_mfma_f32_32x32x16_bf16(c < 2 ? vf[c * 2 + dt] : vh[(c - 2) * 2 + dt], pb, o[dt], 0, 0, 0); } \
        *(LDSP u32x4*)(smem + par * 8192 + kdst) = kst; \
        *(LDSP u32x4*)(smem + 16384 + (par ^ 1) * 8192 + kdst) = vst; \
    } while (0)

    for (int t = 0; t < ntile; t += 2) {
        ATT_STEP(t, sA, sB);
        ATT_STEP(t + 1, sB, sA);
    }
    const float lrun = rs0 + rs1;
    const float ltot = lrun + __shfl_xor(lrun, 32);
    const float inv = 1.f / ltot;
#pragma unroll
    for (int dt = 0; dt < 2; ++dt)
#pragma unroll
        for (int g4 = 0; g4 < 4; ++g4) {
            u32x2 w; w[0] = pk2(o[dt][4 * g4 + 0] * inv, o[dt][4 * g4 + 1] * inv); w[1] = pk2(o[dt][4 * g4 + 2] * inv, o[dt][4 * g4 + 3] * inv);
            *(u32x2*)(Op + (size_t)r * DM + dt * 32 + 8 * g4 + 4 * hh) = w;
        }
    __syncthreads();
}

DI void gmlp_unit(const Params& p, int l, int T, int g, ldsp_t smem) {
    int tid = threadIdx.x;
    asm volatile("" : "+v"(tid));
    const int wid = tid >> 6, lane = tid & 63, fr = lane & 15, fq = lane >> 4;
    {
        const int q = tid >> 2, part = tid & 3;
        const bf16_t* src = p.U + (size_t)(T * 128 + q) * 1024 + 512 + g * 128 + part * 32;
        u32x4 raw[4];
#pragma unroll
        for (int i = 0; i < 4; ++i) raw[i] = *(const u32x4*)(src + i * 8);
        float a = 0.f, b = 0.f;
#pragma unroll
        for (int i = 0; i < 4; ++i)
#pragma unroll
            for (int j = 0; j < 4; ++j) {
                const float lo = __uint_as_float(raw[i][j] << 16), hi = __uint_as_float(raw[i][j] & 0xffff0000u);
                a += lo + hi; b += lo * lo + hi * hi;
            }
        a += __shfl_xor(a, 1); a += __shfl_xor(a, 2);
        b += __shfl_xor(b, 1); b += __shfl_xor(b, 2);
        const float mean = a * (1.f / 128.f);
        const float rstd = rsqrtf(fmaxf(b * (1.f / 128.f) - mean * mean, 0.f) + EPS);
        const float* gn = p.gmlp_norm_g + l * 512 + g * 128 + part * 32;
#pragma unroll
        for (int i = 0; i < 4; ++i)
#pragma unroll
            for (int j = 0; j < 4; ++j) {
                const int c0 = part * 32 + i * 8 + j * 2;
                const float lo = __uint_as_float(raw[i][j] << 16), hi = __uint_as_float(raw[i][j] & 0xffff0000u);
                const unsigned w = pk2((lo - mean) * rstd * gn[i * 8 + j * 2], (hi - mean) * rstd * gn[i * 8 + j * 2 + 1]);
                *(LDSP bf16_t*)(smem + c0 * 256 + (((q >> 3) ^ (c0 & 15)) << 4) + (q & 7) * 2) = (bf16_t)(w & 0xffffu);
                *(LDSP bf16_t*)(smem + (c0 + 1) * 256 + (((q >> 3) ^ ((c0 + 1) & 15)) << 4) + (q & 7) * 2) = (bf16_t)(w >> 16);
            }
    }
    __syncthreads();
    const int prow = wid * 16 + fr;
    const bf16_t* wsp = p.ws_bf + ((size_t)(l * 4 + g) * 128 + prow) * 128 + fq * 8;
    bf16x8 a[4];
#pragma unroll
    for (int ks = 0; ks < 4; ++ks) a[ks] = *(const bf16x8*)(wsp + ks * 32);
    f32x4 acc[8];
#pragma unroll
    for (int n = 0; n < 8; ++n) {
        acc[n] = (f32x4){0.f, 0.f, 0.f, 0.f};
        const int c = n * 16 + fr;
#pragma unroll
        for (int ks = 0; ks < 4; ++ks) {
            const bf16x8 bq = *(const LDSP bf16x8*)(smem + c * 256 + (((ks * 4 + fq) ^ (c & 15)) << 4));
            acc[n] = __builtin_amdgcn_mfma_f32_16x16x32_bf16(bq, a[ks], acc[n], 0, 0, 0);
        }
    }
    const float bs = p.b_spatial[(size_t)(l * 4 + g) * 128 + prow];
    const int row = T * 128 + prow;
    const bf16_t* up = p.U + (size_t)row * 1024 + g * 128 + fq * 4;
    bf16_t* mp = p.MIX + (size_t)row * DM + 512 + g * 128 + fq * 4;
#pragma unroll
    for (int n = 0; n < 8; ++n) {
        const u32x2 uu = *(const u32x2*)(up + n * 16);
        const float u0 = __uint_as_float(uu[0] << 16), u1 = __uint_as_float(uu[0] & 0xffff0000u), u2 = __uint_as_float(uu[1] << 16), u3 = __uint_as_float(uu[1] & 0xffff0000u);
        u32x2 w; w[0] = pk2((acc[n][0] + bs) * u0, (acc[n][1] + bs) * u1); w[1] = pk2((acc[n][2] + bs) * u2, (acc[n][3] + bs) * u3);
        *(u32x2*)(mp + n * 16) = w;
    }
    __syncthreads();
}

DI void mixer_phase(const Params& p, int l, ldsp_t smem) {
    const bool last = l == DEPTH - 1;
    for (int u = blockIdx.x; u < 512; u += gridDim.x) attn_unit(p, l, (u & 7) >> 1, u & 1, u >> 3, false, smem);
    if (!last)
        for (int u = blockIdx.x; u < 32; u += gridDim.x) attn_unit(p, l, (u & 7) >> 1, u & 1, u >> 3, true, smem);
    const int nT = last ? 128 : 136;
    for (int u = blockIdx.x; u < nT * 4; u += gridDim.x) gmlp_unit(p, l, u >> 2, u & 3, smem);
}

DI void grid_barrier(unsigned* bar, unsigned k) {
    asm volatile("s_waitcnt vmcnt(0)" ::: "memory");
    __syncthreads();
    if (threadIdx.x == 0) {
        __builtin_amdgcn_fence(__ATOMIC_RELEASE, "agent");
        asm volatile("s_waitcnt vmcnt(0)" ::: "memory");
        const unsigned j = blockIdx.x & 7u, G = gridDim.x;
        const unsigned nsub = (G - j + 7u) >> 3, ngrp = G < 8u ? G : 8u;
        const unsigned old = __hip_atomic_fetch_add(bar + 64 * (1 + j), 1u, __ATOMIC_RELAXED, __HIP_MEMORY_SCOPE_AGENT);
        if (old + 1u == k * nsub) __hip_atomic_fetch_add(bar, 1u, __ATOMIC_RELAXED, __HIP_MEMORY_SCOPE_AGENT);
        unsigned sp = 0;
        while (__hip_atomic_load(bar, __ATOMIC_RELAXED, __HIP_MEMORY_SCOPE_AGENT) < k * ngrp) { __builtin_amdgcn_s_sleep(1); if (++sp > (1u << 22)) break; }
        __builtin_amdgcn_fence(__ATOMIC_ACQUIRE, "agent");
        asm volatile("s_waitcnt vmcnt(0)" ::: "memory");
    }
    __syncthreads();
}

constexpr int N_PHASES = 2 + DEPTH * 5;
DI void run_phase(const Params& p, int ph, ldsp_t smem) {
    if (ph == 0) { phase0(p, smem); return; }
    if (ph == 1) { phase1(p); return; }
    const int l = (ph - 2) / 5, k = (ph - 2) % 5;
    const bool last = l == DEPTH - 1;
    switch (k) {
        case 0: gemm_stream<0>(p, l, p.H, p.wt_in + (size_t)l * IN_DIM * DM, NTOK, IN_DIM, DM, smem); break;
        case 1: mixer_phase(p, l, smem); break;
        case 2: gemm_stream<1>(p, l, p.MIX, p.wt_out + (size_t)l * DM * DM, NLAT, DM, DM, smem);
                if (!last) ctx_tiles<1, 64, 8>(p, l, p.MIX + (size_t)NLAT * DM, p.wt_out + (size_t)l * DM * DM, DM, DM, smem);
                break;
        case 3: gemm_stream<2>(p, l, p.H, p.wt_ff1 + (size_t)l * FF * DM, NLAT, FF, DM, smem);
                if (!last) ctx_tiles<2, 128, 4>(p, l, p.H + (size_t)NLAT * DM, p.wt_ff1 + (size_t)l * FF * DM, FF, DM, smem);
                break;
        default: gemm_stream<3>(p, l, p.ACT, p.wt_ff2 + (size_t)l * DM * FF, NLAT, DM, FF, smem);
                if (!last) ctx_tiles<3, 64, 8>(p, l, p.ACT + (size_t)NLAT * FF, p.wt_ff2 + (size_t)l * DM * FF, DM, FF, smem);
                break;
    }
}

template <bool COOP>
__global__ void __launch_bounds__(512) mk_kernel(Params p, int ph_lo, int ph_hi) {
    __shared__ __attribute__((aligned(1024))) char smem_raw[2 * G_STAGE_B + 8192];
    ldsp_t smem = (ldsp_t)smem_raw;
    for (int ph = ph_lo; ph < ph_hi; ++ph) {
        run_phase(p, ph, smem);
#ifdef DUP_K
        if (ph > 1 && (ph - 2) % 5 == DUP_K) { cg::this_grid().sync(); run_phase(p, ph, smem); }
#endif
        if (COOP && ph + 1 < ph_hi) {
            if (ph == 0) cg::this_grid().sync();
            else grid_barrier(p.bar, (unsigned)ph);
        }
    }
}

extern "C" void kernel_launch(void* const* d_in, const int* in_sizes, int n_in, void* d_out, int out_size, void* d_ws, size_t ws_size, hipStream_t stream) {
    Params p{};
    p.x = (const float*)d_in[0]; p.c = (const float*)d_in[1]; p.ctx = (const float*)d_in[2]; p.c_ctx = (const float*)d_in[3];
    p.w_mod = (const float*)d_in[4]; p.b_mod = (const float*)d_in[5]; p.norm1_g = (const float*)d_in[6]; p.w_in = (const float*)d_in[7];
    p.q_norm_g = (const float*)d_in[8]; p.k_norm_g = (const float*)d_in[9]; p.gmlp_norm_g = (const float*)d_in[10]; p.w_spatial = (const float*)d_in[11];
    p.b_spatial = (const float*)d_in[12]; p.w_out = (const float*)d_in[13]; p.norm2_g = (const float*)d_in[14]; p.w_ff1 = (const float*)d_in[15]; p.w_ff2 = (const float*)d_in[16];
    p.out = (float*)d_out;
    char* w = (char*)d_ws; size_t off = 0;
    auto take = [&](size_t bytes) { char* r = w + off; off += (bytes + 1023) & ~(size_t)1023; return r; };
    p.wt_in = (bf16_t*)take((size_t)DEPTH * IN_DIM * DM * 2);
    p.wt_out = (bf16_t*)take((size_t)DEPTH * DM * DM * 2);
    p.wt_ff1 = (bf16_t*)take((size_t)DEPTH * FF * DM * 2);
    p.wt_ff2 = (bf16_t*)take((size_t)DEPTH * FF * DM * 2);
    p.ws_bf = (bf16_t*)take((size_t)DEPTH * 4 * 128 * 128 * 2);
    p.mod = (float*)take((size_t)DEPTH * 5 * 6144 * 4);
    p.rope = (float*)take(2048 * 4);
    p.xc = (float*)take((size_t)NCTX * DM * 4);
    p.smax = (float*)take(1024);
    p.bar = (unsigned*)take(4096);
    p.ss = (float*)take((size_t)DEPTH * 2 * NTOK * 16 * 4);
    p.shw_in = (float*)take((size_t)DEPTH * 5 * IN_DIM * 4);
    p.shw_ff1 = (float*)take((size_t)DEPTH * 5 * FF * 4);
    p.H = (bf16_t*)take((size_t)NTOK * DM * 2);
    p.ACT = (bf16_t*)take((size_t)NTOK * FF * 2);
    {
        char* a = (char*)p.ACT; size_t o2 = 0;
        auto take2 = [&](size_t bytes) { char* r = a + o2; o2 += (bytes + 1023) & ~(size_t)1023; return r; };
        p.Q = (bf16_t*)take2((size_t)NLAT * 512 * 2);
        p.Qc = (bf16_t*)take2((size_t)NCTX * 512 * 2);
        p.K = (bf16_t*)take2((size_t)NB * 2 * NKEY * 64 * 2);
        p.Vt = (bf16_t*)take2((size_t)NB * 2 * NKEY * 64 * 2);
        p.U = (bf16_t*)take2((size_t)NTOK * 1024 * 2);
        p.MIX = (bf16_t*)take2((size_t)NTOK * DM * 2);
    }
    if (off > ws_size) { fprintf(stderr, "workspace too small: need %zu have %zu\n", off, ws_size); return; }
#if MK_COOP
    static int grid_blocks = 0;
    if (!grid_blocks) {
        int dev = 0, cus = 0, per_cu = 0;
        hipGetDevice(&dev);
        hipDeviceGetAttribute(&cus, hipDeviceAttributeMultiprocessorCount, dev);
        hipOccupancyMaxActiveBlocksPerMultiprocessor(&per_cu, mk_kernel<true>, 512, 0);
        if (per_cu < 1) per_cu = 1;
        grid_blocks = cus * 1;
    }
    int lo = 0, hi = N_PHASES;
    void* args[] = {&p, &lo, &hi};
    hipError_t e = hipLaunchCooperativeKernel((void*)mk_kernel<true>, dim3(grid_blocks), dim3(512), args, 0, stream);
    if (e != hipSuccess) fprintf(stderr, "cooperative launch failed: %s (grid %d)\n", hipGetErrorString(e), grid_blocks);
#else
    for (int ph = 0; ph < N_PHASES; ++ph) mk_kernel<false><<<256, 512, 0, stream>>>(p, ph, ph + 1);
#endif
}
```
